# Optimizing an MI355X kernel written in HIP

```python
import jax, jax.numpy as jnp
from jax import lax
import numpy as np

D_MODEL = 1024
BATCH = 8
SEQ = 4096
DEPTH = 1

GRID_W = 64
CTX_LEN = 256
D_MIX = D_MODEL
EPS = 1e-6
ML_W = D_MIX // 2
ML_HEADS = 4
ML_DH = ML_W // ML_HEADS
ML_CHUNK = 64
CONV_W = 3
ML_COLS = 4 * ML_W + 4 * ML_HEADS
RW_W = D_MIX - ML_W
RW_DH = 64
RW_HEADS = RW_W // RW_DH
RW_LORA_W = 64
RW_LORA_A = 64
RW_LORA_G = 160
RW_LN_EPS = 64e-5
RW_COLS = 3 * RW_W + 2 * RW_LORA_W + 2 * RW_LORA_A + RW_LORA_G
RW_SPLITS = (RW_W, 2 * RW_W, 3 * RW_W, 3 * RW_W + 2 * RW_LORA_W, 3 * RW_W + 2 * RW_LORA_W + 2 * RW_LORA_A)
P_IN = ML_COLS + RW_COLS
N_EXPERTS = 16
EC_FACTOR = 2
D_EXPERT = 2816

kernel_name = "hybrid_mlstm_rwkv7_ecmoe_dit"

F32 = jnp.float32


def rmsnorm(x, g):
    xf = x.astype(F32)
    y = xf * lax.rsqrt(jnp.mean(xf * xf, axis=-1, keepdims=True) + EPS)
    return (y * g).astype(x.dtype)


def centred_dwconv(z, w, b):
    K = w.shape[0]
    p = K // 2
    T = z.shape[1]
    zp = jnp.pad(z, ((0, 0), (p, p), (0, 0)))
    out = zp[:, 0:T] * w[0]
    for i in range(1, K):
        out = out + zp[:, i:i + T] * w[i]
    return out + b


def token_shift(z, mu_prev, mu_next):
    prev = jnp.pad(z, ((0, 0), (1, 0), (0, 0)))[:, :-1]
    nxt = jnp.pad(z, ((0, 0), (0, 1), (0, 0)))[:, 1:]
    return z + mu_prev * (prev - z) + mu_next * (nxt - z)


def to_col_major(z, rows):
    B, T, C = z.shape
    return z.reshape(B, rows, GRID_W, C).transpose(0, 2, 1, 3).reshape(B, T, C)


def from_col_major(z, rows):
    B, T, C = z.shape
    return z.reshape(B, GRID_W, rows, C).transpose(0, 2, 1, 3).reshape(B, T, C)


def _chunks(a, nc):
    B, H, T = a.shape[:3]
    return jnp.moveaxis(a.reshape(B, H, nc, T // nc, *a.shape[3:]), 2, 0)


def mlstm_chunkwise(q, k, v, log_i, log_f, state):
    T = q.shape[2]
    L = ML_CHUNK
    nc = T // L
    causal = jnp.tril(jnp.ones((L, L), bool))

    def step(carry, inp):
        C, n, m = carry
        qb, kb, vb, li, lf = inp
        b = jnp.cumsum(lf, axis=-1)
        Dm = jnp.where(causal, b[..., :, None] - b[..., None, :] + li[..., None, :], -jnp.inf)
        inter = b + m[..., None]
        m_t = jnp.maximum(inter, jnp.max(Dm, axis=-1))
        Wts = jnp.exp(Dm - m_t[..., None]) * jnp.einsum('bhld,bhsd->bhls', qb, kb)
        w_inter = jnp.exp(inter - m_t)
        num = Wts @ vb + w_inter[..., None] * jnp.einsum('bhvk,bhlk->bhlv', C, qb)
        den = jnp.sum(Wts, axis=-1) + w_inter * jnp.einsum('bhk,bhlk->bhl', n, qb)
        h = num / jnp.maximum(jnp.abs(den), jnp.exp(-m_t))[..., None]
        bL = b[..., -1]
        dec = bL[..., None] - b + li
        m_new = jnp.maximum(bL + m, jnp.max(dec, axis=-1))
        wk = jnp.exp(dec - m_new[..., None])
        s_old = jnp.exp(bL + m - m_new)
        C_new = s_old[..., None, None] * C + jnp.einsum('bhl,bhlv,bhlk->bhvk', wk, vb, kb)
        n_new = s_old[..., None] * n + jnp.einsum('bhl,bhlk->bhk', wk, kb)
        return (C_new, n_new, m_new), h

    xs = (_chunks(q, nc), _chunks(k, nc), _chunks(v, nc), _chunks(log_i, nc), _chunks(log_f, nc))
    state, hs = lax.scan(step, state, xs)
    B, H, _, d = q.shape
    return jnp.moveaxis(hs, 0, 2).reshape(B, H, T, d), state


def mlstm_group(u, conv_w, conv_b, gate_b, norm_g, states):
    B, T, _ = u.shape
    u = u.astype(F32)
    zqk, zv, zo, zg = jnp.split(u, (2 * ML_W, 3 * ML_W, 4 * ML_W), axis=-1)
    qk = jax.nn.silu(centred_dwconv(zqk, conv_w, conv_b))
    heads = lambda a: a.reshape(B, T, ML_HEADS, ML_DH).transpose(0, 2, 1, 3)
    q = heads(qk[..., :ML_W])
    k = heads(qk[..., ML_W:]) * (ML_DH ** -0.5)
    v = heads(zv)
    g = (zg + gate_b).reshape(B, T, 4, ML_HEADS).transpose(2, 0, 3, 1)
    li_f, lf_f = g[0], jax.nn.log_sigmoid(g[1])
    li_b, lf_b = g[2], jax.nn.log_sigmoid(g[3])
    flip = lambda a: jnp.flip(a, axis=2)
    h_f, st_f = mlstm_chunkwise(q, k, v, li_f, lf_f, states[0])
    h_b, st_b = mlstm_chunkwise(flip(q), flip(k), flip(v), flip(li_b), flip(lf_b), states[1])
    h = h_f + flip(h_b)
    h = h * lax.rsqrt(jnp.mean(h * h, axis=-1, keepdims=True) + EPS) * norm_g.reshape(ML_HEADS, 1, ML_DH)
    h = h.transpose(0, 2, 1, 3).reshape(B, T, ML_W) * jax.nn.sigmoid(zo)
    return h, (st_f, st_b)


def rwkv7_scan(r, w, k, v, kk, a, S0, reverse):
    def step(S, inp):
        r_t, w_t, k_t, v_t, kk_t, a_t = inp
        sa = jnp.einsum('bhvk,bhk->bhv', S, -kk_t)
        S = S * w_t[:, :, None, :] + sa[..., None] * (kk_t * a_t)[:, :, None, :] + v_t[..., None] * k_t[:, :, None, :]
        return S, jnp.einsum('bhvk,bhk->bhv', S, r_t)
    xs = tuple(jnp.moveaxis(t, 1, 0) for t in (r, w, k, v, kk, a))
    S, ys = lax.scan(step, S0, xs, reverse=reverse)
    return jnp.moveaxis(ys, 0, 1), S


def rwkv_group(u, mu, w0, w_up, a0, a_up, g_up, k_k, k_a, r_k, ln_g, ln_b, states):
    B, T, _ = u.shape
    u = token_shift(u.astype(F32), mu[0], mu[1])
    r, k, v, wd, ad, gd = jnp.split(u, RW_SPLITS, axis=-1)
    wd = wd.reshape(B, T, 2, RW_LORA_W)
    ad = ad.reshape(B, T, 2, RW_LORA_A)
    log_w = -jax.nn.softplus(-(w0 + jnp.einsum('btjr,jrc->btjc', jnp.tanh(wd), w_up))) - 0.5
    decay = jnp.exp(-jnp.exp(log_w))
    a = jax.nn.sigmoid(a0 + jnp.einsum('btjr,jrc->btjc', ad, a_up))
    g = jax.nn.sigmoid(gd) @ g_up
    hd = lambda t: t.reshape(*t.shape[:-1], RW_HEADS, RW_DH)
    kk = hd(k * k_k)
    kk = kk / jnp.maximum(jnp.sqrt(jnp.sum(kk * kk, axis=-1, keepdims=True)), 1e-12)
    k_dir = hd(k[:, :, None] * (1 + (a - 1) * k_a))
    a, decay, r, v = hd(a), hd(decay), hd(r), hd(v)
    y_f, s_f = rwkv7_scan(r, decay[:, :, 0], k_dir[:, :, 0], v, kk, a[:, :, 0], states[0], False)
    y_b, s_b = rwkv7_scan(r, decay[:, :, 1], k_dir[:, :, 1], v, kk, a[:, :, 1], states[1], True)
    y = y_f + y_b
    mean = jnp.mean(y, axis=-1, keepdims=True)
    var = jnp.mean((y - mean) ** 2, axis=-1, keepdims=True)
    y = (y - mean) * lax.rsqrt(var + RW_LN_EPS) * hd(ln_g) + hd(ln_b)
    bonus = jnp.sum(jnp.sum(r[:, :, None] * k_dir * r_k, axis=-1, keepdims=True), axis=2) * v
    return (y + bonus).reshape(B, T, RW_W) * g, (s_f, s_b)


def expert_choice_ffn(h, router_w, w1, w3, w2):
    B, T, D = h.shape
    cap = EC_FACTOR * T // N_EXPERTS
    aff = jax.nn.softmax((h @ router_w).astype(F32), axis=-1)
    gate, idx = lax.top_k(jnp.swapaxes(aff, 1, 2), cap)
    xs = jax.vmap(lambda hb, ib: hb[ib])(h, idx)
    hid = jax.nn.silu(jnp.einsum('becd,edf->becf', xs, w1)) * jnp.einsum('becd,edf->becf', xs, w3)
    ys = jnp.einsum('becf,efd->becd', hid, w2) * gate[..., None].astype(h.dtype)
    return jax.vmap(lambda yb, ib: jnp.zeros((T, D), yb.dtype).at[ib.reshape(-1)].add(yb.reshape(-1, D)))(ys, idx)


def mlstm_zero_state(B):
    z = (jnp.zeros((B, ML_HEADS, ML_DH, ML_DH), F32), jnp.zeros((B, ML_HEADS, ML_DH), F32), jnp.zeros((B, ML_HEADS), F32))
    return (z, z)


def rwkv_zero_state(B):
    S = jnp.zeros((B, RW_HEADS, RW_DH, RW_DH), F32)
    return (S, S)


def setup_inputs(seed: int = 0) -> dict:
    key = jax.random.key(seed)
    ks = iter(jax.random.split(key, 40))
    nrm = lambda shape, s: jax.random.normal(next(ks), shape, F32) * s
    L = DEPTH
    f_bias = jnp.linspace(3.0, 6.0, ML_HEADS, dtype=F32)
    zb = jnp.zeros((ML_HEADS,), F32)
    gate_base = jnp.concatenate([zb, f_bias, zb, f_bias])
    return {
        "x": nrm((BATCH, SEQ, D_MODEL), 1.0),
        "c": nrm((BATCH, D_MODEL), 1.0),
        "ctx": nrm((BATCH, CTX_LEN, D_MODEL), 1.0),
        "c_ctx": nrm((D_MODEL,), 1.0),
        "mod_w": nrm((L, D_MODEL, 6 * D_MODEL), 0.5 * D_MODEL ** -0.5),
        "mod_b": nrm((L, 6 * D_MODEL), 0.02),
        "norm1_g": 1.0 + nrm((L, D_MODEL), 0.05),
        "w_in": nrm((L, D_MODEL, P_IN), D_MODEL ** -0.5),
        "ml_conv_w": nrm((L, CONV_W, 2 * ML_W), CONV_W ** -0.5),
        "ml_conv_b": nrm((L, 2 * ML_W), 0.02),
        "ml_gate_b": gate_base + nrm((L, 4 * ML_HEADS), 0.1),
        "ml_norm_g": 1.0 + nrm((L, ML_W), 0.05),
        "rw_mu": jax.random.uniform(next(ks), (L, 2, RW_COLS), F32, 0.05, 0.45),
        "rw_w0": jnp.linspace(-6.0, 1.0, RW_W, dtype=F32) + nrm((L, 2, RW_W), 0.1),
        "rw_w_up": nrm((L, 2, RW_LORA_W, RW_W), 0.1 * RW_LORA_W ** -0.5),
        "rw_a0": nrm((L, 2, RW_W), 0.1),
        "rw_a_up": nrm((L, 2, RW_LORA_A, RW_W), 0.1 * RW_LORA_A ** -0.5),
        "rw_g_up": nrm((L, RW_LORA_G, RW_W), RW_LORA_G ** -0.5),
        "rw_k_k": 0.85 + nrm((L, RW_W), 0.05),
        "rw_k_a": 1.0 + nrm((L, RW_W), 0.05),
        "rw_r_k": nrm((L, RW_HEADS, RW_DH), 0.1),
        "rw_ln_g": 1.0 + nrm((L, RW_W), 0.05),
        "rw_ln_b": nrm((L, RW_W), 0.02),
        "w_out": nrm((L, D_MIX, D_MODEL), D_MIX ** -0.5),
        "norm2_g": 1.0 + nrm((L, D_MODEL), 0.05),
        "router_w": nrm((L, D_MODEL, N_EXPERTS), D_MODEL ** -0.5),
        "exp_w1": nrm((L, N_EXPERTS, D_MODEL, D_EXPERT), D_MODEL ** -0.5),
        "exp_w3": nrm((L, N_EXPERTS, D_MODEL, D_EXPERT), D_MODEL ** -0.5),
        "exp_w2": nrm((L, N_EXPERTS, D_EXPERT, D_MODEL), D_EXPERT ** -0.5),
        "final_g": 1.0 + nrm((D_MODEL,), 0.05),
    }


def reference(x, c, ctx, c_ctx, mod_w, mod_b, norm1_g, w_in, ml_conv_w, ml_conv_b, ml_gate_b, ml_norm_g,
              rw_mu, rw_w0, rw_w_up, rw_a0, rw_a_up, rw_g_up, rw_k_k, rw_k_a, rw_r_k, rw_ln_g, rw_ln_b,
              w_out, norm2_g, router_w, exp_w1, exp_w3, exp_w2, final_g):
    B, n, _ = x.shape
    rows = n // GRID_W
    h, hc = x, ctx
    for l in range(DEPTH):
        last = l == DEPTH - 1
        m_lat = (jax.nn.silu(c) @ mod_w[l] + mod_b[l])[:, None, :]
        m_ctx = (jax.nn.silu(c_ctx) @ mod_w[l] + mod_b[l])[None, None, :]
        sh1, sc1, g1, sh2, sc2, g2 = jnp.split(m_lat, 6, axis=-1)
        csh1, csc1, cg1, csh2, csc2, cg2 = jnp.split(m_ctx, 6, axis=-1)
        u_c = (rmsnorm(hc, norm1_g[l]) * (1 + csc1) + csh1) @ w_in[l]
        u_l = (rmsnorm(h, norm1_g[l]) * (1 + sc1) + sh1) @ w_in[l]
        ml_args = (ml_conv_w[l], ml_conv_b[l], ml_gate_b[l], ml_norm_g[l])
        rw_args = (rw_mu[l], rw_w0[l], rw_w_up[l], rw_a0[l], rw_a_up[l], rw_g_up[l], rw_k_k[l], rw_k_a[l],
                   rw_r_k[l], rw_ln_g[l], rw_ln_b[l])
        ml_c, ml_st = mlstm_group(u_c[..., :ML_COLS], *ml_args, mlstm_zero_state(B))
        rw_c, rw_st = rwkv_group(u_c[..., ML_COLS:], *rw_args, rwkv_zero_state(B))
        ml_l, _ = mlstm_group(u_l[..., :ML_COLS], *ml_args, ml_st)
        rw_l, _ = rwkv_group(to_col_major(u_l[..., ML_COLS:], rows), *rw_args, rw_st)
        rw_l = from_col_major(rw_l, rows)
        mix_l = jnp.concatenate([ml_l, rw_l], axis=-1).astype(h.dtype) @ w_out[l]
        h = h + g1 * mix_l
        h = h + g2 * expert_choice_ffn(rmsnorm(h, norm2_g[l]) * (1 + sc2) + sh2, router_w[l], exp_w1[l], exp_w3[l], exp_w2[l])
        if not last:
            mix_c = jnp.concatenate([ml_c, rw_c], axis=-1).astype(hc.dtype) @ w_out[l]
            hc = hc + cg1 * mix_c
            hc = hc + cg2 * expert_choice_ffn(rmsnorm(hc, norm2_g[l]) * (1 + csc2) + csh2, router_w[l], exp_w1[l], exp_w3[l], exp_w2[l])
    return rmsnorm(h, final_g)
```

```cpp
#include <hip/hip_runtime.h>
#include <hip/hip_cooperative_groups.h>
#include <stdint.h>
#include <cstdio>
namespace cg = cooperative_groups;

namespace pg8 {
#define PG8_LAS __attribute__((address_space(3)))
typedef unsigned short bf16_t;
typedef short bf16x8 __attribute__((ext_vector_type(8)));
typedef float f32x4 __attribute__((ext_vector_type(4)));
typedef unsigned u32x4 __attribute__((ext_vector_type(4)));
constexpr int BM = 256, BK = 64, HALF = 128, HTB = HALF * BK * 2  , STAGE_BYTES = 8 * HTB, NXCD = 8, WGM = 8;

__host__ __device__ __forceinline__ int lds_byte(int r, int c) { const int st = (r >> 4) * 2 + (c >> 5), rr = r & 15, cc = c & 31, ob = rr * 64 + cc * 2; return st * 1024 + (ob ^ (((ob >> 9) & 1) << 5)); }
__host__ __device__ __forceinline__ void stage_rc(int b, int& R, int& C) { const int st = b / 1024, sb = b % 1024, swz = sb ^ (((sb >> 9) & 1) << 5); R = (st >> 1) * 16 + swz / 64; C = (st & 1) * 32 + (swz % 64) / 2; }
__host__ __device__ __forceinline__ int perm32(int rho) { const int n = rho >> 4, i = rho & 15; return 8 * (i >> 2) + 4 * n + (i & 3); }

struct Unit { int pm, pn; };
struct Gemm { const bf16_t* A; const bf16_t* Bt; int M, N, K; int sa, sb; const int* gidx; };
typedef int i32x8 __attribute__((ext_vector_type(8)));
typedef int i32x4v __attribute__((ext_vector_type(4)));
__device__ __forceinline__ i32x8 cat8(bf16x8 a, bf16x8 b) { const i32x4v x = __builtin_bit_cast(i32x4v, a), y = __builtin_bit_cast(i32x4v, b); return __builtin_shufflevector(x, y, 0, 1, 2, 3, 4, 5, 6, 7); }

struct StaticOrder {
    int nM, nN, nwg, G, c;
    __host__ __device__ void init(int M, int N, int G_, int c_) { nM = M / BM; nN = N / BM; nwg = nM * nN; G = G_; c = c_; }
    __host__ __device__ bool next(int i, Unit& u) const {
        const long L = (long)i * G + c; if (L >= nwg) return false;
        int wgid = (int)L; { const int q = nwg / NXCD, r = nwg % NXCD, xcd = wgid % NXCD, off = wgid / NXCD; wgid = (xcd < r ? xcd * (q + 1) : r * (q + 1) + (xcd - r) * q) + off; }
        const int nig = WGM * nN, gid = wgid / nig, fm = gid * WGM, gsz = (nM - fm) < WGM ? (nM - fm) : WGM;
        u.pm = fm + ((wgid % nig) % gsz); u.pn = (wgid % nig) / gsz; return true;
    }
    __device__ __forceinline__ void a_ready(const Unit&) const {}
    __device__ __forceinline__ void done(const Unit&) const {}
};


template <class Epi, class Sched, bool ALIGN_EPI = false, bool SP2 = false, bool F8 = false, bool GATHER = false>
__device__ __forceinline__ void gemm_phase(PG8_LAS unsigned char* lds, const Gemm g, const Sched& S, const Epi& E) {
    const int tid = threadIdx.x, wid = __builtin_amdgcn_readfirstlane(tid >> 6), lane = tid & 63, wr = wid >> 2, wc = wid & 3, fr = lane & 15, fq = lane >> 4;
    const int K = g.K, nt = K / BK;
    unsigned voffA[2], voffB[2]; int gR[2]; unsigned gC[2];
#pragma unroll
    for (int i = 0; i < 2; ++i) { int R, C; stage_rc(tid * 16 + i * 8192, R, C); const int Rb = Epi::PERM ? ((R & ~31) + perm32(R & 31)) : R;
        voffA[i] = (unsigned)(R * K + C) * 2u; voffB[i] = (unsigned)(Rb * K + C) * 2u; gR[i] = R; gC[i] = (unsigned)C * 2u; }
    unsigned cG[2][2], nG[2][2];
#define PG8_GOFF(dst, pm_) do { _Pragma("unroll") for (int _h = 0; _h < 2; ++_h) _Pragma("unroll") for (int _i = 0; _i < 2; ++_i) dst[_h][_i] = (unsigned)g.gidx[(pm_) * BM + _h * HALF + gR[_i]] * (unsigned)(K * 2) + gC[_i]; } while (0)
    const size_t kstep = (size_t)(BK * 2);
    const size_t hstep = (size_t)HALF * K * 2;
    const size_t tstep = 2 * hstep;
    const unsigned ldsw = (unsigned)wid * 1024u;
    const int aoff = lds_byte(wr * 64 + fr, fq * 8), boff = lds_byte(wc * 32 + fr, fq * 8);
#define PG8_SA(b, h) (((b) * 2 + (h)) * HTB)
#define PG8_SB(b, h) ((4 + (b) * 2 + (h)) * HTB)
#define PG8_STAGE(bufoff, gbase, voff) do { _Pragma("unroll") for (int _i = 0; _i < 2; ++_i) \
        __builtin_amdgcn_global_load_lds((const unsigned*)((const char*)(gbase) + (voff)[_i]), (PG8_LAS unsigned*)(lds + (bufoff) + ldsw + _i * 8192), 16, 0, 0); } while (0)
#define PG8_STAGE_A(bufoff, abase, half, nx) do { if constexpr (GATHER) { _Pragma("unroll") for (int _i = 0; _i < 2; ++_i) { const unsigned _o = (nx) ? nG[half][_i] : cG[half][_i]; \
        __builtin_amdgcn_global_load_lds((const unsigned*)((const char*)(abase) + _o), (PG8_LAS unsigned*)(lds + (bufoff) + ldsw + _i * 8192), 16, 0, 0); } } \
        else PG8_STAGE(bufoff, (abase) + (half) * hstep, voffA); } while (0)
#define PG8_LDA(dst, b, h) do { _Pragma("unroll") for (int m = 0; m < 4; ++m) { if constexpr (F8) { dst##8[m].lo = *(const PG8_LAS i32x4v*)(lds + PG8_SA(b, h) + aoff + m * 2048); dst##8[m].hi = *(const PG8_LAS i32x4v*)(lds + PG8_SA(b, h) + aoff + m * 2048 + 1024); } \
        else { _Pragma("unroll") for (int k = 0; k < 2; ++k) dst[m][k] = *(const PG8_LAS bf16x8*)(lds + PG8_SA(b, h) + aoff + m * 2048 + k * 1024); } } } while (0)
#define PG8_LDB(dst, b, h) do { _Pragma("unroll") for (int n = 0; n < 2; ++n) { if constexpr (F8) { dst##8[n].lo = *(const PG8_LAS i32x4v*)(lds + PG8_SB(b, h) + boff + n * 2048); dst##8[n].hi = *(const PG8_LAS i32x4v*)(lds + PG8_SB(b, h) + boff + n * 2048 + 1024); } \
        else { _Pragma("unroll") for (int k = 0; k < 2; ++k) dst[n][k] = *(const PG8_LAS bf16x8*)(lds + PG8_SB(b, h) + boff + n * 2048 + k * 1024); } } } while (0)
#define PG8_MMA(ai, bj, At, Bt) do { __builtin_amdgcn_s_setprio(1); _Pragma("unroll") for (int m = 0; m < 4; ++m) _Pragma("unroll") for (int n = 0; n < 2; ++n) { \
        if constexpr (F8) asm volatile("v_mfma_scale_f32_16x16x128_f8f6f4 %0, %1, %2, %0, %3, %4 op_sel_hi:[0,0,0]" : "+v"(acc[ai][bj][m][n]) : "v"(Bt##8[n]), "v"(At##8[m]), "v"(f8sa), "v"(f8sb)); \
        else { _Pragma("unroll") for (int k = 0; k < 2; ++k) acc[ai][bj][m][n] = __builtin_amdgcn_mfma_f32_16x16x32_bf16(Bt[n][k], At[m][k], acc[ai][bj][m][n], 0, 0, 0); } } \
        __builtin_amdgcn_s_setprio(0); } while (0)
#define PG8_WAIT_V(n) asm volatile("s_waitcnt vmcnt(" #n ")" ::: "memory")
#define PG8_WAIT_L(n) asm volatile("s_waitcnt lgkmcnt(" #n ")" ::: "memory")
#define PG8_BAR __builtin_amdgcn_s_barrier()
#define PG8_SCHED __builtin_amdgcn_sched_barrier(0)
    Unit cur, nxt; int ui = 0;
    if (!S.next(0, cur)) return;
    f32x4 acc[2][2][4][2];
#pragma unroll
    for (int a = 0; a < 2; ++a)
#pragma unroll
        for (int b = 0; b < 2; ++b)
#pragma unroll
            for (int m = 0; m < 4; ++m)
#pragma unroll
                for (int n = 0; n < 2; ++n) acc[a][b][m][n] = (f32x4){0.f, 0.f, 0.f, 0.f};
    bf16x8 At[4][2], B0[2][2], B1[2][2];
    i32x8 At8[4], B08[2], B18[2];
    const int f8sa = g.sa, f8sb = g.sb;
    const char* cA = (const char*)g.A + (GATHER ? (size_t)0 : (size_t)cur.pm * tstep); const char* cB = (const char*)g.Bt + (size_t)cur.pn * tstep;
    if constexpr (GATHER) { PG8_GOFF(cG, cur.pm); }
    S.a_ready(cur);
    if constexpr (SP2) {
        PG8_STAGE(PG8_SB(0, 0), cB, voffB); PG8_STAGE(PG8_SB(0, 1), cB + hstep, voffB); PG8_STAGE_A(PG8_SA(0, 0), cA, 0, false); PG8_STAGE_A(PG8_SA(0, 1), cA, 1, false);
        if (wr == 1) PG8_BAR;
        PG8_WAIT_V(2); PG8_BAR;
        PG8_STAGE(PG8_SB(1, 0), cB + kstep, voffB); PG8_STAGE_A(PG8_SA(1, 0), cA + kstep, 0, false); PG8_STAGE(PG8_SB(1, 1), cB + hstep + kstep, voffB);
        PG8_WAIT_V(6); PG8_BAR;
    } else {
        PG8_STAGE(PG8_SB(0, 0), cB, voffB); PG8_STAGE_A(PG8_SA(0, 0), cA, 0, false); PG8_STAGE(PG8_SB(0, 1), cB + hstep, voffB); PG8_STAGE_A(PG8_SA(0, 1), cA, 1, false);
        if (wr == 1) PG8_BAR;
        PG8_WAIT_V(4); PG8_BAR;
        PG8_STAGE(PG8_SB(1, 0), cB + kstep, voffB); PG8_STAGE_A(PG8_SA(1, 0), cA + kstep, 0, false); PG8_STAGE(PG8_SB(1, 1), cB + hstep + kstep, voffB);
        PG8_WAIT_V(6); PG8_BAR;
    }
    for (;;) {
        const bool has_next = S.next(ui + 1, nxt);
        if constexpr (GATHER) { if (has_next) { PG8_GOFF(nG, nxt.pm); } else { _Pragma("unroll") for (int _h = 0; _h < 2; ++_h) _Pragma("unroll") for (int _i = 0; _i < 2; ++_i) nG[_h][_i] = cG[_h][_i]; } }
        const char* nA = (has_next && !GATHER) ? (const char*)g.A + (size_t)nxt.pm * tstep : cA; const char* nB = has_next ? (const char*)g.Bt + (size_t)nxt.pn * tstep : cB;
        for (int t = 0; t < nt; t += 2) {
            const bool last = (t == nt - 2);
            const char* a1 = cA + (size_t)(t + 1) * kstep;
            const char* a2 = last ? nA : cA + (size_t)(t + 2) * kstep; const char* b2 = last ? nB : cB + (size_t)(t + 2) * kstep;
            const char* a3 = a2 + kstep; const char* b3 = b2 + kstep;
            if (last && has_next) S.a_ready(nxt);
            if constexpr (SP2) {
            PG8_LDB(B0, 0, 0); PG8_LDB(B1, 0, 1); PG8_SCHED; PG8_LDA(At, 0, 0); PG8_STAGE_A(PG8_SA(1, 1), a1, 1, false);
            PG8_WAIT_V(8); PG8_WAIT_L(0); PG8_BAR; PG8_MMA(0, 0, At, B0); PG8_MMA(0, 1, At, B1); PG8_BAR; PG8_SCHED;
            PG8_LDA(At, 0, 1); PG8_STAGE(PG8_SB(0, 0), b2, voffB); PG8_STAGE(PG8_SB(0, 1), b2 + hstep, voffB); PG8_STAGE_A(PG8_SA(0, 0), a2, 0, last);
            PG8_WAIT_V(8); PG8_WAIT_L(0); PG8_BAR; PG8_MMA(1, 0, At, B0); PG8_MMA(1, 1, At, B1); PG8_BAR; PG8_SCHED;
            PG8_LDB(B0, 1, 0); PG8_LDB(B1, 1, 1); PG8_SCHED; PG8_LDA(At, 1, 0); PG8_STAGE_A(PG8_SA(0, 1), a2, 1, last);
            PG8_WAIT_V(8); PG8_WAIT_L(0); PG8_BAR; PG8_MMA(0, 0, At, B0); PG8_MMA(0, 1, At, B1); PG8_BAR; PG8_SCHED;
            PG8_LDA(At, 1, 1); PG8_STAGE(PG8_SB(1, 0), b3, voffB); PG8_STAGE(PG8_SB(1, 1), b3 + hstep, voffB); PG8_STAGE_A(PG8_SA(1, 0), a3, 0, last);
            PG8_WAIT_V(8); PG8_WAIT_L(0); PG8_BAR; PG8_MMA(1, 0, At, B0); PG8_MMA(1, 1, At, B1); PG8_BAR; PG8_SCHED;
            } else {
            PG8_LDB(B0, 0, 0); PG8_SCHED; PG8_LDA(At, 0, 0); PG8_STAGE_A(PG8_SA(1, 1), a1, 1, false);
            PG8_WAIT_L(8); PG8_BAR; PG8_WAIT_L(0); PG8_MMA(0, 0, At, B0); PG8_BAR; PG8_SCHED;
            PG8_LDB(B1, 0, 1); PG8_STAGE(PG8_SB(0, 0), b2, voffB);
            PG8_BAR; PG8_WAIT_L(0); PG8_MMA(0, 1, At, B1); PG8_BAR;
            PG8_LDA(At, 0, 1); PG8_STAGE_A(PG8_SA(0, 0), a2, 0, last);
            PG8_BAR; PG8_WAIT_L(0); PG8_MMA(1, 0, At, B0); PG8_BAR; PG8_SCHED;
            PG8_STAGE(PG8_SB(0, 1), b2 + hstep, voffB);
            PG8_WAIT_V(6); PG8_BAR; PG8_MMA(1, 1, At, B1); PG8_BAR;
            PG8_LDB(B0, 1, 0); PG8_SCHED; PG8_LDA(At, 1, 0); PG8_STAGE_A(PG8_SA(0, 1), a2, 1, last);
            PG8_WAIT_L(8); PG8_BAR; PG8_WAIT_L(0); PG8_MMA(0, 0, At, B0); PG8_BAR; PG8_SCHED;
            PG8_LDB(B1, 1, 1); PG8_STAGE(PG8_SB(1, 0), b3, voffB);
            PG8_BAR; PG8_WAIT_L(0); PG8_MMA(0, 1, At, B1); PG8_BAR;
            PG8_LDA(At, 1, 1); PG8_STAGE_A(PG8_SA(1, 0), a3, 0, last);
            PG8_BAR; PG8_WAIT_L(0); PG8_MMA(1, 0, At, B0); PG8_BAR; PG8_SCHED;
            PG8_STAGE(PG8_SB(1, 1), b3 + hstep, voffB);
            PG8_WAIT_V(6); PG8_BAR; PG8_MMA(1, 1, At, B1); PG8_BAR;
            }
        }
        if constexpr (ALIGN_EPI) { if (wr == 0) PG8_BAR; }
        if constexpr (!Epi::AFTER_DRAIN) { E(acc, cur, wr, wc, fr, fq); S.done(cur); }
        if (!has_next) break;
#pragma unroll
        for (int a = 0; a < 2; ++a)
#pragma unroll
            for (int b = 0; b < 2; ++b)
#pragma unroll
                for (int m = 0; m < 4; ++m)
#pragma unroll
                    for (int n = 0; n < 2; ++n) acc[a][b][m][n] = (f32x4){0.f, 0.f, 0.f, 0.f};
        cur = nxt; cA = nA; cB = nB; ++ui;
        if constexpr (GATHER) { _Pragma("unroll") for (int _h = 0; _h < 2; ++_h) _Pragma("unroll") for (int _i = 0; _i < 2; ++_i) cG[_h][_i] = nG[_h][_i]; }
        if constexpr (ALIGN_EPI) { if (wr == 1) PG8_BAR; }
    }
    PG8_WAIT_V(0);
    if constexpr (!ALIGN_EPI) { if (wr == 0) PG8_BAR; }
    PG8_BAR;
    if constexpr (Epi::AFTER_DRAIN) { E.fused(acc, cur, wr, wc, fr, fq, lds, wid, lane); S.done(cur); }
#undef PG8_SA
#undef PG8_SB
#undef PG8_STAGE
#undef PG8_STAGE_A
#undef PG8_GOFF
#undef PG8_LDA
#undef PG8_LDB
#undef PG8_MMA
#undef PG8_WAIT_V
#undef PG8_WAIT_L
#undef PG8_BAR
#undef PG8_SCHED
}

}

namespace {
#define LAS __attribute__((address_space(3)))
typedef unsigned short bf16;
typedef float f32x4 __attribute__((ext_vector_type(4)));
typedef unsigned u32x4 __attribute__((ext_vector_type(4)));
typedef unsigned u32x2 __attribute__((ext_vector_type(2)));
constexpr int NT = 512, NW = 8;
constexpr int B_ = 8, T_ = 4096, TC_ = 256, D_ = 1024;
constexpr int NCTX = B_ * TC_, NLAT = B_ * T_, NROW = NCTX + NLAT;
constexpr int PIN = 4016, UC = 4096, MLC = 2064;
constexpr int E_ = 16, CAP = 512, DE = 2816, EG = 16  , NG = E_ / EG;
constexpr int MOD6 = 6 * D_;
constexpr int LDS_BYTES = 152 * 1024;
constexpr size_t MiB = 1024 * 1024;
constexpr size_t OFF_MOD = 0, OFF_LORA = 256 * 1024, OFF_AFF = 1 * MiB, OFF_IDX = 3 * MiB, OFF_GATE = 3 * MiB + 512 * 1024, OFF_SEL = 4 * MiB, OFF_BON = 6 * MiB, OFF_INVN = 8 * MiB, OFF_BAR = 10 * MiB;
constexpr size_t OFF_WIN = 12 * MiB, OFF_WOUT = 20 * MiB;
constexpr size_t OFF_XN1 = 22 * MiB, OFF_U = 90 * MiB, OFF_RWP = 362 * MiB, OFF_G = 600 * MiB, OFF_MIX = 632 * MiB, OFF_ZOX = 696 * MiB, WS_END = 702 * MiB;
constexpr int ZOX_ROWS = 6144;
constexpr size_t OFF_W13 = 22 * MiB, OFF_W2 = 110 * MiB, OFF_XN2 = 154 * MiB, OFF_XS = 186 * MiB, OFF_HID = 250 * MiB, OFF_YS = 426 * MiB;
static_assert(OFF_HID + (size_t)EG * 4096 * DE <= OFF_YS && OFF_YS + (size_t)65536 * D_ * 2 <= OFF_MIX && OFF_W13 + (size_t)E_ * 5632 * D_ <= OFF_W2 && OFF_W2 + (size_t)E_ * D_ * DE <= OFF_XN2 && OFF_XN2 + (size_t)NLAT * D_ <= OFF_XS && OFF_XS + (size_t)65536 * D_ <= OFF_HID && OFF_RWP + (size_t)NROW * 3584 * 2 <= OFF_G, "ws map");

struct Params { const float* in[30]; float* out; unsigned char* ws; int ph_lo, ph_hi; };

__device__ __forceinline__ float bf2f(bf16 v) { return __uint_as_float(((unsigned)v) << 16); }
typedef __bf16 bf16x2_t __attribute__((ext_vector_type(2)));
typedef float f32x2_t __attribute__((ext_vector_type(2)));
__device__ __forceinline__ unsigned pk2(float lo, float hi) { const bf16x2_t h2 = __builtin_convertvector((f32x2_t){lo, hi}, bf16x2_t); return __builtin_bit_cast(unsigned, h2); }
__device__ __forceinline__ unsigned f2bf(float f) { return pk2(f, 0.f) & 0xffffu; }
__device__ __forceinline__ float sigmoidf_(float x) { return 1.f / (1.f + __expf(-x)); }
__device__ __forceinline__ float siluf_(float x) { return x / (1.f + __expf(-x)); }
__device__ __forceinline__ float softplusf_(float x) { return fmaxf(x, 0.f) + log1pf(__expf(-fabsf(x))); }
__device__ __forceinline__ float wave_sum(float v) {
#pragma unroll
    for (int o = 1; o < 64; o <<= 1) v += __shfl_xor(v, o);
    return v;
}

__device__ __forceinline__ unsigned pk4_f8(float a, float b, float c, float d) {
    a = fminf(fmaxf(a, -448.f), 448.f); b = fminf(fmaxf(b, -448.f), 448.f); c = fminf(fmaxf(c, -448.f), 448.f); d = fminf(fmaxf(d, -448.f), 448.f);
    int r = __builtin_amdgcn_cvt_pk_fp8_f32(a, b, 0, false); r = __builtin_amdgcn_cvt_pk_fp8_f32(c, d, r, true); return (unsigned)r; }
__device__ __forceinline__ void transpose_item(const float* W, int N, int Nvalid, bf16* WT, int ldt, long row_off, LAS float* scr, int kb, int nb, int lane) {
    const int k0 = 64 * kb, n0 = 32 * nb;
    const bool ok = (n0 + (lane & 31)) < Nvalid;
#pragma unroll 8
    for (int i = 0; i < 32; ++i) { const int kk = 2 * i + (lane >> 5); scr[kk * 33 + (lane & 31)] = ok ? W[(size_t)(k0 + kk) * N + n0 + (lane & 31)] : 0.f; }
    asm volatile("s_waitcnt lgkmcnt(0)" ::: "memory");
    const int c = lane & 7;
#pragma unroll
    for (int j = 0; j < 4; ++j) { const int n = (lane >> 3) + 8 * j; const LAS float* s = scr + (8 * c) * 33 + n;
        u32x4 o; o.x = pk2(s[0 * 33], s[1 * 33]); o.y = pk2(s[2 * 33], s[3 * 33]); o.z = pk2(s[4 * 33], s[5 * 33]); o.w = pk2(s[6 * 33], s[7 * 33]);
        *(u32x4*)(WT + (size_t)(row_off + n0 + n) * ldt + k0 + 8 * c) = o; }
    asm volatile("s_waitcnt lgkmcnt(0)" ::: "memory");
}
struct XRaw { f32x4 v[8]; };
__device__ __forceinline__ void transpose_load_f8(const float* W, int N, int kb, int nb, int lane, XRaw& R) {
    const float* src = W + (size_t)(64 * kb + (lane >> 3)) * N + 32 * nb + (lane & 7) * 4;
#pragma unroll
    for (int i = 0; i < 8; ++i) R.v[i] = __builtin_nontemporal_load((const f32x4*)(src + (size_t)(8 * i) * N));
}
__device__ __forceinline__ void transpose_finish_f8(const XRaw& R, unsigned char* WT8, int ldt, long row_off, LAS float* scr, int kb, int nb, int lane, float scl) {
    const int k0 = 64 * kb, n0 = 32 * nb;
#pragma unroll
    for (int i = 0; i < 8; ++i) { LAS float* d = scr + (8 * i + (lane >> 3)) * 33 + (lane & 7) * 4; d[0] = R.v[i].x; d[1] = R.v[i].y; d[2] = R.v[i].z; d[3] = R.v[i].w; }
    asm volatile("s_waitcnt lgkmcnt(0)" ::: "memory");
    const int c = lane & 7;
#pragma unroll
    for (int j = 0; j < 4; ++j) { const int n = (lane >> 3) + 8 * j; const LAS float* s = scr + (8 * c) * 33 + n;
        u32x2 o; o.x = pk4_f8(s[0 * 33] * scl, s[1 * 33] * scl, s[2 * 33] * scl, s[3 * 33] * scl); o.y = pk4_f8(s[4 * 33] * scl, s[5 * 33] * scl, s[6 * 33] * scl, s[7 * 33] * scl);
        *(u32x2*)(WT8 + (size_t)(row_off + n0 + n) * ldt + k0 + 8 * c) = o; }
    asm volatile("s_waitcnt lgkmcnt(0)" ::: "memory");
}
__device__ __forceinline__ void phase_prep(const Params& p, LAS unsigned char* lds) {
    const int tid = threadIdx.x, lane = tid & 63, wave = tid >> 6, G = gridDim.x;
    unsigned char* ws = p.ws;
    {
        LAS float* sc = (LAS float*)lds;
        LAS float* red = sc + 9 * D_;
        const float* c = p.in[1]; const float* c_ctx = p.in[3]; const float* mod_w = p.in[4]; const float* mod_b = p.in[5];
        float* mod = (float*)(ws + OFF_MOD);
        bool staged = false;
        for (int item = blockIdx.x; item < MOD6 / 32; item += G) {
            if (!staged) { for (int i = tid; i < 9 * D_; i += NT) { const int r = i / D_, k = i % D_; sc[i] = siluf_(r < 8 ? c[r * D_ + k] : c_ctx[k]); } staged = true; }
            __syncthreads();
            const int kg = tid >> 5, cl = tid & 31, col = item * 32 + cl;
            float acc[9];
#pragma unroll
            for (int r = 0; r < 9; ++r) acc[r] = 0.f;
            for (int k = kg * 64; k < kg * 64 + 64; ++k) { const float w = mod_w[(size_t)k * MOD6 + col];
#pragma unroll
                for (int r = 0; r < 9; ++r) acc[r] += sc[r * D_ + k] * w; }
#pragma unroll
            for (int r = 0; r < 9; ++r) red[(kg * 9 + r) * 32 + cl] = acc[r];
            __syncthreads();
            if (tid < 32) {
#pragma unroll
                for (int r = 0; r < 9; ++r) { float s = 0.f; for (int g = 0; g < 16; ++g) s += red[(g * 9 + r) * 32 + tid]; mod[r * MOD6 + item * 32 + tid] = s + mod_b[item * 32 + tid]; }
            }
        }
        __syncthreads();
    }
    LAS float* scr = (LAS float*)(lds + wave * 16384);
    const int gw = blockIdx.x * NW + wave, NGW = G * NW;
    constexpr int I_IN = 16 * 128, I_OUT = 16 * 32;
    for (int it = gw; it < I_IN + I_OUT; it += NGW) {
        if (it < I_IN) transpose_item(p.in[7], PIN, PIN, (bf16*)(ws + OFF_WIN), D_, 0, scr, it / 128, it % 128, lane);
        else { const int r = it - I_IN; transpose_item(p.in[23], D_, D_, (bf16*)(ws + OFF_WOUT), D_, 0, scr, r / 32, r % 32, lane); }
    }
    {
        bf16* LT = (bf16*)(ws + OFF_LORA);
        const float* w_up = p.in[14]; const float* a_up = p.in[16]; const float* g_up = p.in[17];
        for (int i = blockIdx.x * NT + tid; i < 212992; i += G * NT) {
            float v;
            if (i < 131072) { const int j = i & 65535, d = j >> 15, c = (j >> 6) & 511, r = j & 63; v = (i < 65536 ? w_up : a_up)[(d * 64 + r) * 512 + c]; }
            else { const int j = i - 131072, c = j / 160, r = j % 160; v = g_up[r * 512 + c]; }
            LT[i] = (bf16)f2bf(v);
        }
    }
}
constexpr int EXP_ITEMS = E_ * (2 * 16 * 88 + 44 * 32);
__device__ __forceinline__ void expert_load(const Params& p, int it, int lane, XRaw& R) {
    constexpr int I_E13 = 16 * 88, I_E2 = 44 * 32;
    const int e = it / (2 * I_E13 + I_E2); int r = it % (2 * I_E13 + I_E2);
    if (r < 2 * I_E13) { const int which = r / I_E13; r %= I_E13; transpose_load_f8((which ? p.in[27] : p.in[26]) + (size_t)e * D_ * DE, DE, r / 88, r % 88, lane, R); }
    else { r -= 2 * I_E13; transpose_load_f8(p.in[28] + (size_t)e * DE * D_, D_, r / 32, r % 32, lane, R); }
}
__device__ __forceinline__ void expert_finish(const Params& p, LAS float* scr, int it, int lane, const XRaw& R) {
    constexpr int I_E13 = 16 * 88, I_E2 = 44 * 32;
    unsigned char* ws = p.ws;
    const int e = it / (2 * I_E13 + I_E2); int r = it % (2 * I_E13 + I_E2);
    if (r < 2 * I_E13) {
        const int which = r / I_E13; r %= I_E13; const int kb = r / 88, nb = r % 88, n0 = nb * 32;
        const long row_off = (long)e * 5632 + (n0 / 128) * 256 + (n0 % 128) + which * 128 - n0;
        transpose_finish_f8(R, ws + OFF_W13, D_, row_off, scr, kb, nb, lane, 32.f);
    } else {
        r -= 2 * I_E13;
        transpose_finish_f8(R, ws + OFF_W2, DE, (long)e * D_, scr, r / 32, r % 32, lane, 64.f);
    }
}
__device__ __forceinline__ void expert_item(const Params& p, LAS float* scr, int it, int lane) { XRaw R; expert_load(p, it, lane, R); expert_finish(p, scr, it, lane, R); }
__device__ __forceinline__ void phase_expert_prep(const Params& p, LAS unsigned char* lds) {
    const int tid = threadIdx.x, lane = tid & 63, wave = tid >> 6, G = gridDim.x;
    LAS float* scr = (LAS float*)(lds + wave * 16384);
    const int gw = blockIdx.x * NW + wave, NGW = G * NW;
    for (int it = gw; it < EXP_ITEMS; it += NGW) expert_item(p, scr, it, lane);
}

__device__ __forceinline__ void phase_norm1(const Params& p) {
    const int lane = threadIdx.x & 63, wave = threadIdx.x >> 6;
    const int gw = blockIdx.x * NW + wave, NGW = gridDim.x * NW;
    const float* g = p.in[6]; const float* mod = (const float*)(p.ws + OFF_MOD);
    bf16* xn = (bf16*)(p.ws + OFF_XN1);
    for (int row = gw; row < NROW; row += NGW) {
        const float* src; int mr;
        if (row < NCTX) { src = p.in[2] + (size_t)row * D_; mr = 8; } else { const int rl = row - NCTX; src = p.in[0] + (size_t)rl * D_; mr = rl / T_; }
        f32x4 v[4]; float s = 0.f;
#pragma unroll
        for (int j = 0; j < 4; ++j) { v[j] = *(const f32x4*)(src + j * 256 + lane * 4); s += (v[j].x * v[j].x + v[j].y * v[j].y) + (v[j].z * v[j].z + v[j].w * v[j].w); }
        const float rstd = rsqrtf(wave_sum(s) * (1.f / D_) + 1e-6f);
        const float* sh = mod + mr * MOD6, *scl = sh + D_;
#pragma unroll
        for (int j = 0; j < 4; ++j) {
            const int d = j * 256 + lane * 4;
            const f32x4 gg = *(const f32x4*)(g + d), ss = *(const f32x4*)(scl + d), hh = *(const f32x4*)(sh + d);
            const f32x4 o = v[j] * rstd * gg * (ss + 1.f) + hh;
            u32x2 w; w.x = pk2(o.x, o.y); w.y = pk2(o.z, o.w);
            *(u32x2*)(xn + (size_t)row * D_ + d) = w;
        }
    }
}

struct EpiU {
    static constexpr bool PERM = true, AFTER_DRAIN = false;
    bf16* C; int ldc;
    __device__ __forceinline__ void operator()(const pg8::f32x4 (&acc)[2][2][4][2], const pg8::Unit& u, int wr, int wc, int fr, int fq) const {
        const int row0 = u.pm * 256 + wr * 64 + fr, col0 = u.pn * 256 + wc * 32 + 8 * fq;
#pragma unroll
        for (int ai = 0; ai < 2; ++ai)
#pragma unroll
            for (int m = 0; m < 4; ++m) { bf16* rowp = C + (size_t)(row0 + ai * 128 + m * 16) * ldc + col0;
#pragma unroll
                for (int bj = 0; bj < 2; ++bj) { const pg8::f32x4 v0 = acc[ai][bj][m][0], v1 = acc[ai][bj][m][1];
                    u32x4 w; w.x = pk2(v0[0], v0[1]); w.y = pk2(v0[2], v0[3]); w.z = pk2(v1[0], v1[1]); w.w = pk2(v1[2], v1[3]);
                    __builtin_nontemporal_store(w, (u32x4*)(rowp + bj * 128)); } }
    }
};
struct EpiH {
    static constexpr bool PERM = false, AFTER_DRAIN = false;
    const float* x; const float* mod; float* h;
    __device__ __forceinline__ void operator()(const pg8::f32x4 (&acc)[2][2][4][2], const pg8::Unit& u, int wr, int wc, int fr, int fq) const {
        const int row0 = u.pm * 256 + wr * 64 + fr, col0 = u.pn * 256 + wc * 32 + 4 * fq;
        const float* g1 = mod + ((u.pm * 256) / T_) * MOD6 + 2 * D_;
#pragma unroll
        for (int ai = 0; ai < 2; ++ai)
#pragma unroll
            for (int m = 0; m < 4; ++m) { const size_t off = (size_t)(row0 + ai * 128 + m * 16) * D_ + col0;
#pragma unroll
                for (int bj = 0; bj < 2; ++bj)
#pragma unroll
                    for (int n = 0; n < 2; ++n) { const int cc = bj * 128 + n * 16; const pg8::f32x4 xv = *(const pg8::f32x4*)(x + off + cc), gv = *(const pg8::f32x4*)(g1 + col0 + cc);
                        *(pg8::f32x4*)(h + off + cc) = xv + gv * acc[ai][bj][m][n]; } }
    }
};
struct EpiHid {
    static constexpr bool PERM = true, AFTER_DRAIN = false;
    unsigned char* hid; int nN;
    __device__ __forceinline__ void operator()(const pg8::f32x4 (&acc)[2][2][4][2], const pg8::Unit& u, int, int, int, int) const {
        int t = threadIdx.x; asm volatile("" : "+v"(t));
        const int wid = t >> 6, wr = wid >> 2, wc = wid & 3, fr = t & 15, fq = (t >> 4) & 3;
        const int row0 = u.pm * 256 + wr * 64 + fr, col0 = (u.pn % nN) * 128 + wc * 32 + 8 * fq;
#pragma unroll
        for (int ai = 0; ai < 2; ++ai)
#pragma unroll
            for (int m = 0; m < 4; ++m) {
                float o[8];
#pragma unroll
                for (int n = 0; n < 2; ++n)
#pragma unroll
                    for (int j = 0; j < 4; ++j) { const float a = acc[ai][0][m][n][j]; o[n * 4 + j] = a * __builtin_amdgcn_rcpf(1.f + __expf(-a)) * acc[ai][1][m][n][j] * 8.f; }
                u32x2 w; w.x = pk4_f8(o[0], o[1], o[2], o[3]); w.y = pk4_f8(o[4], o[5], o[6], o[7]);
                *(u32x2*)(hid + (size_t)(row0 + ai * 128 + m * 16) * DE + col0) = w; }
    }
};
struct EpiYs {
    static constexpr bool PERM = true, AFTER_DRAIN = false;
    bf16* ys; const float* gate; int nN;
    __device__ __forceinline__ void operator()(const pg8::f32x4 (&acc)[2][2][4][2], const pg8::Unit& u, int, int, int, int) const {
        int t = threadIdx.x; asm volatile("" : "+v"(t));
        const int wid = t >> 6, wr = wid >> 2, wc = wid & 3, fr = t & 15, fq = (t >> 4) & 3;
        const int row0 = u.pm * 256 + wr * 64 + fr, col0 = (u.pn % nN) * 256 + wc * 32 + 8 * fq;
#pragma unroll
        for (int ai = 0; ai < 2; ++ai)
#pragma unroll
            for (int m = 0; m < 4; ++m) { const int row = row0 + ai * 128 + m * 16; bf16* rowp = ys + (size_t)row * D_ + col0;
#pragma unroll
                for (int bj = 0; bj < 2; ++bj) { const pg8::f32x4 v0 = acc[ai][bj][m][0], v1 = acc[ai][bj][m][1];
                    u32x4 w; w.x = pk2(v0[0], v0[1]); w.y = pk2(v0[2], v0[3]); w.z = pk2(v1[0], v1[1]); w.w = pk2(v1[2], v1[3]);
                    *(u32x4*)(rowp + bj * 128) = w; } }
    }
};
struct ExpertOrder {
    int nN, G, c;
    __device__ bool next(int i, pg8::Unit& u) const {
        if (G == 256) {
            const int xcd = c & 7, l = c >> 3, uidx = i * 32 + l;
            if (uidx >= (EG / 8) * 16 * nN) return false;
            const int es = uidx / (16 * nN), r2 = uidx % (16 * nN), el = xcd + 8 * es;
            const int rg = r2 / (8 * nN), rem = r2 % (8 * nN);
            u.pm = el * 16 + rg * 8 + (rem & 7); u.pn = el * nN + (rem >> 3); return true;
        }
        const long L = (long)i * G + c; if (L >= (long)EG * 16 * nN) return false;
        const int e = (int)(L / (16 * nN)), rem = (int)(L % (16 * nN));
        u.pm = e * 16 + (rem & 15); u.pn = e * nN + (rem >> 4); return true;
    }
    __device__ __forceinline__ void a_ready(const pg8::Unit&) const {}
    __device__ __forceinline__ void done(const pg8::Unit&) const {}
};

__device__ __forceinline__ float bflo(unsigned w) { return __uint_as_float(w << 16); }
__device__ __forceinline__ float bfhi(unsigned w) { return __uint_as_float(w & 0xffff0000u); }
#define BAR_LDS() do { asm volatile("s_waitcnt lgkmcnt(0)" ::: "memory"); __builtin_amdgcn_s_barrier(); asm volatile("" ::: "memory"); } while (0)
__device__ __forceinline__ float rcpf_(float x) { return __builtin_amdgcn_rcpf(x); }
__device__ __forceinline__ float silu_fast(float x) { return x * rcpf_(1.f + __expf(-x)); }
__device__ __forceinline__ float sigmoid_fast(float x) { return rcpf_(1.f + __expf(-x)); }
__device__ __forceinline__ void phase_qk(const Params& p) {
    const int lane = threadIdx.x & 63, wave = threadIdx.x >> 6;
    const int gw = blockIdx.x * NW + wave, NGW = gridDim.x * NW;
    const bf16* u = (const bf16*)(p.ws + OFF_U);
    bf16* QK = (bf16*)(p.ws + OFF_XN1);
    const float* cw = p.in[8]; const float* cb = p.in[9];
    const int c0 = lane * 16;
    float w0[16], w1[16], w2[16], bb[16];
#pragma unroll
    for (int e = 0; e < 16; ++e) { w0[e] = cw[c0 + e]; w1[e] = cw[1024 + c0 + e]; w2[e] = cw[2048 + c0 + e]; bb[e] = cb[c0 + e]; }
    const float scl = c0 >= 512 ? 0.08838834764831845f : 1.f;
    const bool wsplit = gridDim.x == 256;
    const int rstep = wsplit ? 5 * 1024 : NGW, rcnt = wsplit ? (blockIdx.x < 128 ? 2 : 3) : 1;
    const int rbase = wsplit ? (blockIdx.x < 128 ? gw * 2 : 2048 + (gw - 1024) * 3) : gw;
    for (int row0 = rbase; row0 < NROW; row0 += rstep)
    for (int rj = 0; rj < rcnt; ++rj) {
        const int row = row0 + rj; if (row >= NROW) break;
        int t, Tlen;
        if (row < NCTX) { t = row % TC_; Tlen = TC_; } else { t = (row - NCTX) % T_; Tlen = T_; }
        if (row >= NCTX && row < NCTX + ZOX_ROWS) *(u32x4*)((bf16*)(p.ws + OFF_ZOX) + (size_t)(row - NCTX) * 512 + lane * 8) = *(const u32x4*)(u + (size_t)row * UC + 1536 + lane * 8);
        const bf16* src = u + (size_t)row * UC + c0;
        u32x4 zc[2], zp[2], zn[2];
#pragma unroll
        for (int i = 0; i < 2; ++i) {
            zc[i] = *(const u32x4*)(src + i * 8);
            zp[i] = t > 0 ? *(const u32x4*)(src - UC + i * 8) : (u32x4){0u, 0u, 0u, 0u};
            zn[i] = t < Tlen - 1 ? *(const u32x4*)(src + UC + i * 8) : (u32x4){0u, 0u, 0u, 0u};
        }
#pragma unroll
        for (int i = 0; i < 2; ++i) {
            float o[8];
#pragma unroll
            for (int e = 0; e < 4; ++e) {
                const int c = i * 8 + e * 2;
                o[e * 2] = silu_fast(bflo(zp[i][e]) * w0[c] + bflo(zc[i][e]) * w1[c] + bflo(zn[i][e]) * w2[c] + bb[c]) * scl;
                o[e * 2 + 1] = silu_fast(bfhi(zp[i][e]) * w0[c + 1] + bfhi(zc[i][e]) * w1[c + 1] + bfhi(zn[i][e]) * w2[c + 1] + bb[c + 1]) * scl;
            }
            u32x4 w; w.x = pk2(o[0], o[1]); w.y = pk2(o[2], o[3]); w.z = pk2(o[4], o[5]); w.w = pk2(o[6], o[7]);
            *(u32x4*)(QK + (size_t)row * 1024 + c0 + i * 8) = w;
        }
    }
}

typedef short bf16x8 __attribute__((ext_vector_type(8)));
typedef float f32x16 __attribute__((ext_vector_type(16)));
#define MFMA32(a, b, c) __builtin_amdgcn_mfma_f32_32x32x16_bf16((a), (b), (c), 0, 0, 0)
namespace ml {
constexpr int QS = 0, KS = 17408, KTS = 34816, VTS = 53248, VTW = 62464, WS = 71680, CS = 80896, FB = 98304;
constexpr int F_GQ = 0, F_MJ = 64, F_WI = 128, F_WK = 192, F_BC = 256, F_NV = 320, F_NQ = 448, F_DP = 512, F_SC = 704;
constexpr int LDQ = 136, LDK = 72;
}
struct MlRaw { u32x4 q[4]; u32x4 v; bf16 gi, gf; };
__device__ __forceinline__ void ml_load(const bf16* QK, const bf16* u, size_t rowbase, int Tlen, int c, int dir, int h, int vh, int tid, int gi, int gf, MlRaw& R) {
    const int j = tid >> 3, cg = tid & 7;
    const int pp = c * 64 + j, t = dir ? Tlen - 1 - pp : pp;
    const bf16* src = QK + (rowbase + t) * 1024 + (cg < 4 ? h * 128 + cg * 32 : 512 + h * 128 + (cg - 4) * 32);
#pragma unroll
    for (int i = 0; i < 4; ++i) R.q[i] = *(const u32x4*)(src + i * 8);
    R.v = *(const u32x4*)(u + (rowbase + t) * UC + 1024 + h * 128 + vh * 64 + cg * 8);
    R.gi = 0; R.gf = 0;
    if (tid < 64) {
        const int p2 = c * 64 + tid, t2 = dir ? Tlen - 1 - p2 : p2;
        R.gi = u[(rowbase + t2) * UC + 2048 + gi]; R.gf = u[(rowbase + t2) * UC + 2048 + gf];
    }
}
__device__ __forceinline__ void mlstm_item(const Params& p, LAS unsigned char* lds0, int item) {
    using namespace ml;
    LAS unsigned char* lds = lds0;
    LAS float* F = (LAS float*)(lds + FB);
    const bf16* u = (const bf16*)(p.ws + OFF_U); const bf16* QK = (const bf16*)(p.ws + OFF_XN1);
    const float* gate_b = p.in[10];
    const int tid = threadIdx.x, lane = tid & 63, wave = __builtin_amdgcn_readfirstlane(tid >> 6), l31 = lane & 31, hf = lane >> 5;
    const int dir = item & 1, vh = (item >> 1) & 1, h = (item >> 2) & 3, b = item >> 4;
    const int gi = (dir ? 2 : 0) * 4 + h, gf = (dir ? 3 : 1) * 4 + h;
    const float gbi = gate_b[gi], gbf = gate_b[gf];
    bf16* Hout = (bf16*)(p.ws + OFF_MIX) + dir * 512;
    __syncthreads();
    for (int i = tid; i < 64 * LDQ / 2; i += NT) ((LAS unsigned*)(lds + CS))[i] = 0u;
    if (tid < 128) F[F_NV + tid] = 0.f;
    if (tid == 0) F[F_SC + 0] = 0.f;
    f32x16 accC[2];
#pragma unroll
    for (int r = 0; r < 16; ++r) { accC[0][r] = 0.f; accC[1][r] = 0.f; }
    MlRaw R;
    ml_load(QK, u, (size_t)b * TC_, TC_, 0, dir, h, vh, tid, gi, gf, R);
    __syncthreads();
    for (int ci = 0; ci < 68; ++ci) {
        lds = lds0; asm volatile("" : "+v"(lds));
        F = (LAS float*)(lds + FB);
        const int seq = ci >= 4, c = seq ? ci - 4 : ci, Tlen = seq ? T_ : TC_;
        if (wave == 0) {
            const float m = F[F_SC + 0];
            const float li = bf2f(R.gi) + gbi, lfv = -softplusf_(-(bf2f(R.gf) + gbf));
#define DPPF(x, ctrl, rmask, oldv) __int_as_float(__builtin_amdgcn_update_dpp(__float_as_int(oldv), __float_as_int(x), ctrl, rmask, 0xF, false))
            float bsum = lfv;
            bsum += DPPF(bsum, 0x111, 0xF, 0.f); bsum += DPPF(bsum, 0x112, 0xF, 0.f); bsum += DPPF(bsum, 0x114, 0xF, 0.f); bsum += DPPF(bsum, 0x118, 0xF, 0.f);
            bsum += DPPF(bsum, 0x142, 0xA, 0.f); bsum += DPPF(bsum, 0x143, 0xC, 0.f);
            const float g = li - bsum;
            float pm = g;
            const float ninf = -INFINITY;
            pm = fmaxf(pm, DPPF(pm, 0x111, 0xF, ninf)); pm = fmaxf(pm, DPPF(pm, 0x112, 0xF, ninf)); pm = fmaxf(pm, DPPF(pm, 0x114, 0xF, ninf)); pm = fmaxf(pm, DPPF(pm, 0x118, 0xF, ninf));
            pm = fmaxf(pm, DPPF(pm, 0x142, 0xA, ninf)); pm = fmaxf(pm, DPPF(pm, 0x143, 0xC, ninf));
#undef DPPF
            const float Mj = fmaxf(m, pm);
            const float M63 = __shfl(Mj, 63), bL = __shfl(bsum, 63);
            F[F_GQ + lane] = g; F[F_MJ + lane] = Mj; F[F_WI + lane] = __expf(m - Mj); F[F_WK + lane] = __expf(g - M63); F[F_BC + lane] = bsum;
            if (lane == 0) { F[F_SC + 1] = __expf(m - M63); F[F_SC + 2] = bL + M63; }
        }
        {
            const int j = tid >> 3, cg = tid & 7, k0 = (cg & 3) * 32;
#pragma unroll
            for (int i = 0; i < 4; ++i) *(LAS u32x4*)(lds + (cg < 4 ? QS : KS) + (j * LDQ + k0 + i * 8) * 2) = R.q[i];
            if (cg >= 4) {
                const int jc = j ^ ((cg & 3) << 4);
#pragma unroll
                for (int i = 0; i < 4; ++i)
#pragma unroll
                    for (int e = 0; e < 4; ++e) { const unsigned w = R.q[i][e];
                        *(LAS bf16*)(lds + KTS + ((k0 + i * 8 + e * 2) * LDK + jc) * 2) = (bf16)(w & 0xffffu);
                        *(LAS bf16*)(lds + KTS + ((k0 + i * 8 + e * 2 + 1) * LDK + jc) * 2) = (bf16)(w >> 16); }
            }
            const int jv = j ^ (cg << 3);
#pragma unroll
            for (int e = 0; e < 4; ++e) { const unsigned w = R.v[e];
                *(LAS bf16*)(lds + VTS + ((cg * 8 + e * 2) * LDK + jv) * 2) = (bf16)(w & 0xffffu);
                *(LAS bf16*)(lds + VTS + ((cg * 8 + e * 2 + 1) * LDK + jv) * 2) = (bf16)(w >> 16); }
        }
        BAR_LDS();
        {
            const int j = tid >> 3, cg = tid & 7, jv = j ^ (cg << 3); const float wk = F[F_WK + j];
#pragma unroll
            for (int e = 0; e < 4; ++e) { const unsigned w = R.v[e];
                *(LAS bf16*)(lds + VTW + ((cg * 8 + e * 2) * LDK + jv) * 2) = (bf16)f2bf(bflo(w) * wk);
                *(LAS bf16*)(lds + VTW + ((cg * 8 + e * 2 + 1) * LDK + jv) * 2) = (bf16)f2bf(bfhi(w) * wk); }
        }
        if (ci + 1 < 68) { const int s2 = (ci + 1) >= 4, c2 = s2 ? ci + 1 - 4 : ci + 1;
            ml_load(QK, u, s2 ? (size_t)NCTX + (size_t)b * T_ : (size_t)b * TC_, s2 ? T_ : TC_, c2, dir, h, vh, tid, gi, gf, R); }
        f32x16 accH;
#pragma unroll
        for (int r = 0; r < 16; ++r) accH[r] = 0.f;
        const int vt = (wave - 4) >> 1, jt4 = (wave - 4) & 1;
        const int vsw = ((l31 >> 3) & 3) << 3;
        if (wave < 3) {
            const int st = wave == 2 ? 1 : 0, jt = wave == 0 ? 0 : 1;
            f32x16 acc;
#pragma unroll
            for (int r = 0; r < 16; ++r) acc[r] = 0.f;
#pragma unroll
            for (int kk = 0; kk < 8; ++kk) {
                const bf16x8 a = *(const LAS bf16x8*)(lds + KS + ((st * 32 + l31) * LDQ + kk * 16 + hf * 8) * 2);
                const bf16x8 bq = *(const LAS bf16x8*)(lds + QS + ((jt * 32 + l31) * LDQ + kk * 16 + hf * 8) * 2);
                acc = MFMA32(a, bq, acc);
            }
            const int j = jt * 32 + l31; const float Mj = F[F_MJ + j];
            float sum = 0.f;
#pragma unroll
            for (int g4 = 0; g4 < 4; ++g4) {
                const f32x4 gq4 = *(const LAS f32x4*)(F + F_GQ + st * 32 + 8 * g4 + 4 * hf);
                float w4[4];
#pragma unroll
                for (int e = 0; e < 4; ++e) { const int s = st * 32 + 8 * g4 + 4 * hf + e; const float arg = (s <= j) ? gq4[e] - Mj : -INFINITY; const float wv = __expf(arg) * acc[g4 * 4 + e]; w4[e] = wv; sum += wv; }
                u32x2 w; w.x = pk2(w4[0], w4[1]); w.y = pk2(w4[2], w4[3]);
                *(LAS u32x2*)(lds + WS + (j * LDK + st * 32 + 8 * g4 + 4 * hf) * 2) = w;
            }
            sum += __shfl_xor(sum, 32);
            if (hf == 0) F[F_DP + wave * 64 + j] = sum;
        } else if (wave == 3) {
            float s2 = 0.f;
#pragma unroll
            for (int k8 = 0; k8 < 16; ++k8) { const u32x4 w = *(const LAS u32x4*)(lds + QS + (lane * LDQ + k8 * 8) * 2);
                const f32x4 n0 = *(const LAS f32x4*)(F + F_NV + k8 * 8), n1 = *(const LAS f32x4*)(F + F_NV + k8 * 8 + 4);
                s2 += bflo(w[0]) * n0.x + bfhi(w[0]) * n0.y + bflo(w[1]) * n0.z + bfhi(w[1]) * n0.w + bflo(w[2]) * n1.x + bfhi(w[2]) * n1.y + bflo(w[3]) * n1.z + bfhi(w[3]) * n1.w; }
            F[F_NQ + lane] = s2;
        } else {
#pragma unroll
            for (int kk = 0; kk < 8; ++kk) {
                const bf16x8 a = *(const LAS bf16x8*)(lds + CS + ((vt * 32 + l31) * LDQ + kk * 16 + hf * 8) * 2);
                const bf16x8 bq = *(const LAS bf16x8*)(lds + QS + ((jt4 * 32 + l31) * LDQ + kk * 16 + hf * 8) * 2);
                accH = MFMA32(a, bq, accH);
            }
        }
        BAR_LDS();
        if (wave >= 4) {
            f32x16 acc2;
#pragma unroll
            for (int r = 0; r < 16; ++r) acc2[r] = 0.f;
            const int nk = jt4 ? 4 : 2;
            const int vsw4 = (((vt * 32 + l31) >> 3) & 7) << 3;
            for (int kk = 0; kk < nk; ++kk) {
                const bf16x8 a = *(const LAS bf16x8*)(lds + VTS + ((vt * 32 + l31) * LDK + ((kk * 16 + hf * 8) ^ vsw4)) * 2);
                const bf16x8 bw = *(const LAS bf16x8*)(lds + WS + ((jt4 * 32 + l31) * LDK + kk * 16 + hf * 8) * 2);
                acc2 = MFMA32(a, bw, acc2);
            }
            if (seq) {
                const int j = jt4 * 32 + l31;
                const float wi = F[F_WI + j];
                const float dsum = j < 32 ? F[F_DP + j] : F[F_DP + 64 + j] + F[F_DP + 128 + j];
                const float den = dsum + wi * F[F_NQ + j];
                const float inv = rcpf_(fmaxf(fabsf(den), __expf(-(F[F_BC + j] + F[F_MJ + j]))));
                const int pp = c * 64 + j, t = dir ? Tlen - 1 - pp : pp;
                bf16* dst = Hout + ((size_t)b * T_ + t) * 1024 + h * 128 + vh * 64 + vt * 32 + 4 * hf;
#pragma unroll
                for (int g4 = 0; g4 < 4; ++g4) { u32x2 w;
                    w.x = pk2((acc2[g4 * 4] + wi * accH[g4 * 4]) * inv, (acc2[g4 * 4 + 1] + wi * accH[g4 * 4 + 1]) * inv);
                    w.y = pk2((acc2[g4 * 4 + 2] + wi * accH[g4 * 4 + 2]) * inv, (acc2[g4 * 4 + 3] + wi * accH[g4 * 4 + 3]) * inv);
                    *(u32x2*)(dst + 8 * g4) = w; }
            }
        } else {
            const float s_old = F[F_SC + 1];
            const int kt = wave;
#pragma unroll
            for (int r = 0; r < 16; ++r) { accC[0][r] *= s_old; accC[1][r] *= s_old; }
#pragma unroll
            for (int kk = 0; kk < 4; ++kk) {
                const bf16x8 a = *(const LAS bf16x8*)(lds + KTS + ((kt * 32 + l31) * LDK + ((kk * 16 + hf * 8) ^ (kt << 4))) * 2);
                const bf16x8 b0 = *(const LAS bf16x8*)(lds + VTW + ((l31) * LDK + ((kk * 16 + hf * 8) ^ vsw)) * 2);
                const bf16x8 b1 = *(const LAS bf16x8*)(lds + VTW + ((32 + l31) * LDK + ((kk * 16 + hf * 8) ^ (vsw + 32))) * 2);
                accC[0] = MFMA32(a, b0, accC[0]); accC[1] = MFMA32(a, b1, accC[1]);
            }
#pragma unroll
            for (int v2 = 0; v2 < 2; ++v2)
#pragma unroll
                for (int g4 = 0; g4 < 4; ++g4) { u32x2 w; w.x = pk2(accC[v2][g4 * 4], accC[v2][g4 * 4 + 1]); w.y = pk2(accC[v2][g4 * 4 + 2], accC[v2][g4 * 4 + 3]);
                    *(LAS u32x2*)(lds + CS + ((v2 * 32 + l31) * LDQ + kt * 32 + 8 * g4 + 4 * hf) * 2) = w; }
            if (tid < 128) {
                float nn = s_old * F[F_NV + tid];
                const int ksw = ((tid >> 5) & 3) << 4;
#pragma unroll
                for (int s8 = 0; s8 < 8; ++s8) { const u32x4 w = *(const LAS u32x4*)(lds + KTS + (tid * LDK + ((s8 * 8) ^ ksw)) * 2);
                    const f32x4 k0 = *(const LAS f32x4*)(F + F_WK + s8 * 8), k1 = *(const LAS f32x4*)(F + F_WK + s8 * 8 + 4);
                    nn += bflo(w[0]) * k0.x + bfhi(w[0]) * k0.y + bflo(w[1]) * k0.z + bfhi(w[1]) * k0.w + bflo(w[2]) * k1.x + bfhi(w[2]) * k1.y + bflo(w[3]) * k1.z + bfhi(w[3]) * k1.w; }
                F[F_NV + tid] = nn;
            }
            if (tid == 0) F[F_SC + 0] = F[F_SC + 2];
        }
        BAR_LDS();
    }
}

constexpr int RWP_LD = 3584;
__device__ __forceinline__ size_t rw_row(int seq, int b, int p) { return seq ? (size_t)NCTX + (size_t)b * T_ + (size_t)((p & 63) * 64 + (p >> 6)) : (size_t)b * TC_ + p; }
typedef short bf16x8 __attribute__((ext_vector_type(8)));
#define MFMA16(a, b, c) __builtin_amdgcn_mfma_f32_16x16x32_bf16((a), (b), (c), 0, 0, 0)
__device__ __forceinline__ float tanh_fast(float x) { const float xc = fminf(fmaxf(x, -15.f), 15.f); return 1.f - 2.f * rcpf_(__expf(2.f * xc) + 1.f); }
namespace rp {
constexpr int RS = 0, KSH = 16384, XW = 32768, XA = XW + 4608, XG = XA + 4608, OUT = 49152, LDX = 72, LDG = 168;
}
struct RpRaw { u32x4 rows[10]; };
__device__ __forceinline__ void rp_load(const Params& p, int tile, RpRaw& R) {
    const int tid = threadIdx.x, cgp = tid & 255, half = tid >> 8;
    const bf16* u = (const bf16*)(p.ws + OFF_U);
    int seq, b, p0;
    if (tile < 128) { seq = 0; b = tile >> 4; p0 = (tile & 15) * 16; } else { const int t2 = tile - 128; seq = 1; b = t2 >> 8; p0 = (t2 & 255) * 16; }
    const int Tlen = seq ? T_ : TC_;
    if (cgp < 244) {
#pragma unroll
        for (int i = 0; i < 10; ++i) { const int pos = p0 + half * 8 - 1 + i; const bool ok = pos >= 0 && pos < Tlen;
            R.rows[i] = *(const u32x4*)(u + rw_row(seq, b, ok ? pos : p0) * UC + MLC + cgp * 8); }
    }
}
__device__ __forceinline__ void rwkv_prep_tile(const Params& p, LAS unsigned char* lds, int tile, RpRaw& R, int next) {
    using namespace rp;
    const int tid = threadIdx.x, lane = tid & 63, wave = __builtin_amdgcn_readfirstlane(tid >> 6);
    const bf16* u = (const bf16*)(p.ws + OFF_U);
    bf16* RWP = (bf16*)(p.ws + OFF_RWP);
    const float* mu = p.in[12];
    int seq, b, p0;
    if (tile < 128) { seq = 0; b = tile >> 4; p0 = (tile & 15) * 16; } else { const int t2 = tile - 128; seq = 1; b = t2 >> 8; p0 = (t2 & 255) * 16; }
    const int Tlen = seq ? T_ : TC_;
    const size_t srow0 = (seq ? (size_t)NCTX + (size_t)b * T_ : (size_t)b * TC_) + p0;
    {
        const int cgp = tid & 255, half = tid >> 8;
        if (cgp < 244) {
            const int col = cgp * 8;
            u32x4 (&rows)[10] = R.rows;
            if (p0 + half * 8 - 1 < 0) rows[0] = (u32x4){0u, 0u, 0u, 0u};
            if (p0 + half * 8 + 8 >= Tlen) rows[9] = (u32x4){0u, 0u, 0u, 0u};
            float mp[8], mn[8];
#pragma unroll
            for (int e = 0; e < 8; ++e) { mp[e] = mu[col + e]; mn[e] = mu[1952 + col + e]; }
            float kkw[8];
#pragma unroll
            for (int e = 0; e < 8; ++e) kkw[e] = (col >= 512 && col < 1024) ? p.in[18][col - 512 + e] : 0.f;
#pragma unroll
            for (int i = 0; i < 8; ++i) {
                const int t = half * 8 + i;
                float s[8];
#pragma unroll
                for (int e = 0; e < 4; ++e) {
                    const float c0 = bflo(rows[i + 1][e]), c1 = bfhi(rows[i + 1][e]);
                    s[2 * e] = c0 + mp[2 * e] * (bflo(rows[i][e]) - c0) + mn[2 * e] * (bflo(rows[i + 2][e]) - c0);
                    s[2 * e + 1] = c1 + mp[2 * e + 1] * (bfhi(rows[i][e]) - c1) + mn[2 * e + 1] * (bfhi(rows[i + 2][e]) - c1);
                }
                if (col < 1536) {
                    u32x4 w; w.x = pk2(s[0], s[1]); w.y = pk2(s[2], s[3]); w.z = pk2(s[4], s[5]); w.w = pk2(s[6], s[7]);
                    *(u32x4*)(RWP + (srow0 + t) * RWP_LD + col) = w;
                    if (col < 1024) *(LAS u32x4*)(lds + (col < 512 ? RS : KSH) + (t * 512 + (col & 511)) * 2) = w;
                    if (col >= 512 && col < 1024) {
                        float ss = 0.f;
#pragma unroll
                        for (int e = 0; e < 8; ++e) { const float kk = s[e] * kkw[e]; ss += kk * kk; }
                        ss += __shfl_xor(ss, 1); ss += __shfl_xor(ss, 2); ss += __shfl_xor(ss, 4);
                        if ((cgp & 7) == 0) ((float*)(p.ws + OFF_INVN))[(srow0 + t) * 8 + ((col - 512) >> 6)] = rcpf_(fmaxf(sqrtf(ss), 1e-12f));
                    }
                } else if (col < 1664) {
                    const int d = (col - 1536) >> 6, rr = (col - 1536) & 63;
                    u32x4 w; w.x = pk2(tanh_fast(s[0]), tanh_fast(s[1])); w.y = pk2(tanh_fast(s[2]), tanh_fast(s[3])); w.z = pk2(tanh_fast(s[4]), tanh_fast(s[5])); w.w = pk2(tanh_fast(s[6]), tanh_fast(s[7]));
                    *(LAS u32x4*)(lds + XW + ((d * 16 + t) * LDX + rr) * 2) = w;
                } else if (col < 1792) {
                    const int d = (col - 1664) >> 6, rr = (col - 1664) & 63;
                    u32x4 w; w.x = pk2(s[0], s[1]); w.y = pk2(s[2], s[3]); w.z = pk2(s[4], s[5]); w.w = pk2(s[6], s[7]);
                    *(LAS u32x4*)(lds + XA + ((d * 16 + t) * LDX + rr) * 2) = w;
                } else {
                    u32x4 w; w.x = pk2(sigmoid_fast(s[0]), sigmoid_fast(s[1])); w.y = pk2(sigmoid_fast(s[2]), sigmoid_fast(s[3])); w.z = pk2(sigmoid_fast(s[4]), sigmoid_fast(s[5])); w.w = pk2(sigmoid_fast(s[6]), sigmoid_fast(s[7]));
                    *(LAS u32x4*)(lds + XG + (t * LDG + (col - 1792)) * 2) = w;
                }
            }
        }
    }
    {
        const int l15 = lane & 15, q = lane >> 4, head = wave;
        const bf16* LT = (const bf16*)(p.ws + OFF_LORA);
        float bp[2][4];
#pragma unroll
        for (int d = 0; d < 2; ++d)
#pragma unroll
            for (int r = 0; r < 4; ++r) bp[d][r] = 0.f;
        bf16x8 bw[2][2], ba[2][2], bg[5]; float ka_n, rk_n, w0_n[2], a0_n[2];
#define RP_LOADB(ci_) do { const int c_ = head * 64 + (ci_) * 16 + l15; \
            _Pragma("unroll") for (int d = 0; d < 2; ++d) { _Pragma("unroll") for (int s = 0; s < 2; ++s) { \
                bw[d][s] = *(const bf16x8*)(LT + ((size_t)(d * 512 + c_) * 64 + s * 32 + q * 8)); ba[d][s] = *(const bf16x8*)(LT + 65536 + ((size_t)(d * 512 + c_) * 64 + s * 32 + q * 8)); } \
                w0_n[d] = p.in[13][d * 512 + c_]; a0_n[d] = p.in[15][d * 512 + c_]; } \
            _Pragma("unroll") for (int s = 0; s < 5; ++s) bg[s] = *(const bf16x8*)(LT + 131072 + ((size_t)c_ * 160 + s * 32 + q * 8)); \
            ka_n = p.in[19][c_]; rk_n = p.in[20][c_]; } while (0)
        RP_LOADB(0);
        __syncthreads();
#pragma unroll 1
        for (int ci = 0; ci < 4; ++ci) {
            const int c = head * 64 + ci * 16 + l15;
            f32x4 accW[2], accA[2], accG = (f32x4){0.f, 0.f, 0.f, 0.f};
#pragma unroll
            for (int d = 0; d < 2; ++d) {
                accW[d] = (f32x4){0.f, 0.f, 0.f, 0.f}; accA[d] = (f32x4){0.f, 0.f, 0.f, 0.f};
#pragma unroll
                for (int s = 0; s < 2; ++s) {
                    accW[d] = MFMA16(*(const LAS bf16x8*)(lds + XW + ((d * 16 + l15) * LDX + s * 32 + q * 8) * 2), bw[d][s], accW[d]);
                    accA[d] = MFMA16(*(const LAS bf16x8*)(lds + XA + ((d * 16 + l15) * LDX + s * 32 + q * 8) * 2), ba[d][s], accA[d]); }
            }
#pragma unroll
            for (int s = 0; s < 5; ++s) accG = MFMA16(*(const LAS bf16x8*)(lds + XG + (l15 * LDG + s * 32 + q * 8) * 2), bg[s], accG);
            const float ka = ka_n, rk = rk_n, w0c[2] = {w0_n[0], w0_n[1]}, a0c[2] = {a0_n[0], a0_n[1]};
            if (ci < 3) RP_LOADB(ci + 1);
            float rkv[4];
#pragma unroll
            for (int r = 0; r < 4; ++r) { const int t = q * 4 + r; rkv[r] = bf2f(*(const LAS bf16*)(lds + RS + (t * 512 + c) * 2)) * bf2f(*(const LAS bf16*)(lds + KSH + (t * 512 + c) * 2)) * rk; }
#pragma unroll
            for (int d = 0; d < 2; ++d) {
#pragma unroll
                for (int r = 0; r < 4; ++r) {
                    const int t = q * 4 + r;
                    const float lw = accW[d][r] + w0c[d];
                    const float ld = -0.6065306597126334f * sigmoid_fast(lw);
                    const float a = sigmoid_fast(accA[d][r] + a0c[d]);
                    *(LAS bf16*)(lds + OUT + ((2 * d) * 8192 + t * 512 + c) * 2) = (bf16)f2bf(ld);
                    *(LAS bf16*)(lds + OUT + ((2 * d + 1) * 8192 + t * 512 + c) * 2) = (bf16)f2bf(a);
                    bp[d][r] += rkv[r] * (1.f + (a - 1.f) * ka);
                }
            }
#pragma unroll
            for (int r = 0; r < 4; ++r) *(LAS bf16*)(lds + OUT + (4 * 8192 + (q * 4 + r) * 512 + c) * 2) = (bf16)f2bf(accG[r]);
        }
#undef RP_LOADB
        if (seq) {
#pragma unroll
            for (int d = 0; d < 2; ++d)
#pragma unroll
                for (int r = 0; r < 4; ++r) {
                    float v = bp[d][r];
                    v += __shfl_xor(v, 1); v += __shfl_xor(v, 2); v += __shfl_xor(v, 4); v += __shfl_xor(v, 8);
                    if (l15 == 0) ((float*)(p.ws + OFF_BON))[((size_t)d * NLAT + (size_t)b * T_ + p0 + q * 4 + r) * 8 + head] = v;
                }
        }
    }
    __syncthreads();
#pragma unroll
    for (int i = 0; i < 8; ++i) {
        const int pc = tid + i * NT, t = pc >> 8, rem = pc & 255, qq = rem >> 6, c8 = (rem & 63) * 8;
        *(u32x4*)(RWP + (srow0 + t) * RWP_LD + 1536 + qq * 512 + c8) = *(const LAS u32x4*)(lds + OUT + (qq * 8192 + t * 512 + c8) * 2);
    }
    if (seq) {
#pragma unroll
        for (int i = 0; i < 2; ++i) {
            const int pc = tid + i * NT, t = pc >> 6, c8 = (pc & 63) * 8;
            *(u32x4*)((bf16*)(p.ws + OFF_G) + ((size_t)b * T_ + p0 + t) * 512 + c8) = *(const LAS u32x4*)(lds + OUT + (4 * 8192 + t * 512 + c8) * 2);
        }
    }
    rp_load(p, next, R);
    __syncthreads();
}

typedef float f32x2 __attribute__((ext_vector_type(2)));
__device__ __forceinline__ float dpp_sum8(float x) {
    x += __int_as_float(__builtin_amdgcn_update_dpp(0, __float_as_int(x), 0xB1, 0xF, 0xF, true));
    x += __int_as_float(__builtin_amdgcn_update_dpp(0, __float_as_int(x), 0x4E, 0xF, 0xF, true));
    x += __int_as_float(__builtin_amdgcn_update_dpp(0, __float_as_int(x), 0x141, 0xF, 0xF, true));
    return x;
}
namespace rs { constexpr int NS = 32, OPS = 0, VV = 2 * NS * 320 * 4, YB = VV + 2 * NS * 32 * 4, XSCR = YB + 2 * NS * 32 * 4, NCH = (TC_ + T_) / NS; }
struct RsRaw { u32x4 r, k, ld, a, v; float invn; };
__device__ __forceinline__ void rs_load(const bf16* RWP, const float* INVN, int cc, int b, int h, int dir, int vh, int st, RsRaw& R) {
    const int seq = cc >= TC_ / rs::NS, c = seq ? cc - TC_ / rs::NS : cc, Tlen = seq ? T_ : TC_;
    const int step = st >> 3, kq = st & 7;
    const int pos = dir ? Tlen - 1 - (c * rs::NS + step) : c * rs::NS + step;
    const size_t srow = (seq ? (size_t)NCTX + (size_t)b * T_ : (size_t)b * TC_) + pos;
    const bf16* rowp = RWP + srow * RWP_LD + h * 64 + kq * 8;
    R.r = *(const u32x4*)(rowp); R.k = *(const u32x4*)(rowp + 512);
    R.ld = *(const u32x4*)(rowp + 1536 + dir * 1024); R.a = *(const u32x4*)(rowp + 2048 + dir * 1024);
    R.v = *(const u32x4*)(RWP + srow * RWP_LD + 1024 + h * 64 + vh * 32 + (kq & 3) * 8);
    R.invn = INVN[srow * 8 + h];
}
template <bool XCVT>
__device__ __forceinline__ void rwkv_scan_item(const Params& p, LAS unsigned char* lds0, int item) {
    using namespace rs;
    const int tid = threadIdx.x, lane = tid & 63, wave = __builtin_amdgcn_readfirstlane(tid >> 6);
    const int dir = item & 1, vh = (item >> 1) & 1, h = (item >> 2) & 7, b = item >> 5;
    const bf16* RWP = (const bf16*)(p.ws + OFF_RWP); const float* INVN = (const float*)(p.ws + OFF_INVN);
    float* Y = p.out + (size_t)dir * NLAT * 512;
    const int st = tid - 256, skq = st & 7, sstep = st >> 3;
    float kkw[8], kaw[8];
    RsRaw R;
    if (wave >= 4) {
#pragma unroll
        for (int e = 0; e < 8; ++e) { kkw[e] = p.in[18][h * 64 + skq * 8 + e]; kaw[e] = p.in[19][h * 64 + skq * 8 + e]; }
        rs_load(RWP, INVN, 0, b, h, dir, vh, st, R);
    }
    f32x2 S[4];
#pragma unroll
    for (int i = 0; i < 4; ++i) S[i] = (f32x2){0.f, 0.f};
    const int v8 = lane >> 3, kq = lane & 7, vrow = wave * 8 + v8;
    __syncthreads();
    for (int cc = -1; cc <= NCH; ++cc) {
        LAS unsigned char* lds = lds0; asm volatile("" : "+v"(lds));
        if (wave >= 4) {
            if (cc >= 1 + TC_ / NS) {
                const int c1 = cc - 1 - TC_ / NS, pos = dir ? T_ - 1 - (c1 * NS + sstep) : c1 * NS + sstep;
                const f32x4 yv = *(const LAS f32x4*)((const LAS float*)(lds + YB) + (((cc - 1) & 1) * NS + sstep) * 32 + skq * 4);
                *(f32x4*)(Y + ((size_t)b * T_ + (size_t)((pos & 63) * 64 + (pos >> 6))) * 512 + h * 64 + vh * 32 + skq * 4) = yv;
            }
            if (cc + 1 < NCH) {
                const int buf = (cc + 1) & 1;
                LAS float* o = (LAS float*)(lds + OPS) + ((buf * NS + sstep) * 8 + skq) * 40;
                float nk[8], w[8], bb[8], kt[8], rr[8];
#pragma unroll
                for (int e = 0; e < 4; ++e) {
                    const float k0 = bflo(R.k[e]), k1 = bfhi(R.k[e]), a0 = bflo(R.a[e]), a1 = bfhi(R.a[e]);
                    const float n0 = k0 * kkw[2 * e] * R.invn, n1 = k1 * kkw[2 * e + 1] * R.invn;
                    nk[2 * e] = -n0; nk[2 * e + 1] = -n1; bb[2 * e] = n0 * a0; bb[2 * e + 1] = n1 * a1;
                    w[2 * e] = __expf(bflo(R.ld[e])); w[2 * e + 1] = __expf(bfhi(R.ld[e]));
                    kt[2 * e] = k0 * (1.f + (a0 - 1.f) * kaw[2 * e]); kt[2 * e + 1] = k1 * (1.f + (a1 - 1.f) * kaw[2 * e + 1]);
                    rr[2 * e] = bflo(R.r[e]); rr[2 * e + 1] = bfhi(R.r[e]);
                }
                *(LAS f32x4*)(o + 0) = (f32x4){nk[0], nk[1], nk[2], nk[3]}; *(LAS f32x4*)(o + 4) = (f32x4){nk[4], nk[5], nk[6], nk[7]};
                *(LAS f32x4*)(o + 8) = (f32x4){w[0], w[1], w[2], w[3]}; *(LAS f32x4*)(o + 12) = (f32x4){w[4], w[5], w[6], w[7]};
                *(LAS f32x4*)(o + 16) = (f32x4){bb[0], bb[1], bb[2], bb[3]}; *(LAS f32x4*)(o + 20) = (f32x4){bb[4], bb[5], bb[6], bb[7]};
                *(LAS f32x4*)(o + 24) = (f32x4){kt[0], kt[1], kt[2], kt[3]}; *(LAS f32x4*)(o + 28) = (f32x4){kt[4], kt[5], kt[6], kt[7]};
                *(LAS f32x4*)(o + 32) = (f32x4){rr[0], rr[1], rr[2], rr[3]}; *(LAS f32x4*)(o + 36) = (f32x4){rr[4], rr[5], rr[6], rr[7]};
                if (skq < 4) {
                    LAS float* vo = (LAS float*)(lds + VV) + (buf * NS + sstep) * 32 + skq * 8;
                    *(LAS f32x4*)(vo) = (f32x4){bflo(R.v[0]), bfhi(R.v[0]), bflo(R.v[1]), bfhi(R.v[1])};
                    *(LAS f32x4*)(vo + 4) = (f32x4){bflo(R.v[2]), bfhi(R.v[2]), bflo(R.v[3]), bfhi(R.v[3])};
                }
            }
            if (cc + 2 < NCH) rs_load(RWP, INVN, cc + 2, b, h, dir, vh, st, R);
            if (XCVT && cc >= 0 && (cc & 1) == 0) {
                const int it = (blockIdx.x * 4 + (wave - 4)) + 1024 * (cc >> 1);
                if (it < EXP_ITEMS) expert_item(p, (LAS float*)(lds + XSCR + (wave - 4) * 8448), it, lane);
            }
        } else if (cc >= 0 && cc < NCH) {
            const int buf = cc & 1;
            const LAS float* ob = (const LAS float*)(lds + OPS) + (buf * NS * 8 + kq) * 40;
            const LAS float* vb = (const LAS float*)(lds + VV) + buf * NS * 32 + vrow;
            LAS float* yl = (LAS float*)(lds + YB) + buf * NS * 32 + vrow;
            struct Ops { f32x4 n0, n1, w0, w1, b0, b1, k0, k1, r0, r1; float vv; };
#define RS_LOAD(P, i) do { const LAS float* o = ob + (i) * 320; P.n0 = *(const LAS f32x4*)(o); P.n1 = *(const LAS f32x4*)(o + 4); P.w0 = *(const LAS f32x4*)(o + 8); P.w1 = *(const LAS f32x4*)(o + 12); \
        P.b0 = *(const LAS f32x4*)(o + 16); P.b1 = *(const LAS f32x4*)(o + 20); P.k0 = *(const LAS f32x4*)(o + 24); P.k1 = *(const LAS f32x4*)(o + 28); P.r0 = *(const LAS f32x4*)(o + 32); P.r1 = *(const LAS f32x4*)(o + 36); P.vv = vb[(i) * 32]; } while (0)
#define RS_YDONE(i) do { yl[(i) * 32] = dpp_sum8(yp.x + yp.y); } while (0)
#define RS_STEP(P, i, FIN) do { \
        const f32x2 sa2 = (S[0] * (f32x2){P.n0.x, P.n0.y} + S[1] * (f32x2){P.n0.z, P.n0.w}) + (S[2] * (f32x2){P.n1.x, P.n1.y} + S[3] * (f32x2){P.n1.z, P.n1.w}); \
        if (FIN) RS_YDONE((i) - 1); \
        const float sa = dpp_sum8(sa2.x + sa2.y); const f32x2 sav = (f32x2){sa, sa}, vvv = (f32x2){P.vv, P.vv}; \
        S[0] = S[0] * (f32x2){P.w0.x, P.w0.y} + sav * (f32x2){P.b0.x, P.b0.y} + vvv * (f32x2){P.k0.x, P.k0.y}; \
        S[1] = S[1] * (f32x2){P.w0.z, P.w0.w} + sav * (f32x2){P.b0.z, P.b0.w} + vvv * (f32x2){P.k0.z, P.k0.w}; \
        S[2] = S[2] * (f32x2){P.w1.x, P.w1.y} + sav * (f32x2){P.b1.x, P.b1.y} + vvv * (f32x2){P.k1.x, P.k1.y}; \
        S[3] = S[3] * (f32x2){P.w1.z, P.w1.w} + sav * (f32x2){P.b1.z, P.b1.w} + vvv * (f32x2){P.k1.z, P.k1.w}; \
        yp = (S[0] * (f32x2){P.r0.x, P.r0.y} + S[1] * (f32x2){P.r0.z, P.r0.w}) + (S[2] * (f32x2){P.r1.x, P.r1.y} + S[3] * (f32x2){P.r1.z, P.r1.w}); \
    } while (0)
            Ops A, B;
            f32x2 yp;
            RS_LOAD(A, 0);
            RS_LOAD(B, 1);
            RS_STEP(A, 0, false);
            RS_LOAD(A, 2);
            RS_STEP(B, 1, true);
#pragma unroll 1
            for (int i = 2; i < NS; i += 2) {
                RS_LOAD(B, i + 1);
                RS_STEP(A, i, true);
                RS_LOAD(A, i + 2);
                RS_STEP(B, i + 1, true);
            }
            RS_YDONE(NS - 1);
#undef RS_LOAD
#undef RS_STEP
#undef RS_YDONE
        }
        __syncthreads();
    }
}

namespace rc {
constexpr int SET = 10752;
constexpr int RH = 0, BKT = 2304, VT = 6400, GAM = 10496;
constexpr int AH = 3 * SET, BH = AH + 2304, KH = BH + 2304, AHT = KH + 2304  , ABK = AHT + 2 * 4096  , AAK = ABK + 2 * 1024  , AABT = AAK + 2 * 1024, TT = AABT + 1024, W2T = TT + 1024,
              P1T = W2T + 1024, YB = P1T + 2304, END = YB + 4096;
constexpr int NCH = (TC_ + T_) / 16;
}
struct RcRaw { u32x2 r, k, a, v, ld; float invn; };
__device__ __forceinline__ void rc_load(const bf16* RWP, const float* INVN, int cc, int b, int h, int dir, int ei, int ekq, RcRaw& R) {
    const int seq = cc >= TC_ / 16, c = seq ? cc - TC_ / 16 : cc, Tlen = seq ? T_ : TC_;
    const size_t srow = (seq ? (size_t)NCTX + (size_t)b * T_ : (size_t)b * TC_) + (dir ? Tlen - 1 - (c * 16 + ei) : c * 16 + ei);
    const bf16* rowp = RWP + srow * RWP_LD + h * 64 + ekq * 4;
    R.r = *(const u32x2*)(rowp); R.k = *(const u32x2*)(rowp + 512); R.v = *(const u32x2*)(rowp + 1024);
    R.ld = *(const u32x2*)(rowp + 1536 + dir * 1024); R.a = *(const u32x2*)(rowp + 2048 + dir * 1024);
    R.invn = INVN[srow * 8 + h];
}
__device__ __forceinline__ float scan16_row(float x) {
    x += __int_as_float(__builtin_amdgcn_update_dpp(0, __float_as_int(x), 0x111, 0xF, 0xF, true));
    x += __int_as_float(__builtin_amdgcn_update_dpp(0, __float_as_int(x), 0x112, 0xF, 0xF, true));
    x += __int_as_float(__builtin_amdgcn_update_dpp(0, __float_as_int(x), 0x114, 0xF, 0xF, true));
    x += __int_as_float(__builtin_amdgcn_update_dpp(0, __float_as_int(x), 0x118, 0xF, 0xF, true));
    return x;
}
__device__ __forceinline__ void rwkv_chunk_item(const Params& p, LAS unsigned char* lds0, int item) {
    using namespace rc;
    const int tid = threadIdx.x, lane = tid & 63, wave = __builtin_amdgcn_readfirstlane(tid >> 6), l15 = lane & 15, q = lane >> 4;
    const int dir = item & 1, h = (item >> 1) & 7, b = item >> 4;
    const bf16* RWP = (const bf16*)(p.ws + OFF_RWP); const float* INVN = (const float*)(p.ws + OFF_INVN);
    bf16* Y = (bf16*)p.out + (size_t)dir * NLAT * 512;
    __syncthreads();
    for (int i = tid; i < END / 4; i += NT) ((LAS unsigned*)lds0)[i] = 0u;
    const int ei = lane & 15, ekq = (wave & 3) * 4 + (lane >> 4);
    RcRaw R;
    const f32x4 kkw = *(const f32x4*)(p.in[18] + h * 64 + ekq * 4), kaw = *(const f32x4*)(p.in[19] + h * 64 + ekq * 4);
    f32x4 acc[4];
#pragma unroll
    for (int t = 0; t < 4; ++t) acc[t] = (f32x4){0.f, 0.f, 0.f, 0.f};
    __syncthreads();
    for (int cc = -4; cc < NCH; ++cc) {
        LAS unsigned char* lds = lds0; asm volatile("" : "+v"(lds));
        int l15o = l15, qo = q; asm volatile("" : "+v"(l15o), "+v"(qo));
        const int c2 = cc + 2, c1 = cc + 1;
        if (wave < 4) {
            if (c2 >= 0 && c2 < NCH) {
                LAS unsigned char* S2 = lds + (c2 % 3) * SET;
                const float l0 = bflo(R.ld.x), l1 = bfhi(R.ld.x), l2 = bflo(R.ld.y), l3 = bfhi(R.ld.y);
                const float ldi[4] = {l0, l1, l2, l3};
                const float cl[4] = {scan16_row(l0), scan16_row(l1), scan16_row(l2), scan16_row(l3)};
                const float rr[4] = {bflo(R.r.x), bfhi(R.r.x), bflo(R.r.y), bfhi(R.r.y)}, kv[4] = {bflo(R.k.x), bfhi(R.k.x), bflo(R.k.y), bfhi(R.k.y)};
                const float av[4] = {bflo(R.a.x), bfhi(R.a.x), bflo(R.a.y), bfhi(R.a.y)};
                float rh[4], ah[4], bh[4], kh[4], e1[4];
#pragma unroll
                for (int e = 0; e < 4; ++e) {
                    e1[e] = __expf(cl[e]); const float e2 = __expf(-cl[e]), e3 = __expf(cl[e] - ldi[e]);
                    const float kkv = kv[e] * kkw[e] * R.invn;
                    rh[e] = rr[e] * e1[e]; ah[e] = -kkv * e3; bh[e] = kkv * av[e] * e2; kh[e] = kv[e] * (1.f + (av[e] - 1.f) * kaw[e]) * e2;
                }
                const int k0 = ekq * 4;
                { u32x2 w; w.x = pk2(rh[0], rh[1]); w.y = pk2(rh[2], rh[3]); *(LAS u32x2*)(S2 + RH + (ei * 72 + k0) * 2) = w; }
                { u32x2 w; w.x = pk2(ah[0], ah[1]); w.y = pk2(ah[2], ah[3]); *(LAS u32x2*)(lds + AH + (ei * 72 + k0) * 2) = w; }
                { u32x2 w; w.x = pk2(bh[0], bh[1]); w.y = pk2(bh[2], bh[3]); *(LAS u32x2*)(lds + BH + (ei * 72 + k0) * 2) = w; }
                { u32x2 w; w.x = pk2(kh[0], kh[1]); w.y = pk2(kh[2], kh[3]); *(LAS u32x2*)(lds + KH + (ei * 72 + k0) * 2) = w; }
                const int bq = (ei >> 2) * 8 + (ei & 3);
                LAS unsigned char* aht = lds + AHT + (c2 & 1) * 4096;
#pragma unroll
                for (int e = 0; e < 4; ++e) {
                    *(LAS bf16*)(aht + ((k0 + e) * 32 + ei) * 2) = (bf16)f2bf(ah[e]);
                    *(LAS bf16*)(S2 + BKT + ((k0 + e) * 32 + bq) * 2) = (bf16)f2bf(bh[e]);
                    *(LAS bf16*)(S2 + BKT + ((k0 + e) * 32 + bq + 4) * 2) = (bf16)f2bf(kh[e]);
                }
                *(LAS bf16*)(S2 + VT + ((k0 + 0) * 32 + ei) * 2) = (bf16)(R.v.x & 0xffffu); *(LAS bf16*)(S2 + VT + ((k0 + 1) * 32 + ei) * 2) = (bf16)(R.v.x >> 16);
                *(LAS bf16*)(S2 + VT + ((k0 + 2) * 32 + ei) * 2) = (bf16)(R.v.y & 0xffffu); *(LAS bf16*)(S2 + VT + ((k0 + 3) * 32 + ei) * 2) = (bf16)(R.v.y >> 16);
                if (ei == 15) *(LAS f32x4*)(S2 + GAM + k0 * 4) = (f32x4){e1[0], e1[1], e1[2], e1[3]};
            }
            if (cc + 3 >= 0 && cc + 3 < NCH) rc_load(RWP, INVN, cc + 3, b, h, dir, ei, ekq, R);
            if (wave == 0 && c1 >= 0 && c1 < NCH) {
                int lo = lane; asm volatile("" : "+v"(lo));
                const int ci = lo >> 2, part = lo & 3;
                float t[4];
#pragma unroll
                for (int e = 0; e < 4; ++e) t[e] = (part + 4 * e == ci) ? 1.f : 0.f;
#pragma unroll
                for (int m = 15; m >= 1; --m) {
                    const int src = __float_as_int(t[m >> 2]);
                    float tm;
                    switch (m & 3) {
                        case 0: tm = __int_as_float(__builtin_amdgcn_update_dpp(0, src, 0x00, 0xF, 0xF, true)); break;
                        case 1: tm = __int_as_float(__builtin_amdgcn_update_dpp(0, src, 0x55, 0xF, 0xF, true)); break;
                        case 2: tm = __int_as_float(__builtin_amdgcn_update_dpp(0, src, 0xAA, 0xF, 0xF, true)); break;
                        default: tm = __int_as_float(__builtin_amdgcn_update_dpp(0, src, 0xFF, 0xF, 0xF, true)); break;
                    }
                    const f32x4 a4 = *(const LAS f32x4*)((const LAS float*)(lds + AABT) + m * 16 + part * 4);
#pragma unroll
                    for (int e = 0; e < 4; ++e) if (4 * e < m) t[e] = fmaf(a4[e], tm, t[e]);
                }
#pragma unroll
                for (int e = 0; e < 4; ++e) *(LAS bf16*)(lds + TT + (ci * 32 + part + 4 * e) * 2) = (bf16)f2bf(t[e]);
            }
        } else if (cc >= 0) {
            const LAS unsigned char* S0 = lds + (cc % 3) * SET;
            const int vt = wave - 4;
            f32x4 sat = (f32x4){0.f, 0.f, 0.f, 0.f};
            {
                const bf16x8 a = *(const LAS bf16x8*)(lds + W2T + (l15 * 32 + q * 8) * 2);
                const bf16x8 bv = *(const LAS bf16x8*)(S0 + VT + ((vt * 16 + l15) * 32 + q * 8) * 2);
                sat = MFMA16(a, bv, sat);
            }
            f32x4 yt = (f32x4){0.f, 0.f, 0.f, 0.f};
#pragma unroll
            for (int s = 0; s < 2; ++s) {
                u32x4 sb; sb.x = pk2(acc[2 * s][0], acc[2 * s][1]); sb.y = pk2(acc[2 * s][2], acc[2 * s][3]); sb.z = pk2(acc[2 * s + 1][0], acc[2 * s + 1][1]); sb.w = pk2(acc[2 * s + 1][2], acc[2 * s + 1][3]);
                const bf16x8 sB = __builtin_bit_cast(bf16x8, sb);
                u32x4 pa; { const u32x2 lo = *(const LAS u32x2*)(lds + P1T + (l15 * 72 + 32 * s + 4 * q) * 2), hi = *(const LAS u32x2*)(lds + P1T + (l15 * 72 + 32 * s + 16 + 4 * q) * 2); pa = (u32x4){lo.x, lo.y, hi.x, hi.y}; }
                u32x4 ra; { const u32x2 lo = *(const LAS u32x2*)(S0 + RH + (l15 * 72 + 32 * s + 4 * q) * 2), hi = *(const LAS u32x2*)(S0 + RH + (l15 * 72 + 32 * s + 16 + 4 * q) * 2); ra = (u32x4){lo.x, lo.y, hi.x, hi.y}; }
                sat = MFMA16(__builtin_bit_cast(bf16x8, pa), sB, sat);
                yt = MFMA16(__builtin_bit_cast(bf16x8, ra), sB, yt);
            }
            const u32x2 vv = *(const LAS u32x2*)(S0 + VT + ((vt * 16 + l15) * 32 + 4 * q) * 2);
            u32x4 b2; b2.x = pk2(sat[0], sat[1]); b2.y = pk2(sat[2], sat[3]); b2.z = vv.x; b2.w = vv.y;
            const bf16x8 B2 = __builtin_bit_cast(bf16x8, b2);
            yt = MFMA16(*(const LAS bf16x8*)(lds + ABK + (cc & 1) * 1024 + (l15 * 32 + q * 8) * 2), B2, yt);
#pragma unroll
            for (int kt = 0; kt < 4; ++kt) {
                acc[kt] = MFMA16(*(const LAS bf16x8*)(S0 + BKT + ((kt * 16 + l15) * 32 + q * 8) * 2), B2, acc[kt]);
                acc[kt] = acc[kt] * *(const LAS f32x4*)(S0 + GAM + (kt * 16 + 4 * q) * 4);
            }
            LAS float* yb = (LAS float*)(lds + YB) + vt * 16 + l15;
#pragma unroll
            for (int r = 0; r < 4; ++r) yb[(4 * q + r) * 64] = yt[r];
        }
        BAR_LDS();
        if (wave < 4) {
            if (c2 >= 0 && c2 < NCH) {
                const LAS unsigned char* S2 = lds + (c2 % 3) * SET;
                const int ia = wave == 3 ? AH : (wave == 1 ? KH : BH);
                f32x4 d = (f32x4){0.f, 0.f, 0.f, 0.f};
#pragma unroll
                for (int s = 0; s < 2; ++s) {
                    const bf16x8 a = *(const LAS bf16x8*)(lds + ia + (l15 * 72 + s * 32 + q * 8) * 2);
                    bf16x8 bb;
                    if (wave < 2) bb = *(const LAS bf16x8*)(S2 + RH + (l15 * 72 + s * 32 + q * 8) * 2);
                    else if (wave == 2) bb = *(const LAS bf16x8*)(lds + AH + (l15 * 72 + s * 32 + q * 8) * 2);
                    else bb = *(const LAS bf16x8*)(lds + KH + (l15 * 72 + s * 32 + q * 8) * 2);
                    d = MFMA16(a, bb, d);
                }
                if (wave < 2) {
                    float o[4];
#pragma unroll
                    for (int r = 0; r < 4; ++r) o[r] = (4 * qo + r <= l15o) ? d[r] : 0.f;
                    u32x2 w; w.x = pk2(o[0], o[1]); w.y = pk2(o[2], o[3]);
                    *(LAS u32x2*)(lds + ABK + (c2 & 1) * 1024 + (l15 * 32 + q * 8 + wave * 4) * 2) = w;
                } else if (wave == 2) {
                    f32x4 o;
#pragma unroll
                    for (int r = 0; r < 4; ++r) o[r] = (4 * qo + r < l15o) ? d[r] : 0.f;
#pragma unroll
                    for (int r = 0; r < 4; ++r) *(LAS float*)(lds + AABT + (l15 * 16 + r * 4 + q) * 4) = o[r];
                } else {
                    float o[4];
#pragma unroll
                    for (int r = 0; r < 4; ++r) o[r] = (l15o < 4 * qo + r) ? d[r] : 0.f;
                    u32x2 w; w.x = pk2(o[0], o[1]); w.y = pk2(o[2], o[3]);
                    *(LAS u32x2*)(lds + AAK + (c2 & 1) * 1024 + (l15 * 32 + 4 * q) * 2) = w;
                }
            }
        } else {
            if (c1 >= 0 && c1 < NCH) {
                const bf16x8 bt = *(const LAS bf16x8*)(lds + TT + (l15 * 32 + q * 8) * 2);
                const int mt = wave - 4;
                f32x4 d = (f32x4){0.f, 0.f, 0.f, 0.f};
                d = MFMA16(*(const LAS bf16x8*)(lds + AHT + (c1 & 1) * 4096 + ((mt * 16 + l15) * 32 + q * 8) * 2), bt, d);
                { u32x2 w; w.x = pk2(d[0], d[1]); w.y = pk2(d[2], d[3]); *(LAS u32x2*)(lds + P1T + (l15 * 72 + mt * 16 + 4 * q) * 2) = w; }
                if (wave == 4) {
                    f32x4 d2 = (f32x4){0.f, 0.f, 0.f, 0.f};
                    d2 = MFMA16(*(const LAS bf16x8*)(lds + AAK + (c1 & 1) * 1024 + (l15 * 32 + q * 8) * 2), bt, d2);
                    u32x2 w; w.x = pk2(d2[0], d2[1]); w.y = pk2(d2[2], d2[3]);
                    *(LAS u32x2*)(lds + W2T + (l15 * 32 + 4 * q) * 2) = w;
                }
            }
            if (cc >= TC_ / 16) {
                const int t2 = tid - 256, fi = t2 >> 4, part = t2 & 15;
                const int cl1 = cc - TC_ / 16, pos = dir ? T_ - 1 - (cl1 * 16 + fi) : cl1 * 16 + fi;
                const f32x4 yv = *(const LAS f32x4*)((const LAS float*)(lds + YB) + fi * 64 + part * 4);
                u32x2 yw; yw.x = pk2(yv.x, yv.y); yw.y = pk2(yv.z, yv.w);
                *(u32x2*)(Y + ((size_t)b * T_ + (size_t)((pos & 63) * 64 + (pos >> 6))) * 512 + h * 64 + part * 4) = yw;
            }
        }
        BAR_LDS();
    }
}

__device__ __forceinline__ void phase_combine(const Params& p) {
    const int lane = threadIdx.x & 63, wave = threadIdx.x >> 6;
    const int gw = blockIdx.x * NW + wave, NGW = gridDim.x * NW;
    const bf16* u = (const bf16*)(p.ws + OFF_U); const bf16* HFB = (const bf16*)(p.ws + OFF_MIX);
    const bf16* Y = (const bf16*)p.out; const float* BON = (const float*)(p.ws + OFF_BON);
    const bf16* RWP = (const bf16*)(p.ws + OFF_RWP); const bf16* Gb = (const bf16*)(p.ws + OFF_G);
    const float* ml_norm_g = p.in[11]; const float* ln_g = p.in[21]; const float* ln_b = p.in[22];
    bf16* mix = (bf16*)(p.ws + OFF_MIX);
    const int c8 = lane * 8;
    for (int rl = gw; rl < NLAT; rl += NGW) {
        const int b = rl / T_, t = rl % T_, pp = (t & 63) * 64 + (t >> 6);
        const size_t lrow = (size_t)b * T_ + pp;
        const u32x4 hf = *(const u32x4*)(HFB + (size_t)rl * 1024 + c8), hb = *(const u32x4*)(HFB + (size_t)rl * 1024 + 512 + c8);
        const u32x4 zo = rl < ZOX_ROWS ? *(const u32x4*)((const bf16*)(p.ws + OFF_ZOX) + (size_t)rl * 512 + c8) : *(const u32x4*)(u + ((size_t)NCTX + rl) * UC + 1536 + c8);
        float hs[8], ss = 0.f;
#pragma unroll
        for (int e = 0; e < 4; ++e) { hs[2 * e] = bflo(hf[e]) + bflo(hb[e]); hs[2 * e + 1] = bfhi(hf[e]) + bfhi(hb[e]); ss += hs[2 * e] * hs[2 * e] + hs[2 * e + 1] * hs[2 * e + 1]; }
        ss += __shfl_xor(ss, 1); ss += __shfl_xor(ss, 2); ss += __shfl_xor(ss, 4); ss += __shfl_xor(ss, 8);
        const float rs_ = rsqrtf(ss * (1.f / 128.f) + 1e-6f);
        float o[8];
#pragma unroll
        for (int e = 0; e < 4; ++e) { o[2 * e] = hs[2 * e] * rs_ * ml_norm_g[c8 + 2 * e] * sigmoidf_(bflo(zo[e])); o[2 * e + 1] = hs[2 * e + 1] * rs_ * ml_norm_g[c8 + 2 * e + 1] * sigmoidf_(bfhi(zo[e])); }
        { u32x4 w; w.x = pk2(o[0], o[1]); w.y = pk2(o[2], o[3]); w.z = pk2(o[4], o[5]); w.w = pk2(o[6], o[7]); *(u32x4*)(mix + (size_t)rl * D_ + c8) = w; }
        const u32x4 yf = *(const u32x4*)(Y + (size_t)rl * 512 + c8), yb = *(const u32x4*)(Y + ((size_t)NLAT + rl) * 512 + c8);
        float y[8];
#pragma unroll
        for (int e = 0; e < 4; ++e) { y[2 * e] = bflo(yf[e]) + bflo(yb[e]); y[2 * e + 1] = bfhi(yf[e]) + bfhi(yb[e]); }
        float sm = 0.f;
#pragma unroll
        for (int e = 0; e < 8; ++e) sm += y[e];
        sm += __shfl_xor(sm, 1); sm += __shfl_xor(sm, 2); sm += __shfl_xor(sm, 4);
        const float mean = sm * (1.f / 64.f);
        float sv = 0.f;
#pragma unroll
        for (int e = 0; e < 8; ++e) { y[e] -= mean; sv += y[e] * y[e]; }
        sv += __shfl_xor(sv, 1); sv += __shfl_xor(sv, 2); sv += __shfl_xor(sv, 4);
        const float rstd = rsqrtf(sv * (1.f / 64.f) + 64e-5f);
        const int head = lane >> 3;
        const float bonus = BON[lrow * 8 + head] + BON[((size_t)NLAT + lrow) * 8 + head];
        const u32x4 vs = *(const u32x4*)(RWP + ((size_t)NCTX + lrow) * RWP_LD + 1024 + c8), gg = *(const u32x4*)(Gb + lrow * 512 + c8);
#pragma unroll
        for (int e = 0; e < 4; ++e) {
            o[2 * e] = (y[2 * e] * rstd * ln_g[c8 + 2 * e] + ln_b[c8 + 2 * e] + bonus * bflo(vs[e])) * bflo(gg[e]);
            o[2 * e + 1] = (y[2 * e + 1] * rstd * ln_g[c8 + 2 * e + 1] + ln_b[c8 + 2 * e + 1] + bonus * bfhi(vs[e])) * bfhi(gg[e]);
        }
        { u32x4 w; w.x = pk2(o[0], o[1]); w.y = pk2(o[2], o[3]); w.z = pk2(o[4], o[5]); w.w = pk2(o[6], o[7]); *(u32x4*)(mix + (size_t)rl * D_ + 512 + c8) = w; }
    }
}

__device__ __forceinline__ void phase_norm2(const Params& p, LAS unsigned char* lds) {
    const int tid = threadIdx.x, wave = tid >> 6;
    const int gw = blockIdx.x * NW + wave, NGW = gridDim.x * NW;
    const float* g = p.in[24]; const float* router_w = p.in[25]; const float* mod = (const float*)(p.ws + OFF_MOD);
    const float* h = p.out;
    unsigned char* xn2 = p.ws + OFF_XN2;
    float* aff = (float*)(p.ws + OFF_AFF);
    LAS float* RWT = (LAS float*)lds;
    __syncthreads();
    for (int i = tid; i < 16384; i += NT) RWT[(i & 15) * 1024 + (i >> 4)] = router_w[i];
    __syncthreads();
#pragma unroll 1
    for (int rl = gw; rl < NLAT; rl += NGW) {
        int lane = tid & 63; asm volatile("" : "+v"(lane));
        const int b = rl / T_, t = rl % T_;
        const float* sh2 = mod + b * MOD6 + 3 * D_, *sc2 = sh2 + D_;
        f32x4 o[4]; float s = 0.f;
#pragma unroll
        for (int j = 0; j < 4; ++j) { o[j] = *(const f32x4*)(h + (size_t)rl * D_ + j * 256 + lane * 4); s += (o[j].x * o[j].x + o[j].y * o[j].y) + (o[j].z * o[j].z + o[j].w * o[j].w); }
        const float rstd = rsqrtf(wave_sum(s) * (1.f / D_) + 1e-6f);
#pragma unroll
        for (int j = 0; j < 4; ++j) {
            const int d = j * 256 + lane * 4;
            const f32x4 gg = *(const f32x4*)(g + d), ss = *(const f32x4*)(sc2 + d), hh = *(const f32x4*)(sh2 + d);
            o[j] = o[j] * rstd * gg * (ss + 1.f) + hh;
            *(unsigned*)(xn2 + (size_t)rl * D_ + d) = pk4_f8(o[j].x, o[j].y, o[j].z, o[j].w);
        }
        float lg[16];
        const LAS float* RW = RWT + lane * 4;
#pragma unroll
        for (int e = 0; e < 16; ++e) {
            float a0 = 0.f;
#pragma unroll
            for (int j = 0; j < 4; ++j) { const f32x4 w4 = *(const LAS f32x4*)(RW + e * 1024 + j * 256); a0 += (o[j].x * w4.x + o[j].y * w4.y) + (o[j].z * w4.z + o[j].w * w4.w); }
            lg[e] = a0;
        }
        float x8[8], x4[4], x2[2], x1;
#pragma unroll
        for (int i = 0; i < 8; ++i) { const bool up = lane & 32; const float send = up ? lg[i] : lg[i + 8], keep = up ? lg[i + 8] : lg[i]; x8[i] = keep + __shfl_xor(send, 32); }
#pragma unroll
        for (int i = 0; i < 4; ++i) { const bool up = lane & 16; const float send = up ? x8[i] : x8[i + 4], keep = up ? x8[i + 4] : x8[i]; x4[i] = keep + __shfl_xor(send, 16); }
#pragma unroll
        for (int i = 0; i < 2; ++i) { const bool up = lane & 8; const float send = up ? x4[i] : x4[i + 2], keep = up ? x4[i + 2] : x4[i]; x2[i] = keep + __shfl_xor(send, 8); }
        { const bool up = lane & 4; const float send = up ? x2[0] : x2[1], keep = up ? x2[1] : x2[0]; x1 = keep + __shfl_xor(send, 4); }
        x1 += __shfl_xor(x1, 2); x1 += __shfl_xor(x1, 1);
        float mx = x1;
        mx = fmaxf(mx, __shfl_xor(mx, 4)); mx = fmaxf(mx, __shfl_xor(mx, 8)); mx = fmaxf(mx, __shfl_xor(mx, 16)); mx = fmaxf(mx, __shfl_xor(mx, 32));
        const float ex = expf(x1 - mx);
        float sm = ex;
        sm += __shfl_xor(sm, 4); sm += __shfl_xor(sm, 8); sm += __shfl_xor(sm, 16); sm += __shfl_xor(sm, 32);
        const int e = ((lane >> 5) & 1) * 8 + ((lane >> 4) & 1) * 4 + ((lane >> 3) & 1) * 2 + ((lane >> 2) & 1);
        if ((lane & 3) == 0) aff[((size_t)b * E_ + e) * T_ + t] = ex / sm;
    }
}

__device__ __forceinline__ void phase_topk(const Params& p, LAS unsigned char* lds) {
    LAS unsigned* hist = (LAS unsigned*)lds;
    LAS unsigned* wsum = hist + 256;
    LAS unsigned* bc = wsum + 8;
    const float* aff = (const float*)(p.ws + OFF_AFF);
    int* idx = (int*)(p.ws + OFF_IDX); float* gate = (float*)(p.ws + OFF_GATE); int* sel = (int*)(p.ws + OFF_SEL);
    const int tid = threadIdx.x, lane = tid & 63, wave = tid >> 6;
    for (int be = blockIdx.x; be < B_ * E_; be += gridDim.x) {
        const int b = be / E_, e = be % E_;
        unsigned key[8];
        { const u32x4 k0 = *(const u32x4*)(aff + (size_t)be * T_ + tid * 8), k1 = *(const u32x4*)(aff + (size_t)be * T_ + tid * 8 + 4);
          key[0] = k0.x; key[1] = k0.y; key[2] = k0.z; key[3] = k0.w; key[4] = k1.x; key[5] = k1.y; key[6] = k1.z; key[7] = k1.w; }
        unsigned prefix = 0u, need = CAP;
#pragma unroll 1
        for (int pass = 0; pass < 4; ++pass) {
            const int shift = 24 - 8 * pass;
            __syncthreads();
            if (tid < 256) hist[tid] = 0u;
            __syncthreads();
#pragma unroll
            for (int i = 0; i < 8; ++i) if (pass == 0 || (key[i] >> (shift + 8)) == prefix) __hip_atomic_fetch_add(&hist[(key[i] >> shift) & 255u], 1u, __ATOMIC_RELAXED, __HIP_MEMORY_SCOPE_WORKGROUP);
            __syncthreads();
            if (wave == 0) {
                const unsigned h0 = hist[4 * lane], h1 = hist[4 * lane + 1], h2 = hist[4 * lane + 2], h3 = hist[4 * lane + 3];
                const unsigned s = h0 + h1 + h2 + h3;
                unsigned suf = s;
#pragma unroll
                for (int o = 1; o < 64; o <<= 1) { const unsigned t = __shfl_down(suf, o); if (lane + o < 64) suf += t; }
                const unsigned above = suf - s;
                if (above < need && need <= suf) {
                    unsigned c = above, bin, nn;
                    if (c + h3 >= need) { bin = 4 * lane + 3; nn = need - c; }
                    else { c += h3; if (c + h2 >= need) { bin = 4 * lane + 2; nn = need - c; }
                    else { c += h2; if (c + h1 >= need) { bin = 4 * lane + 1; nn = need - c; }
                    else { c += h1; bin = 4 * lane; nn = need - c; } } }
                    bc[0] = bin; bc[1] = nn;
                }
            }
            __syncthreads();
            prefix = (prefix << 8) | bc[0]; need = bc[1];
        }
        unsigned cg = 0u, ce = 0u;
#pragma unroll
        for (int i = 0; i < 8; ++i) { cg += key[i] > prefix ? 1u : 0u; ce += key[i] == prefix ? 1u : 0u; }
        unsigned pk = cg | (ce << 16), inc = pk;
#pragma unroll
        for (int o = 1; o < 64; o <<= 1) { const unsigned t = __shfl_up(inc, o); if (lane >= o) inc += t; }
        __syncthreads();
        if (lane == 63) wsum[wave] = inc;
        __syncthreads();
        unsigned base = 0u;
#pragma unroll
        for (int w = 0; w < 8; ++w) base += w < wave ? wsum[w] : 0u;
        unsigned excl = base + inc - pk;
        unsigned gtb = excl & 0xffffu, eqb = excl >> 16;
#pragma unroll
        for (int i = 0; i < 8; ++i) {
            const int t = tid * 8 + i;
            const bool isg = key[i] > prefix, ise = key[i] == prefix;
            const bool take = isg || (ise && eqb < need);
            const int slot = (int)(gtb + (eqb < need ? eqb : need));
            if (take) { idx[e * 4096 + b * CAP + slot] = b * T_ + t; gate[e * 4096 + b * CAP + slot] = __uint_as_float(key[i]); }
            sel[(size_t)be * T_ + t] = take ? slot : -1;
            gtb += isg ? 1u : 0u; eqb += ise ? 1u : 0u;
        }
    }
}

__device__ __forceinline__ void phase_gather(const Params& p) {
    const int lane = threadIdx.x & 63, wave = threadIdx.x >> 6;
    const int gw = blockIdx.x * NW + wave, NGW = gridDim.x * NW;
    const unsigned char* xn2 = p.ws + OFF_XN2; const int* idx = (const int*)(p.ws + OFF_IDX);
    unsigned char* xs = p.ws + OFF_XS;
    for (int r = gw; r < E_ * 4096; r += NGW) *(u32x4*)(xs + (size_t)r * D_ + lane * 16) = *(const u32x4*)(xn2 + (size_t)idx[r] * D_ + lane * 16);
}

__device__ __forceinline__ void phase_final(const Params& p) {
    const int lane = threadIdx.x & 63, wave = threadIdx.x >> 6;
    const int gw = blockIdx.x * NW + wave, NGW = gridDim.x * NW;
    const float* mod = (const float*)(p.ws + OFF_MOD); const float* fg = p.in[29];
    const bf16* ys = (const bf16*)(p.ws + OFF_YS); const int* sel = (const int*)(p.ws + OFF_SEL); const float* gate = (const float*)(p.ws + OFF_GATE);
    float* out = p.out;
    for (int rl = gw; rl < NLAT; rl += NGW) {
        const int b = rl / T_, t = rl % T_;
        const int myslot = lane < 16 ? sel[((size_t)b * E_ + lane) * T_ + t] : -1;
        const float mygate = myslot >= 0 ? gate[(size_t)lane * 4096 + b * CAP + myslot] : 0.f;
        f32x4 acc[4];
#pragma unroll
        for (int j = 0; j < 4; ++j) acc[j] = (f32x4){0.f, 0.f, 0.f, 0.f};
        for (int e = 0; e < 16; ++e) {
            const int s = __shfl(myslot, e); const float gt = __shfl(mygate, e);
            if (s >= 0) {
                const bf16* yr = ys + ((size_t)e * 4096 + b * CAP + s) * D_;
#pragma unroll
                for (int j = 0; j < 4; ++j) { const u32x2 w = *(const u32x2*)(yr + j * 256 + lane * 4);
                    acc[j].x += gt * __uint_as_float(w.x << 16); acc[j].y += gt * __uint_as_float(w.x & 0xffff0000u); acc[j].z += gt * __uint_as_float(w.y << 16); acc[j].w += gt * __uint_as_float(w.y & 0xffff0000u); }
            }
        }
        const float* g2 = mod + b * MOD6 + 5 * D_;
        f32x4 o[4]; float s2 = 0.f;
#pragma unroll
        for (int j = 0; j < 4; ++j) { const int d = j * 256 + lane * 4; o[j] = *(const f32x4*)(out + (size_t)rl * D_ + d) + *(const f32x4*)(g2 + d) * acc[j];
            s2 += (o[j].x * o[j].x + o[j].y * o[j].y) + (o[j].z * o[j].z + o[j].w * o[j].w); }
        const float rstd = rsqrtf(wave_sum(s2) * (1.f / D_) + 1e-6f);
#pragma unroll
        for (int j = 0; j < 4; ++j) { const int d = j * 256 + lane * 4; *(f32x4*)(out + (size_t)rl * D_ + d) = o[j] * rstd * *(const f32x4*)(fg + d); }
    }
}


#define GAS __attribute__((address_space(1)))
#define XB_TMO      128
#define XB_XCNT(j)  (256  + 64 * (j))
#define XB_XSUB(j)  (1280 + 64 * (j))
#define XB_XGEN(j)  (2304 + 64 * (j))
#define XB_TOP      3328
#define XB_TOPGEN   3392
#define XCD_BAR_WORDS 3456
#define XB_SPIN_CAP (1u << 24)

__device__ __forceinline__ unsigned xb_ld(unsigned* p)              { return __hip_atomic_load(p, __ATOMIC_RELAXED, __HIP_MEMORY_SCOPE_AGENT); }
__device__ __forceinline__ unsigned xb_add(unsigned* p, unsigned v) { return __hip_atomic_fetch_add(p, v, __ATOMIC_RELAXED, __HIP_MEMORY_SCOPE_AGENT); }
__device__ __forceinline__ unsigned xb_xcc_id() { return (unsigned)__builtin_amdgcn_s_getreg((3 << 11) | 20) & 0xFu; }
#define XB_SPIN(cond, bar) do { unsigned _sp = 0; while (cond) { __builtin_amdgcn_s_sleep(1); \
    if ((++_sp & 255u) == 0u) { if (xb_ld(&(bar)[XB_TMO])) break; if (_sp > XB_SPIN_CAP) { atomicAdd(&(bar)[XB_TMO], 1u); break; } } } } while (0)

struct XcdBarrier {
    unsigned* bar; unsigned x;
    volatile LAS unsigned* st;
};

__device__ __forceinline__ XcdBarrier xcd_barrier_post(unsigned* bar, volatile LAS unsigned* st) {
    XcdBarrier b; b.bar = bar; b.x = xb_xcc_id(); b.st = st;
    if (threadIdx.x == 0) (void)xb_add(&bar[XB_XCNT(b.x)], 1u);
    return b;
}
__device__ __forceinline__ void xcd_barrier_complete(unsigned* bar, unsigned x, unsigned& nloc, unsigned& nx) {
    const unsigned G = gridDim.x * gridDim.y * gridDim.z;
    unsigned sum, cnt, mine, sp = 0u;
    for (;;) {
        sum = 0u; cnt = 0u; mine = 0u;
#pragma unroll
        for (unsigned j = 0; j < 16; ++j) { const unsigned c = xb_ld(&bar[XB_XCNT(j)]); sum += c; cnt += (c > 0u) ? 1u : 0u; mine = (j == x) ? c : mine; }
        if (sum == G) break;
        __builtin_amdgcn_s_sleep(1);
        if ((++sp & 255u) == 0u) { if (xb_ld(&bar[XB_TMO])) break; if (sp > XB_SPIN_CAP) { atomicAdd(&bar[XB_TMO], 1u); break; } }
    }
    nloc = mine > 0u ? mine : 1u; nx = cnt > 0u ? cnt : 1u;
}

__device__ __forceinline__ void xcd_barrier(const XcdBarrier& b) {
    asm volatile("s_waitcnt vmcnt(0)" ::: "memory");
    __syncthreads();
    if (threadIdx.x == 0) {
        unsigned* bar = b.bar;
        __builtin_amdgcn_s_waitcnt(0);
        unsigned nloc = b.st[0], nx = b.st[1];
        if (nloc == 0u) { xcd_barrier_complete(bar, b.x, nloc, nx); b.st[0] = nloc; b.st[1] = nx; }
        const unsigned old = xb_add(&bar[XB_XSUB(b.x)], 1u);
        const unsigned gen = old / nloc;
        if (old + 1u == (gen + 1u) * nloc) {
            __builtin_amdgcn_fence(__ATOMIC_RELEASE, "agent");
            asm volatile("s_waitcnt vmcnt(0)" ::: "memory");
            const unsigned og = xb_add(&bar[XB_TOP], 1u);
            const unsigned tg = og / nx;
            if (og + 1u == (tg + 1u) * nx) xb_add(&bar[XB_TOPGEN], 1u);
            else XB_SPIN(xb_ld(&bar[XB_TOPGEN]) == tg, bar);
            __builtin_amdgcn_fence(__ATOMIC_ACQUIRE, "agent");
            xb_add(&bar[XB_XGEN(b.x)], 1u);
            asm volatile("s_waitcnt vmcnt(0)" ::: "memory");
        } else {
            XB_SPIN(xb_ld(&bar[XB_XGEN(b.x)]) == gen, bar);
            __builtin_amdgcn_fence(__ATOMIC_ACQUIRE, "agent");
            asm volatile("s_waitcnt vmcnt(0)" ::: "memory");
        }
    }
    __syncthreads();
}


__device__ __forceinline__ void phase_expert_dynamic(const Params& p, LAS unsigned char* lds, volatile LAS unsigned* misc, unsigned* xctr) {
    const int lane = threadIdx.x & 63, wave = threadIdx.x >> 6; LAS float* scr = (LAS float*)(lds + wave * 16384);
    constexpr int XCH = 64;
    static_assert(EXP_ITEMS % XCH == 0, "chunking");
    __syncthreads();
    if (threadIdx.x == 0) misc[8] = xb_add(xctr, 1u);
    __syncthreads();
    unsigned cur = misc[8];
#pragma unroll 1
    while (cur < (unsigned)(EXP_ITEMS / XCH)) {
        unsigned nxt = 0u; if (threadIdx.x == 0) nxt = xb_add(xctr, 1u);
        const int it0 = (int)cur * XCH + wave;
        XRaw Ra, Rb;
        expert_load(p, it0, lane, Ra);
#pragma unroll 1
        for (int j = 0; j < XCH / NW; j += 2) {
            expert_load(p, it0 + (j + 1) * NW, lane, Rb);
            expert_finish(p, scr, it0 + j * NW, lane, Ra);
            if (j + 2 < XCH / NW) expert_load(p, it0 + (j + 2) * NW, lane, Ra);
            expert_finish(p, scr, it0 + (j + 1) * NW, lane, Rb);
        }
        __syncthreads();
        if (threadIdx.x == 0) misc[8] = nxt;
        __syncthreads();
        cur = misc[8];
    }
}

constexpr int N_PHASES = 17;
__global__ void __launch_bounds__(NT) mega(Params p) {
    extern __shared__ __attribute__((aligned(16))) unsigned char lds_raw[];
    LAS unsigned char* lds = (LAS unsigned char*)lds_raw;
    cg::grid_group grid = cg::this_grid();
    unsigned char* ws = p.ws;
    const int G = gridDim.x;
    const int lo = p.ph_lo, hi = p.ph_hi;
    volatile LAS unsigned* misc = (volatile LAS unsigned*)(lds + LDS_BYTES - 64);
    if (threadIdx.x < 16) misc[threadIdx.x] = 0u;
    __syncthreads();
    XcdBarrier bar; bar.bar = (unsigned*)(ws + OFF_BAR); bar.x = 0; bar.st = nullptr;
    if (hi - lo > 1) bar = xcd_barrier_post((unsigned*)(ws + OFF_BAR), misc);
#ifndef PHMASK
#define PHMASK 0xFFFFFFFFu
#endif
#define IN(k) (((PHMASK >> (k)) & 1) && lo <= (k) && (k) < hi)
#define SEAM(k) do { if (IN(k) && IN((k) + 1)) { if ((k) == 0 && G != 256) grid.sync(); else xcd_barrier(bar); } } while (0)
#ifndef PROBE_PH
#define PROBE_PH (-1)
#endif
#define RUNPH(k, ...) do { if (IN(k)) { __VA_ARGS__; if (PROBE_PH == (k)) { xcd_barrier(bar); __VA_ARGS__; } } } while (0)
    RUNPH(0, phase_prep(p, lds));
    SEAM(0);
    RUNPH(1, phase_norm1(p));
    SEAM(1);
    RUNPH(2, { pg8::Gemm g{(const bf16*)(ws + OFF_XN1), (const bf16*)(ws + OFF_WIN), NROW, UC, D_}; pg8::StaticOrder S; S.init(NROW, UC, G, blockIdx.x);
                 EpiU E{(bf16*)(ws + OFF_U), UC}; pg8::gemm_phase<EpiU, pg8::StaticOrder, true, true>(lds, g, S, E); });
    SEAM(2);
    RUNPH(3, phase_qk(p));
    RUNPH(4, {
        constexpr int NTILE = 128 + 2048;
        RpRaw RR; int t = blockIdx.x;
        if (t < NTILE) rp_load(p, t, RR);
        for (; t < NTILE; t += G) rwkv_prep_tile(p, lds, t, RR, t + G < NTILE ? t + G : t);
    });
    SEAM(4);
    RUNPH(5, {
        unsigned* mdone = (unsigned*)(ws + OFF_BAR) + 3520; unsigned* xctr = mdone + 64;
        if (G == 256) {
            if (blockIdx.x < 128) rwkv_chunk_item(p, lds, blockIdx.x);
            else { mlstm_item(p, lds, blockIdx.x - 128); __syncthreads(); if (threadIdx.x == 0) { __threadfence(); xb_add(mdone, 1u); } }
            if (threadIdx.x == 0) { while (xb_ld(mdone) < 128u) __builtin_amdgcn_s_sleep(8); }
            __syncthreads();
        } else {
            for (int it = blockIdx.x; it < 128; it += G) mlstm_item(p, lds, it);
            __syncthreads();
            for (int it = blockIdx.x; it < 128; it += G) rwkv_chunk_item(p, lds, it);
            xcd_barrier(bar);
        }
        phase_expert_dynamic(p, lds, misc, xctr);
    });
    SEAM(5);
    RUNPH(6, phase_combine(p));
    SEAM(6);
    RUNPH(7, { pg8::Gemm g{(const bf16*)(ws + OFF_MIX), (const bf16*)(ws + OFF_WOUT), NLAT, D_, D_}; pg8::StaticOrder S; S.init(NLAT, D_, G, blockIdx.x);
                 EpiH E{p.in[0], (const float*)(ws + OFF_MOD), p.out}; pg8::gemm_phase<EpiH, pg8::StaticOrder, true, true>(lds, g, S, E); });
    SEAM(7);
    RUNPH(9, phase_norm2(p, lds));
    SEAM(9);
    RUNPH(10, phase_topk(p, lds));
    SEAM(10);
#pragma unroll 1
    for (int gi = 0; gi < NG; ++gi) {
        RUNPH(12 + 2 * gi, {
            pg8::Gemm g{(const bf16*)(ws + OFF_XN2), (const bf16*)(ws + OFF_W13 + (size_t)gi * EG * 5632 * D_), EG * 4096, EG * 5632, D_ / 2, 0x7A7A7A7A, 0x7F7F7F7F, (const int*)(ws + OFF_IDX) + (size_t)gi * EG * 4096};
            ExpertOrder S{22, G, (int)blockIdx.x}; EpiHid E{ws + OFF_HID, 22};
            pg8::gemm_phase<EpiHid, ExpertOrder, true, true, true, true>(lds, g, S, E); });
        SEAM(12 + 2 * gi);
        RUNPH(13 + 2 * gi, {
            pg8::Gemm g{(const bf16*)(ws + OFF_HID), (const bf16*)(ws + OFF_W2 + (size_t)gi * EG * D_ * DE), EG * 4096, EG * D_, DE / 2, 0x79797979, 0x7C7C7C7C};
            ExpertOrder S{4, G, (int)blockIdx.x}; EpiYs E{(bf16*)(ws + OFF_YS) + (size_t)gi * EG * 4096 * D_, (const float*)(ws + OFF_GATE) + (size_t)gi * EG * 4096, 4};
            pg8::gemm_phase<EpiYs, ExpertOrder, true, true, true>(lds, g, S, E); });
        SEAM(13 + 2 * gi);
    }
    if (IN(16)) phase_final(p);
}
}

#ifndef MK_SPLIT
#define MK_SPLIT 0
#endif
extern "C" void kernel_launch(void* const* d_in, const int* in_sizes, int n_in, void* d_out, int out_size, void* d_ws, size_t ws_size, hipStream_t stream) {
    static int grid = 0;
    if (grid == 0) {
        int dev = 0, cus = 0, per_cu = 0;
        (void)hipGetDevice(&dev);
        (void)hipDeviceGetAttribute(&cus, hipDeviceAttributeMultiprocessorCount, dev);
        (void)hipFuncSetAttribute((const void*)mega, hipFuncAttributeMaxDynamicSharedMemorySize, LDS_BYTES);
        (void)hipOccupancyMaxActiveBlocksPerMultiprocessor(&per_cu, (const void*)mega, NT, LDS_BYTES);
        if (per_cu < 1) { fprintf(stderr, "kernel_launch: occupancy query reports %d blocks per CU\n", per_cu); per_cu = 1; }
        grid = cus * 1;
        if (ws_size < WS_END) { fprintf(stderr, "kernel_launch: workspace too small (%zu < %zu)\n", ws_size, (size_t)WS_END); grid = -1; }
    }
    if (grid < 0) return;
    if (hipMemsetAsync((char*)d_ws + OFF_BAR, 0, 16384, stream) != hipSuccess) { fprintf(stderr, "kernel_launch: memset of the barrier words failed\n"); return; }
    Params p{};
    for (int i = 0; i < 30; ++i) p.in[i] = (const float*)d_in[i];
    p.out = (float*)d_out; p.ws = (unsigned char*)d_ws;
#if MK_SPLIT
    for (int ph = 0; ph < N_PHASES; ++ph) { p.ph_lo = ph; p.ph_hi = ph + 1; hipLaunchKernelGGL(mega, dim3(grid), dim3(NT), LDS_BYTES, stream, p); }
#else
    p.ph_lo = 0; p.ph_hi = N_PHASES;
    void* args[] = {&p};
    hipError_t e = hipLaunchCooperativeKernel((const void*)mega, dim3(grid), dim3(NT), args, LDS_BYTES, stream);
    if (e != hipSuccess) fprintf(stderr, "cooperative launch failed: %s (grid %d)\n", hipGetErrorString(e), grid);
#endif
}
```

```cpp
#include <hip/hip_runtime.h>
#include <hip/hip_cooperative_groups.h>
#include <stdint.h>
#include <cstdio>
namespace cg = cooperative_groups;

namespace pg8 {
#define PG8_LAS __attribute__((address_space(3)))
typedef unsigned short bf16_t;
typedef short bf16x8 __attribute__((ext_vector_type(8)));
typedef float f32x4 __attribute__((ext_vector_type(4)));
typedef unsigned u32x4 __attribute__((ext_vector_type(4)));
constexpr int BM = 256, BK = 64, HALF = 128, HTB = HALF * BK * 2  , STAGE_BYTES = 8 * HTB, NXCD = 8, WGM = 8;

__host__ __device__ __forceinline__ int lds_byte(int r, int c) { const int st = (r >> 4) * 2 + (c >> 5), rr = r & 15, cc = c & 31, ob = rr * 64 + cc * 2; return st * 1024 + (ob ^ (((ob >> 9) & 1) << 5)); }
__host__ __device__ __forceinline__ void stage_rc(int b, int& R, int& C) { const int st = b / 1024, sb = b % 1024, swz = sb ^ (((sb >> 9) & 1) << 5); R = (st >> 1) * 16 + swz / 64; C = (st & 1) * 32 + (swz % 64) / 2; }
__host__ __device__ __forceinline__ int perm32(int rho) { const int n = rho >> 4, i = rho & 15; return 8 * (i >> 2) + 4 * n + (i & 3); }

struct Unit { int pm, pn; };
struct Gemm { const bf16_t* A; const bf16_t* Bt; int M, N, K; int sa, sb; const int* gidx; };
typedef int i32x8 __attribute__((ext_vector_type(8)));
typedef int i32x4v __attribute__((ext_vector_type(4)));
__device__ __forceinline__ i32x8 cat8(bf16x8 a, bf16x8 b) { const i32x4v x = __builtin_bit_cast(i32x4v, a), y = __builtin_bit_cast(i32x4v, b); return __builtin_shufflevector(x, y, 0, 1, 2, 3, 4, 5, 6, 7); }

struct StaticOrder {
    int nM, nN, nwg, G, c;
    __host__ __device__ void init(int M, int N, int G_, int c_) { nM = M / BM; nN = N / BM; nwg = nM * nN; G = G_; c = c_; }
    __host__ __device__ bool next(int i, Unit& u) const {
        const long L = (long)i * G + c; if (L >= nwg) return false;
        int wgid = (int)L; { const int q = nwg / NXCD, r = nwg % NXCD, xcd = wgid % NXCD, off = wgid / NXCD; wgid = (xcd < r ? xcd * (q + 1) : r * (q + 1) + (xcd - r) * q) + off; }
        const int nig = WGM * nN, gid = wgid / nig, fm = gid * WGM, gsz = (nM - fm) < WGM ? (nM - fm) : WGM;
        u.pm = fm + ((wgid % nig) % gsz); u.pn = (wgid % nig) / gsz; return true;
    }
    __device__ __forceinline__ void a_ready(const Unit&) const {}
    __device__ __forceinline__ void done(const Unit&) const {}
};


template <class Epi, class Sched, bool ALIGN_EPI = false, bool SP2 = false, bool F8 = false, bool GATHER = false>
__device__ __forceinline__ void gemm_phase(PG8_LAS unsigned char* lds, const Gemm g, const Sched& S, const Epi& E) {
    const int tid = threadIdx.x, wid = __builtin_amdgcn_readfirstlane(tid >> 6), lane = tid & 63, wr = wid >> 2, wc = wid & 3, fr = lane & 15, fq = lane >> 4;
    const int K = g.K, nt = K / BK;
    unsigned voffA[2], voffB[2]; int gR[2]; unsigned gC[2];
#pragma unroll
    for (int i = 0; i < 2; ++i) { int R, C; stage_rc(tid * 16 + i * 8192, R, C); const int Rb = Epi::PERM ? ((R & ~31) + perm32(R & 31)) : R;
        voffA[i] = (unsigned)(R * K + C) * 2u; voffB[i] = (unsigned)(Rb * K + C) * 2u; gR[i] = R; gC[i] = (unsigned)C * 2u; }
    unsigned cG[2][2], nG[2][2];
#define PG8_GOFF(dst, pm_) do { _Pragma("unroll") for (int _h = 0; _h < 2; ++_h) _Pragma("unroll") for (int _i = 0; _i < 2; ++_i) dst[_h][_i] = (unsigned)g.gidx[(pm_) * BM + _h * HALF + gR[_i]] * (unsigned)(K * 2) + gC[_i]; } while (0)
    const size_t kstep = (size_t)(BK * 2);
    const size_t hstep = (size_t)HALF * K * 2;
    const size_t tstep = 2 * hstep;
    const unsigned ldsw = (unsigned)wid * 1024u;
    const int aoff = lds_byte(wr * 64 + fr, fq * 8), boff = lds_byte(wc * 32 + fr, fq * 8);
#define PG8_SA(b, h) (((b) * 2 + (h)) * HTB)
#define PG8_SB(b, h) ((4 + (b) * 2 + (h)) * HTB)
#define PG8_STAGE(bufoff, gbase, voff) do { _Pragma("unroll") for (int _i = 0; _i < 2; ++_i) \
        __builtin_amdgcn_global_load_lds((const unsigned*)((const char*)(gbase) + (voff)[_i]), (PG8_LAS unsigned*)(lds + (bufoff) + ldsw + _i * 8192), 16, 0, 0); } while (0)
#define PG8_STAGE_A(bufoff, abase, half, nx) do { if constexpr (GATHER) { _Pragma("unroll") for (int _i = 0; _i < 2; ++_i) { const unsigned _o = (nx) ? nG[half][_i] : cG[half][_i]; \
        __builtin_amdgcn_global_load_lds((const unsigned*)((const char*)(abase) + _o), (PG8_LAS unsigned*)(lds + (bufoff) + ldsw + _i * 8192), 16, 0, 0); } } \
        else PG8_STAGE(bufoff, (abase) + (half) * hstep, voffA); } while (0)
#define PG8_LDA(dst, b, h) do { _Pragma("unroll") for (int m = 0; m < 4; ++m) { if constexpr (F8) { dst##8[m].lo = *(const PG8_LAS i32x4v*)(lds + PG8_SA(b, h) + aoff + m * 2048); dst##8[m].hi = *(const PG8_LAS i32x4v*)(lds + PG8_SA(b, h) + aoff + m * 2048 + 1024); } \
        else { _Pragma("unroll") for (int k = 0; k < 2; ++k) dst[m][k] = *(const PG8_LAS bf16x8*)(lds + PG8_SA(b, h) + aoff + m * 2048 + k * 1024); } } } while (0)
#define PG8_LDB(dst, b, h) do { _Pragma("unroll") for (int n = 0; n < 2; ++n) { if constexpr (F8) { dst##8[n].lo = *(const PG8_LAS i32x4v*)(lds + PG8_SB(b, h) + boff + n * 2048); dst##8[n].hi = *(const PG8_LAS i32x4v*)(lds + PG8_SB(b, h) + boff + n * 2048 + 1024); } \
        else { _Pragma("unroll") for (int k = 0; k < 2; ++k) dst[n][k] = *(const PG8_LAS bf16x8*)(lds + PG8_SB(b, h) + boff + n * 2048 + k * 1024); } } } while (0)
#define PG8_MMA(ai, bj, At, Bt) do { __builtin_amdgcn_s_setprio(1); _Pragma("unroll") for (int m = 0; m < 4; ++m) _Pragma("unroll") for (int n = 0; n < 2; ++n) { \
        if constexpr (F8) asm volatile("v_mfma_scale_f32_16x16x128_f8f6f4 %0, %1, %2, %0, %3, %4 op_sel_hi:[0,0,0]" : "+v"(acc[ai][bj][m][n]) : "v"(Bt##8[n]), "v"(At##8[m]), "v"(f8sa), "v"(f8sb)); \
        else { _Pragma("unroll") for (int k = 0; k < 2; ++k) acc[ai][bj][m][n] = __builtin_amdgcn_mfma_f32_16x16x32_bf16(Bt[n][k], At[m][k], acc[ai][bj][m][n], 0, 0, 0); } } \
        __builtin_amdgcn_s_setprio(0); } while (0)
#define PG8_WAIT_V(n) asm volatile("s_waitcnt vmcnt(" #n ")" ::: "memory")
#define PG8_WAIT_L(n) asm volatile("s_waitcnt lgkmcnt(" #n ")" ::: "memory")
#define PG8_BAR __builtin_amdgcn_s_barrier()
#define PG8_SCHED __builtin_amdgcn_sched_barrier(0)
    Unit cur, nxt; int ui = 0;
    if (!S.next(0, cur)) return;
    f32x4 acc[2][2][4][2];
#pragma unroll
    for (int a = 0; a < 2; ++a)
#pragma unroll
        for (int b = 0; b < 2; ++b)
#pragma unroll
            for (int m = 0; m < 4; ++m)
#pragma unroll
                for (int n = 0; n < 2; ++n) acc[a][b][m][n] = (f32x4){0.f, 0.f, 0.f, 0.f};
    bf16x8 At[4][2], B0[2][2], B1[2][2];
    i32x8 At8[4], B08[2], B18[2];
    const int f8sa = g.sa, f8sb = g.sb;
    const char* cA = (const char*)g.A + (GATHER ? (size_t)0 : (size_t)cur.pm * tstep); const char* cB = (const char*)g.Bt + (size_t)cur.pn * tstep;
    if constexpr (GATHER) { PG8_GOFF(cG, cur.pm); }
    S.a_ready(cur);
    if constexpr (SP2) {
        PG8_STAGE(PG8_SB(0, 0), cB, voffB); PG8_STAGE(PG8_SB(0, 1), cB + hstep, voffB); PG8_STAGE_A(PG8_SA(0, 0), cA, 0, false); PG8_STAGE_A(PG8_SA(0, 1), cA, 1, false);
        if (wr == 1) PG8_BAR;
        PG8_WAIT_V(2); PG8_BAR;
        PG8_STAGE(PG8_SB(1, 0), cB + kstep, voffB); PG8_STAGE_A(PG8_SA(1, 0), cA + kstep, 0, false); PG8_STAGE(PG8_SB(1, 1), cB + hstep + kstep, voffB);
        PG8_WAIT_V(6); PG8_BAR;
    } else {
        PG8_STAGE(PG8_SB(0, 0), cB, voffB); PG8_STAGE_A(PG8_SA(0, 0), cA, 0, false); PG8_STAGE(PG8_SB(0, 1), cB + hstep, voffB); PG8_STAGE_A(PG8_SA(0, 1), cA, 1, false);
        if (wr == 1) PG8_BAR;
        PG8_WAIT_V(4); PG8_BAR;
        PG8_STAGE(PG8_SB(1, 0), cB + kstep, voffB); PG8_STAGE_A(PG8_SA(1, 0), cA + kstep, 0, false); PG8_STAGE(PG8_SB(1, 1), cB + hstep + kstep, voffB);
        PG8_WAIT_V(6); PG8_BAR;
    }
    for (;;) {
        const bool has_next = S.next(ui + 1, nxt);
        if constexpr (GATHER) { if (has_next) { PG8_GOFF(nG, nxt.pm); } else { _Pragma("unroll") for (int _h = 0; _h < 2; ++_h) _Pragma("unroll") for (int _i = 0; _i < 2; ++_i) nG[_h][_i] = cG[_h][_i]; } }
        const char* nA = (has_next && !GATHER) ? (const char*)g.A + (size_t)nxt.pm * tstep : cA; const char* nB = has_next ? (const char*)g.Bt + (size_t)nxt.pn * tstep : cB;
        for (int t = 0; t < nt; t += 2) {
            const bool last = (t == nt - 2);
            const char* a1 = cA + (size_t)(t + 1) * kstep;
            const char* a2 = last ? nA : cA + (size_t)(t + 2) * kstep; const char* b2 = last ? nB : cB + (size_t)(t + 2) * kstep;
            const char* a3 = a2 + kstep; const char* b3 = b2 + kstep;
            if (last && has_next) S.a_ready(nxt);
            if constexpr (SP2) {
            PG8_LDB(B0, 0, 0); PG8_LDB(B1, 0, 1); PG8_SCHED; PG8_LDA(At, 0, 0); PG8_STAGE_A(PG8_SA(1, 1), a1, 1, false);
            PG8_WAIT_V(8); PG8_WAIT_L(0); PG8_BAR; PG8_MMA(0, 0, At, B0); PG8_MMA(0, 1, At, B1); PG8_BAR; PG8_SCHED;
            PG8_LDA(At, 0, 1); PG8_STAGE(PG8_SB(0, 0), b2, voffB); PG8_STAGE(PG8_SB(0, 1), b2 + hstep, voffB); PG8_STAGE_A(PG8_SA(0, 0), a2, 0, last);
            PG8_WAIT_V(8); PG8_WAIT_L(0); PG8_BAR; PG8_MMA(1, 0, At, B0); PG8_MMA(1, 1, At, B1); PG8_BAR; PG8_SCHED;
            PG8_LDB(B0, 1, 0); PG8_LDB(B1, 1, 1); PG8_SCHED; PG8_LDA(At, 1, 0); PG8_STAGE_A(PG8_SA(0, 1), a2, 1, last);
            PG8_WAIT_V(8); PG8_WAIT_L(0); PG8_BAR; PG8_MMA(0, 0, At, B0); PG8_MMA(0, 1, At, B1); PG8_BAR; PG8_SCHED;
            PG8_LDA(At, 1, 1); PG8_STAGE(PG8_SB(1, 0), b3, voffB); PG8_STAGE(PG8_SB(1, 1), b3 + hstep, voffB); PG8_STAGE_A(PG8_SA(1, 0), a3, 0, last);
            PG8_WAIT_V(8); PG8_WAIT_L(0); PG8_BAR; PG8_MMA(1, 0, At, B0); PG8_MMA(1, 1, At, B1); PG8_BAR; PG8_SCHED;
            } else {
            PG8_LDB(B0, 0, 0); PG8_SCHED; PG8_LDA(At, 0, 0); PG8_STAGE_A(PG8_SA(1, 1), a1, 1, false);
            PG8_WAIT_L(8); PG8_BAR; PG8_WAIT_L(0); PG8_MMA(0, 0, At, B0); PG8_BAR; PG8_SCHED;
            PG8_LDB(B1, 0, 1); PG8_STAGE(PG8_SB(0, 0), b2, voffB);
            PG8_BAR; PG8_WAIT_L(0); PG8_MMA(0, 1, At, B1); PG8_BAR;
            PG8_LDA(At, 0, 1); PG8_STAGE_A(PG8_SA(0, 0), a2, 0, last);
            PG8_BAR; PG8_WAIT_L(0); PG8_MMA(1, 0, At, B0); PG8_BAR; PG8_SCHED;
            PG8_STAGE(PG8_SB(0, 1), b2 + hstep, voffB);
            PG8_WAIT_V(6); PG8_BAR; PG8_MMA(1, 1, At, B1); PG8_BAR;
            PG8_LDB(B0, 1, 0); PG8_SCHED; PG8_LDA(At, 1, 0); PG8_STAGE_A(PG8_SA(0, 1), a2, 1, last);
            PG8_WAIT_L(8); PG8_BAR; PG8_WAIT_L(0); PG8_MMA(0, 0, At, B0); PG8_BAR; PG8_SCHED;
            PG8_LDB(B1, 1, 1); PG8_STAGE(PG8_SB(1, 0), b3, voffB);
            PG8_BAR; PG8_WAIT_L(0); PG8_MMA(0, 1, At, B1); PG8_BAR;
            PG8_LDA(At, 1, 1); PG8_STAGE_A(PG8_SA(1, 0), a3, 0, last);
            PG8_BAR; PG8_WAIT_L(0); PG8_MMA(1, 0, At, B0); PG8_BAR; PG8_SCHED;
            PG8_STAGE(PG8_SB(1, 1), b3 + hstep, voffB);
            PG8_WAIT_V(6); PG8_BAR; PG8_MMA(1, 1, At, B1); PG8_BAR;
            }
        }
        if constexpr (ALIGN_EPI) { if (wr == 0) PG8_BAR; }
        if constexpr (!Epi::AFTER_DRAIN) { E(acc, cur, wr, wc, fr, fq); S.done(cur); }
        if (!has_next) break;
#pragma unroll
        for (int a = 0; a < 2; ++a)
#pragma unroll
            for (int b = 0; b < 2; ++b)
#pragma unroll
                for (int m = 0; m < 4; ++m)
#pragma unroll
                    for (int n = 0; n < 2; ++n) acc[a][b][m][n] = (f32x4){0.f, 0.f, 0.f, 0.f};
        cur = nxt; cA = nA; cB = nB; ++ui;
        if constexpr (GATHER) { _Pragma("unroll") for (int _h = 0; _h < 2; ++_h) _Pragma("unroll") for (int _i = 0; _i < 2; ++_i) cG[_h][_i] = nG[_h][_i]; }
        if constexpr (ALIGN_EPI) { if (wr == 1) PG8_BAR; }
    }
    PG8_WAIT_V(0);
    if constexpr (!ALIGN_EPI) { if (wr == 0) PG8_BAR; }
    PG8_BAR;
    if constexpr (Epi::AFTER_DRAIN) { E.fused(acc, cur, wr, wc, fr, fq, lds, wid, lane); S.done(cur); }
#undef PG8_SA
#undef PG8_SB
#undef PG8_STAGE
#undef PG8_STAGE_A
#undef PG8_GOFF
#undef PG8_LDA
#undef PG8_LDB
#undef PG8_MMA
#undef PG8_WAIT_V
#undef PG8_WAIT_L
#undef PG8_BAR
#undef PG8_SCHED
}

}

namespace {
#define LAS __attribute__((address_space(3)))
typedef unsigned short bf16;
typedef float f32x4 __attribute__((ext_vector_type(4)));
typedef unsigned u32x4 __attribute__((ext_vector_type(4)));
typedef unsigned u32x2 __attribute__((ext_vector_type(2)));
constexpr int NT = 512, NW = 8;
constexpr int B_ = 8, T_ = 4096, TC_ = 256, D_ = 1024;
constexpr int NCTX = B_ * TC_, NLAT = B_ * T_, NROW = NCTX + NLAT;
constexpr int PIN = 4016, UC = 4096, MLC = 2064;
constexpr int E_ = 16, CAP = 512, DE = 2816, EG = 16  , NG = E_ / EG;
constexpr int MOD6 = 6 * D_;
constexpr int LDS_BYTES = 152 * 1024;
constexpr size_t MiB = 1024 * 1024;
constexpr size_t OFF_MOD = 0, OFF_LORA = 256 * 1024, OFF_AFF = 1 * MiB, OFF_IDX = 3 * MiB, OFF_GATE = 3 * MiB + 512 * 1024, OFF_SEL = 4 * MiB, OFF_BON = 6 * MiB, OFF_INVN = 8 * MiB, OFF_BAR = 10 * MiB;
constexpr size_t OFF_WIN = 12 * MiB, OFF_WOUT = 20 * MiB;
constexpr size_t OFF_XN1 = 22 * MiB, OFF_U = 90 * MiB, OFF_RWP = 362 * MiB, OFF_G = 600 * MiB, OFF_MIX = 632 * MiB, OFF_ZOX = 696 * MiB, WS_END = 702 * MiB;
constexpr int ZOX_ROWS = 6144;
constexpr size_t OFF_W13 = 22 * MiB, OFF_W2 = 110 * MiB, OFF_XN2 = 154 * MiB, OFF_XS = 186 * MiB, OFF_HID = 250 * MiB, OFF_YS = 426 * MiB;
static_assert(OFF_HID + (size_t)EG * 4096 * DE <= OFF_YS && OFF_YS + (size_t)65536 * D_ * 2 <= OFF_MIX && OFF_W13 + (size_t)E_ * 5632 * D_ <= OFF_W2 && OFF_W2 + (size_t)E_ * D_ * DE <= OFF_XN2 && OFF_XN2 + (size_t)NLAT * D_ <= OFF_XS && OFF_XS + (size_t)65536 * D_ <= OFF_HID && OFF_RWP + (size_t)NROW * 3584 * 2 <= OFF_G, "ws map");

struct Params { const float* in[30]; float* out; unsigned char* ws; int ph_lo, ph_hi; };

__device__ __forceinline__ float bf2f(bf16 v) { return __uint_as_float(((unsigned)v) << 16); }
typedef __bf16 bf16x2_t __attribute__((ext_vector_type(2)));
typedef float f32x2_t __attribute__((ext_vector_type(2)));
__device__ __forceinline__ unsigned pk2(float lo, float hi) { const bf16x2_t h2 = __builtin_convertvector((f32x2_t){lo, hi}, bf16x2_t); return __builtin_bit_cast(unsigned, h2); }
__device__ __forceinline__ unsigned f2bf(float f) { return pk2(f, 0.f) & 0xffffu; }
__device__ __forceinline__ float sigmoidf_(float x) { return 1.f / (1.f + __expf(-x)); }
__device__ __forceinline__ float siluf_(float x) { return x / (1.f + __expf(-x)); }
__device__ __forceinline__ float softplusf_(float x) { return fmaxf(x, 0.f) + log1pf(__expf(-fabsf(x))); }
__device__ __forceinline__ float wave_sum(float v) {
#pragma unroll
    for (int o = 1; o < 64; o <<= 1) v += __shfl_xor(v, o);
    return v;
}

__device__ __forceinline__ unsigned pk4_f8(float a, float b, float c, float d) {
    a = fminf(fmaxf(a, -448.f), 448.f); b = fminf(fmaxf(b, -448.f), 448.f); c = fminf(fmaxf(c, -448.f), 448.f); d = fminf(fmaxf(d, -448.f), 448.f);
    int r = __builtin_amdgcn_cvt_pk_fp8_f32(a, b, 0, false); r = __builtin_amdgcn_cvt_pk_fp8_f32(c, d, r, true); return (unsigned)r; }
__device__ __forceinline__ void transpose_item(const float* W, int N, int Nvalid, bf16* WT, int ldt, long row_off, LAS float* scr, int kb, int nb, int lane) {
    const int k0 = 64 * kb, n0 = 32 * nb;
    const bool ok = (n0 + (lane & 31)) < Nvalid;
#pragma unroll 8
    for (int i = 0; i < 32; ++i) { const int kk = 2 * i + (lane >> 5); scr[kk * 33 + (lane & 31)] = ok ? W[(size_t)(k0 + kk) * N + n0 + (lane & 31)] : 0.f; }
    asm volatile("s_waitcnt lgkmcnt(0)" ::: "memory");
    const int c = lane & 7;
#pragma unroll
    for (int j = 0; j < 4; ++j) { const int n = (lane >> 3) + 8 * j; const LAS float* s = scr + (8 * c) * 33 + n;
        u32x4 o; o.x = pk2(s[0 * 33], s[1 * 33]); o.y = pk2(s[2 * 33], s[3 * 33]); o.z = pk2(s[4 * 33], s[5 * 33]); o.w = pk2(s[6 * 33], s[7 * 33]);
        *(u32x4*)(WT + (size_t)(row_off + n0 + n) * ldt + k0 + 8 * c) = o; }
    asm volatile("s_waitcnt lgkmcnt(0)" ::: "memory");
}
struct XRaw { f32x4 v[8]; };
__device__ __forceinline__ void transpose_load_f8(const float* W, int N, int kb, int nb, int lane, XRaw& R) {
    const float* src = W + (size_t)(64 * kb + (lane >> 3)) * N + 32 * nb + (lane & 7) * 4;
#pragma unroll
    for (int i = 0; i < 8; ++i) R.v[i] = __builtin_nontemporal_load((const f32x4*)(src + (size_t)(8 * i) * N));
}
__device__ __forceinline__ void transpose_finish_f8(const XRaw& R, unsigned char* WT8, int ldt, long row_off, LAS float* scr, int kb, int nb, int lane, float scl) {
    const int k0 = 64 * kb, n0 = 32 * nb;
#pragma unroll
    for (int i = 0; i < 8; ++i) { LAS float* d = scr + (8 * i + (lane >> 3)) * 33 + (lane & 7) * 4; d[0] = R.v[i].x; d[1] = R.v[i].y; d[2] = R.v[i].z; d[3] = R.v[i].w; }
    asm volatile("s_waitcnt lgkmcnt(0)" ::: "memory");
    const int c = lane & 7;
#pragma unroll
    for (int j = 0; j < 4; ++j) { const int n = (lane >> 3) + 8 * j; const LAS float* s = scr + (8 * c) * 33 + n;
        u32x2 o; o.x = pk4_f8(s[0 * 33] * scl, s[1 * 33] * scl, s[2 * 33] * scl, s[3 * 33] * scl); o.y = pk4_f8(s[4 * 33] * scl, s[5 * 33] * scl, s[6 * 33] * scl, s[7 * 33] * scl);
        *(u32x2*)(WT8 + (size_t)(row_off + n0 + n) * ldt + k0 + 8 * c) = o; }
    asm volatile("s_waitcnt lgkmcnt(0)" ::: "memory");
}
__device__ __forceinline__ void phase_prep(const Params& p, LAS unsigned char* lds) {
    const int tid = threadIdx.x, lane = tid & 63, wave = tid >> 6, G = gridDim.x;
    unsigned char* ws = p.ws;
    {
        LAS float* sc = (LAS float*)lds;
        LAS float* red = sc + 9 * D_;
        const float* c = p.in[1]; const float* c_ctx = p.in[3]; const float* mod_w = p.in[4]; const float* mod_b = p.in[5];
        float* mod = (float*)(ws + OFF_MOD);
        bool staged = false;
        for (int item = blockIdx.x; item < MOD6 / 32; item += G) {
            if (!staged) { for (int i = tid; i < 9 * D_; i += NT) { const int r = i / D_, k = i % D_; sc[i] = siluf_(r < 8 ? c[r * D_ + k] : c_ctx[k]); } staged = true; }
            __syncthreads();
            const int kg = tid >> 5, cl = tid & 31, col = item * 32 + cl;
            float acc[9];
#pragma unroll
            for (int r = 0; r < 9; ++r) acc[r] = 0.f;
            for (int k = kg * 64; k < kg * 64 + 64; ++k) { const float w = mod_w[(size_t)k * MOD6 + col];
#pragma unroll
                for (int r = 0; r < 9; ++r) acc[r] += sc[r * D_ + k] * w; }
#pragma unroll
            for (int r = 0; r < 9; ++r) red[(kg * 9 + r) * 32 + cl] = acc[r];
            __syncthreads();
            if (tid < 32) {
#pragma unroll
                for (int r = 0; r < 9; ++r) { float s = 0.f; for (int g = 0; g < 16; ++g) s += red[(g * 9 + r) * 32 + tid]; mod[r * MOD6 + item * 32 + tid] = s + mod_b[item * 32 + tid]; }
            }
        }
        __syncthreads();
    }
    LAS float* scr = (LAS float*)(lds + wave * 16384);
    const int gw = blockIdx.x * NW + wave, NGW = G * NW;
    constexpr int I_IN = 16 * 128, I_OUT = 16 * 32;
    for (int it = gw; it < I_IN + I_OUT; it += NGW) {
        if (it < I_IN) transpose_item(p.in[7], PIN, PIN, (bf16*)(ws + OFF_WIN), D_, 0, scr, it / 128, it % 128, lane);
        else { const int r = it - I_IN; transpose_item(p.in[23], D_, D_, (bf16*)(ws + OFF_WOUT), D_, 0, scr, r / 32, r % 32, lane); }
    }
    {
        bf16* LT = (bf16*)(ws + OFF_LORA);
        const float* w_up = p.in[14]; const float* a_up = p.in[16]; const float* g_up = p.in[17];
        for (int i = blockIdx.x * NT + tid; i < 212992; i += G * NT) {
            float v;
            if (i < 131072) { const int j = i & 65535, d = j >> 15, c = (j >> 6) & 511, r = j & 63; v = (i < 65536 ? w_up : a_up)[(d * 64 + r) * 512 + c]; }
            else { const int j = i - 131072, c = j / 160, r = j % 160; v = g_up[r * 512 + c]; }
            LT[i] = (bf16)f2bf(v);
        }
    }
}
constexpr int EXP_ITEMS = E_ * (2 * 16 * 88 + 44 * 32);
__device__ __forceinline__ void expert_load(const Params& p, int it, int lane, XRaw& R) {
    constexpr int I_E13 = 16 * 88, I_E2 = 44 * 32;
    const int e = it / (2 * I_E13 + I_E2); int r = it % (2 * I_E13 + I_E2);
    if (r < 2 * I_E13) { const int which = r / I_E13; r %= I_E13; transpose_load_f8((which ? p.in[27] : p.in[26]) + (size_t)e * D_ * DE, DE, r / 88, r % 88, lane, R); }
    else { r -= 2 * I_E13; transpose_load_f8(p.in[28] + (size_t)e * DE * D_, D_, r / 32, r % 32, lane, R); }
}
__device__ __forceinline__ void expert_finish(const Params& p, LAS float* scr, int it, int lane, const XRaw& R) {
    constexpr int I_E13 = 16 * 88, I_E2 = 44 * 32;
    unsigned char* ws = p.ws;
    const int e = it / (2 * I_E13 + I_E2); int r = it % (2 * I_E13 + I_E2);
    if (r < 2 * I_E13) {
        const int which = r / I_E13; r %= I_E13; const int kb = r / 88, nb = r % 88, n0 = nb * 32;
        const long row_off = (long)e * 5632 + (n0 / 128) * 256 + (n0 % 128) + which * 128 - n0;
        transpose_finish_f8(R, ws + OFF_W13, D_, row_off, scr, kb, nb, lane, 32.f);
    } else {
        r -= 2 * I_E13;
        transpose_finish_f8(R, ws + OFF_W2, DE, (long)e * D_, scr, r / 32, r % 32, lane, 64.f);
    }
}
__device__ __forceinline__ void expert_item(const Params& p, LAS float* scr, int it, int lane) { XRaw R; expert_load(p, it, lane, R); expert_finish(p, scr, it, lane, R); }
__device__ __forceinline__ void phase_expert_prep(const Params& p, LAS unsigned char* lds) {
    const int tid = threadIdx.x, lane = tid & 63, wave = tid >> 6, G = gridDim.x;
    LAS float* scr = (LAS float*)(lds + wave * 16384);
    const int gw = blockIdx.x * NW + wave, NGW = G * NW;
    for (int it = gw; it < EXP_ITEMS; it += NGW) expert_item(p, scr, it, lane);
}

__device__ __forceinline__ void phase_norm1(const Params& p) {
    const int lane = threadIdx.x & 63, wave = threadIdx.x >> 6;
    const int gw = blockIdx.x * NW + wave, NGW = gridDim.x * NW;
    const float* g = p.in[6]; const float* mod = (const float*)(p.ws + OFF_MOD);
    bf16* xn = (bf16*)(p.ws + OFF_XN1);
    for (int row = gw; row < NROW; row += NGW) {
        const float* src; int mr;
        if (row < NCTX) { src = p.in[2] + (size_t)row * D_; mr = 8; } else { const int rl = row - NCTX; src = p.in[0] + (size_t)rl * D_; mr = rl / T_; }
        f32x4 v[4]; float s = 0.f;
#pragma unroll
        for (int j = 0; j < 4; ++j) { v[j] = *(const f32x4*)(src + j * 256 + lane * 4); s += (v[j].x * v[j].x + v[j].y * v[j].y) + (v[j].z * v[j].z + v[j].w * v[j].w); }
        const float rstd = rsqrtf(wave_sum(s) * (1.f / D_) + 1e-6f);
        const float* sh = mod + mr * MOD6, *scl = sh + D_;
#pragma unroll
        for (int j = 0; j < 4; ++j) {
            const int d = j * 256 + lane * 4;
            const f32x4 gg = *(const f32x4*)(g + d), ss = *(const f32x4*)(scl + d), hh = *(const f32x4*)(sh + d);
            const f32x4 o = v[j] * rstd * gg * (ss + 1.f) + hh;
            u32x2 w; w.x = pk2(o.x, o.y); w.y = pk2(o.z, o.w);
            *(u32x2*)(xn + (size_t)row * D_ + d) = w;
        }
    }
}

struct EpiU {
    static constexpr bool PERM = true, AFTER_DRAIN = false;
    bf16* C; int ldc;
    __device__ __forceinline__ void operator()(const pg8::f32x4 (&acc)[2][2][4][2], const pg8::Unit& u, int wr, int wc, int fr, int fq) const {
        const int row0 = u.pm * 256 + wr * 64 + fr, col0 = u.pn * 256 + wc * 32 + 8 * fq;
#pragma unroll
        for (int ai = 0; ai < 2; ++ai)
#pragma unroll
            for (int m = 0; m < 4; ++m) { bf16* rowp = C + (size_t)(row0 + ai * 128 + m * 16) * ldc + col0;
#pragma unroll
                for (int bj = 0; bj < 2; ++bj) { const pg8::f32x4 v0 = acc[ai][bj][m][0], v1 = acc[ai][bj][m][1];
                    u32x4 w; w.x = pk2(v0[0], v0[1]); w.y = pk2(v0[2], v0[3]); w.z = pk2(v1[0], v1[1]); w.w = pk2(v1[2], v1[3]);
                    __builtin_nontemporal_store(w, (u32x4*)(rowp + bj * 128)); } }
    }
};
struct EpiH {
    static constexpr bool PERM = false, AFTER_DRAIN = false;
    const float* x; const float* mod; float* h;
    __device__ __forceinline__ void operator()(const pg8::f32x4 (&acc)[2][2][4][2], const pg8::Unit& u, int wr, int wc, int fr, int fq) const {
        const int row0 = u.pm * 256 + wr * 64 + fr, col0 = u.pn * 256 + wc * 32 + 4 * fq;
        const float* g1 = mod + ((u.pm * 256) / T_) * MOD6 + 2 * D_;
#pragma unroll
        for (int ai = 0; ai < 2; ++ai)
#pragma unroll
            for (int m = 0; m < 4; ++m) { const size_t off = (size_t)(row0 + ai * 128 + m * 16) * D_ + col0;
#pragma unroll
                for (int bj = 0; bj < 2; ++bj)
#pragma unroll
                    for (int n = 0; n < 2; ++n) { const int cc = bj * 128 + n * 16; const pg8::f32x4 xv = *(const pg8::f32x4*)(x + off + cc), gv = *(const pg8::f32x4*)(g1 + col0 + cc);
                        *(pg8::f32x4*)(h + off + cc) = xv + gv * acc[ai][bj][m][n]; } }
    }
};
struct EpiHid {
    static constexpr bool PERM = true, AFTER_DRAIN = false;
    unsigned char* hid; int nN;
    __device__ __forceinline__ void operator()(const pg8::f32x4 (&acc)[2][2][4][2], const pg8::Unit& u, int, int, int, int) const {
        int t = threadIdx.x; asm volatile("" : "+v"(t));
        const int wid = t >> 6, wr = wid >> 2, wc = wid & 3, fr = t & 15, fq = (t >> 4) & 3;
        const int row0 = u.pm * 256 + wr * 64 + fr, col0 = (u.pn % nN) * 128 + wc * 32 + 8 * fq;
#pragma unroll
        for (int ai = 0; ai < 2; ++ai)
#pragma unroll
            for (int m = 0; m < 4; ++m) {
                float o[8];
#pragma unroll
                for (int n = 0; n < 2; ++n)
#pragma unroll
                    for (int j = 0; j < 4; ++j) { const float a = acc[ai][0][m][n][j]; o[n * 4 + j] = a * __builtin_amdgcn_rcpf(1.f + __expf(-a)) * acc[ai][1][m][n][j] * 8.f; }
                u32x2 w; w.x = pk4_f8(o[0], o[1], o[2], o[3]); w.y = pk4_f8(o[4], o[5], o[6], o[7]);
                *(u32x2*)(hid + (size_t)(row0 + ai * 128 + m * 16) * DE + col0) = w; }
    }
};
struct EpiYs {
    static constexpr bool PERM = true, AFTER_DRAIN = false;
    bf16* ys; const float* gate; int nN;
    __device__ __forceinline__ void operator()(const pg8::f32x4 (&acc)[2][2][4][2], const pg8::Unit& u, int, int, int, int) const {
        int t = threadIdx.x; asm volatile("" : "+v"(t));
        const int wid = t >> 6, wr = wid >> 2, wc = wid & 3, fr = t & 15, fq = (t >> 4) & 3;
        const int row0 = u.pm * 256 + wr * 64 + fr, col0 = (u.pn % nN) * 256 + wc * 32 + 8 * fq;
#pragma unroll
        for (int ai = 0; ai < 2; ++ai)
#pragma unroll
            for (int m = 0; m < 4; ++m) { const int row = row0 + ai * 128 + m * 16; bf16* rowp = ys + (size_t)row * D_ + col0;
#pragma unroll
                for (int bj = 0; bj < 2; ++bj) { const pg8::f32x4 v0 = acc[ai][bj][m][0], v1 = acc[ai][bj][m][1];
                    u32x4 w; w.x = pk2(v0[0], v0[1]); w.y = pk2(v0[2], v0[3]); w.z = pk2(v1[0], v1[1]); w.w = pk2(v1[2], v1[3]);
                    *(u32x4*)(rowp + bj * 128) = w; } }
    }
};
struct ExpertOrder {
    int nN, G, c;
    __device__ bool next(int i, pg8::Unit& u) const {
        if (G == 256) {
            const int xcd = c & 7, l = c >> 3, uidx = i * 32 + l;
            if (uidx >= (EG / 8) * 16 * nN) return false;
            const int es = uidx / (16 * nN), r2 = uidx % (16 * nN), el = xcd + 8 * es;
            const int rg = r2 / (8 * nN), rem = r2 % (8 * nN);
            u.pm = el * 16 + rg * 8 + (rem & 7); u.pn = el * nN + (rem >> 3); return true;
        }
        const long L = (long)i * G + c; if (L >= (long)EG * 16 * nN) return false;
        const int e = (int)(L / (16 * nN)), rem = (int)(L % (16 * nN));
        u.pm = e * 16 + (rem & 15); u.pn = e * nN + (rem >> 4); return true;
    }
    __device__ __forceinline__ void a_ready(const pg8::Unit&) const {}
    __device__ __forceinline__ void done(const pg8::Unit&) const {}
};

__device__ __forceinline__ float bflo(unsigned w) { return __uint_as_float(w << 16); }
__device__ __forceinline__ float bfhi(unsigned w) { return __uint_as_float(w & 0xffff0000u); }
#define BAR_LDS() do { asm volatile("s_waitcnt lgkmcnt(0)" ::: "memory"); __builtin_amdgcn_s_barrier(); asm volatile("" ::: "memory"); } while (0)
__device__ __forceinline__ float rcpf_(float x) { return __builtin_amdgcn_rcpf(x); }
__device__ __forceinline__ float silu_fast(float x) { return x * rcpf_(1.f + __expf(-x)); }
__device__ __forceinline__ float sigmoid_fast(float x) { return rcpf_(1.f + __expf(-x)); }
__device__ __forceinline__ void phase_qk(const Params& p) {
    const int lane = threadIdx.x & 63, wave = threadIdx.x >> 6;
    const int gw = blockIdx.x * NW + wave, NGW = gridDim.x * NW;
    const bf16* u = (const bf16*)(p.ws + OFF_U);
    bf16* QK = (bf16*)(p.ws + OFF_XN1);
    const float* cw = p.in[8]; const float* cb = p.in[9];
    const int c0 = lane * 16;
    float w0[16], w1[16], w2[16], bb[16];
#pragma unroll
    for (int e = 0; e < 16; ++e) { w0[e] = cw[c0 + e]; w1[e] = cw[1024 + c0 + e]; w2[e] = cw[2048 + c0 + e]; bb[e] = cb[c0 + e]; }
    const float scl = c0 >= 512 ? 0.08838834764831845f : 1.f;
    const bool wsplit = gridDim.x == 256;
    const int rstep = wsplit ? 5 * 1024 : NGW, rcnt = wsplit ? (blockIdx.x < 128 ? 2 : 3) : 1;
    const int rbase = wsplit ? (blockIdx.x < 128 ? gw * 2 : 2048 + (gw - 1024) * 3) : gw;
    for (int row0 = rbase; row0 < NROW; row0 += rstep)
    for (int rj = 0; rj < rcnt; ++rj) {
        const int row = row0 + rj; if (row >= NROW) break;
        int t, Tlen;
        if (row < NCTX) { t = row % TC_; Tlen = TC_; } else { t = (row - NCTX) % T_; Tlen = T_; }
        if (row >= NCTX && row < NCTX + ZOX_ROWS) *(u32x4*)((bf16*)(p.ws + OFF_ZOX) + (size_t)(row - NCTX) * 512 + lane * 8) = *(const u32x4*)(u + (size_t)row * UC + 1536 + lane * 8);
        const bf16* src = u + (size_t)row * UC + c0;
        u32x4 zc[2], zp[2], zn[2];
#pragma unroll
        for (int i = 0; i < 2; ++i) {
            zc[i] = *(const u32x4*)(src + i * 8);
            zp[i] = t > 0 ? *(const u32x4*)(src - UC + i * 8) : (u32x4){0u, 0u, 0u, 0u};
            zn[i] = t < Tlen - 1 ? *(const u32x4*)(src + UC + i * 8) : (u32x4){0u, 0u, 0u, 0u};
        }
#pragma unroll
        for (int i = 0; i < 2; ++i) {
            float o[8];
#pragma unroll
            for (int e = 0; e < 4; ++e) {
                const int c = i * 8 + e * 2;
                o[e * 2] = silu_fast(bflo(zp[i][e]) * w0[c] + bflo(zc[i][e]) * w1[c] + bflo(zn[i][e]) * w2[c] + bb[c]) * scl;
                o[e * 2 + 1] = silu_fast(bfhi(zp[i][e]) * w0[c + 1] + bfhi(zc[i][e]) * w1[c + 1] + bfhi(zn[i][e]) * w2[c + 1] + bb[c + 1]) * scl;
            }
            u32x4 w; w.x = pk2(o[0], o[1]); w.y = pk2(o[2], o[3]); w.z = pk2(o[4], o[5]); w.w = pk2(o[6], o[7]);
            *(u32x4*)(QK + (size_t)row * 1024 + c0 + i * 8) = w;
        }
    }
}

typedef short bf16x8 __attribute__((ext_vector_type(8)));
typedef float f32x16 __attribute__((ext_vector_type(16)));
#define MFMA32(a, b, c) __builtin_amdgcn_mfma_f32_32x32x16_bf16((a), (b), (c), 0, 0, 0)
namespace ml {
constexpr int QS = 0, KS = 17408, KTS = 34816, VTS = 53248, VTW = 62464, WS = 71680, CS = 80896, FB = 98304;
constexpr int F_GQ = 0, F_MJ = 64, F_WI = 128, F_WK = 192, F_BC = 256, F_NV = 320, F_NQ = 448, F_DP = 512, F_SC = 704;
constexpr int LDQ = 136, LDK = 72;
}
struct MlRaw { u32x4 q[4]; u32x4 v; bf16 gi, gf; };
__device__ __forceinline__ void ml_load(const bf16* QK, const bf16* u, size_t rowbase, int Tlen, int c, int dir, int h, int vh, int tid, int gi, int gf, MlRaw& R) {
    const int j = tid >> 3, cg = tid & 7;
    const int pp = c * 64 + j, t = dir ? Tlen - 1 - pp : pp;
    const bf16* src = QK + (rowbase + t) * 1024 + (cg < 4 ? h * 128 + cg * 32 : 512 + h * 128 + (cg - 4) * 32);
#pragma unroll
    for (int i = 0; i < 4; ++i) R.q[i] = *(const u32x4*)(src + i * 8);
    R.v = *(const u32x4*)(u + (rowbase + t) * UC + 1024 + h * 128 + vh * 64 + cg * 8);
    R.gi = 0; R.gf = 0;
    if (tid < 64) {
        const int p2 = c * 64 + tid, t2 = dir ? Tlen - 1 - p2 : p2;
        R.gi = u[(rowbase + t2) * UC + 2048 + gi]; R.gf = u[(rowbase + t2) * UC + 2048 + gf];
    }
}
__device__ __forceinline__ void mlstm_item(const Params& p, LAS unsigned char* lds0, int item) {
    using namespace ml;
    LAS unsigned char* lds = lds0;
    LAS float* F = (LAS float*)(lds + FB);
    const bf16* u = (const bf16*)(p.ws + OFF_U); const bf16* QK = (const bf16*)(p.ws + OFF_XN1);
    const float* gate_b = p.in[10];
    const int tid = threadIdx.x, lane = tid & 63, wave = __builtin_amdgcn_readfirstlane(tid >> 6), l31 = lane & 31, hf = lane >> 5;
    const int dir = item & 1, vh = (item >> 1) & 1, h = (item >> 2) & 3, b = item >> 4;
    const int gi = (dir ? 2 : 0) * 4 + h, gf = (dir ? 3 : 1) * 4 + h;
    const float gbi = gate_b[gi], gbf = gate_b[gf];
    bf16* Hout = (bf16*)(p.ws + OFF_MIX) + dir * 512;
    __syncthreads();
    for (int i = tid; i < 64 * LDQ / 2; i += NT) ((LAS unsigned*)(lds + CS))[i] = 0u;
    if (tid < 128) F[F_NV + tid] = 0.f;
    if (tid == 0) F[F_SC + 0] = 0.f;
    f32x16 accC[2];
#pragma unroll
    for (int r = 0; r < 16; ++r) { accC[0][r] = 0.f; accC[1][r] = 0.f; }
    MlRaw R;
    ml_load(QK, u, (size_t)b * TC_, TC_, 0, dir, h, vh, tid, gi, gf, R);
    __syncthreads();
    for (int ci = 0; ci < 68; ++ci) {
        lds = lds0; asm volatile("" : "+v"(lds));
        F = (LAS float*)(lds + FB);
        const int seq = ci >= 4, c = seq ? ci - 4 : ci, Tlen = seq ? T_ : TC_;
        if (wave == 0) {
            const float m = F[F_SC + 0];
            const float li = bf2f(R.gi) + gbi, lfv = -softplusf_(-(bf2f(R.gf) + gbf));
#define DPPF(x, ctrl, rmask, oldv) __int_as_float(__builtin_amdgcn_update_dpp(__float_as_int(oldv), __float_as_int(x), ctrl, rmask, 0xF, false))
            float bsum = lfv;
            bsum += DPPF(bsum, 0x111, 0xF, 0.f); bsum += DPPF(bsum, 0x112, 0xF, 0.f); bsum += DPPF(bsum, 0x114, 0xF, 0.f); bsum += DPPF(bsum, 0x118, 0xF, 0.f);
            bsum += DPPF(bsum, 0x142, 0xA, 0.f); bsum += DPPF(bsum, 0x143, 0xC, 0.f);
            const float g = li - bsum;
            float pm = g;
            const float ninf = -INFINITY;
            pm = fmaxf(pm, DPPF(pm, 0x111, 0xF, ninf)); pm = fmaxf(pm, DPPF(pm, 0x112, 0xF, ninf)); pm = fmaxf(pm, DPPF(pm, 0x114, 0xF, ninf)); pm = fmaxf(pm, DPPF(pm, 0x118, 0xF, ninf));
            pm = fmaxf(pm, DPPF(pm, 0x142, 0xA, ninf)); pm = fmaxf(pm, DPPF(pm, 0x143, 0xC, ninf));
#undef DPPF
            const float Mj = fmaxf(m, pm);
            const float M63 = __shfl(Mj, 63), bL = __shfl(bsum, 63);
            F[F_GQ + lane] = g; F[F_MJ + lane] = Mj; F[F_WI + lane] = __expf(m - Mj); F[F_WK + lane] = __expf(g - M63); F[F_BC + lane] = bsum;
            if (lane == 0) { F[F_SC + 1] = __expf(m - M63); F[F_SC + 2] = bL + M63; }
        }
        {
            const int j = tid >> 3, cg = tid & 7, k0 = (cg & 3) * 32;
#pragma unroll
            for (int i = 0; i < 4; ++i) *(LAS u32x4*)(lds + (cg < 4 ? QS : KS) + (j * LDQ + k0 + i * 8) * 2) = R.q[i];
            if (cg >= 4) {
                const int jc = j ^ ((cg & 3) << 4);
#pragma unroll
                for (int i = 0; i < 4; ++i)
#pragma unroll
                    for (int e = 0; e < 4; ++e) { const unsigned w = R.q[i][e];
                        *(LAS bf16*)(lds + KTS + ((k0 + i * 8 + e * 2) * LDK + jc) * 2) = (bf16)(w & 0xffffu);
                        *(LAS bf16*)(lds + KTS + ((k0 + i * 8 + e * 2 + 1) * LDK + jc) * 2) = (bf16)(w >> 16); }
            }
            const int jv = j ^ (cg << 3);
#pragma unroll
            for (int e = 0; e < 4; ++e) { const unsigned w = R.v[e];
                *(LAS bf16*)(lds + VTS + ((cg * 8 + e * 2) * LDK + jv) * 2) = (bf16)(w & 0xffffu);
                *(LAS bf16*)(lds + VTS + ((cg * 8 + e * 2 + 1) * LDK + jv) * 2) = (bf16)(w >> 16); }
        }
        BAR_LDS();
        {
            const int j = tid >> 3, cg = tid & 7, jv = j ^ (cg << 3); const float wk = F[F_WK + j];
#pragma unroll
            for (int e = 0; e < 4; ++e) { const unsigned w = R.v[e];
                *(LAS bf16*)(lds + VTW + ((cg * 8 + e * 2) * LDK + jv) * 2) = (bf16)f2bf(bflo(w) * wk);
                *(LAS bf16*)(lds + VTW + ((cg * 8 + e * 2 + 1) * LDK + jv) * 2) = (bf16)f2bf(bfhi(w) * wk); }
        }
        if (ci + 1 < 68) { const int s2 = (ci + 1) >= 4, c2 = s2 ? ci + 1 - 4 : ci + 1;
            ml_load(QK, u, s2 ? (size_t)NCTX + (size_t)b * T_ : (size_t)b * TC_, s2 ? T_ : TC_, c2, dir, h, vh, tid, gi, gf, R); }
        f32x16 accH;
#pragma unroll
        for (int r = 0; r < 16; ++r) accH[r] = 0.f;
        const int vt = (wave - 4) >> 1, jt4 = (wave - 4) & 1;
        const int vsw = ((l31 >> 3) & 3) << 3;
        if (wave < 3) {
            const int st = wave == 2 ? 1 : 0, jt = wave == 0 ? 0 : 1;
            f32x16 acc;
#pragma unroll
            for (int r = 0; r < 16; ++r) acc[r] = 0.f;
#pragma unroll
            for (int kk = 0; kk < 8; ++kk) {
                const bf16x8 a = *(const LAS bf16x8*)(lds + KS + ((st * 32 + l31) * LDQ + kk * 16 + hf * 8) * 2);
                const bf16x8 bq = *(const LAS bf16x8*)(lds + QS + ((jt * 32 + l31) * LDQ + kk * 16 + hf * 8) * 2);
                acc = MFMA32(a, bq, acc);
            }
            const int j = jt * 32 + l31; const float Mj = F[F_MJ + j];
            float sum = 0.f;
#pragma unroll
            for (int g4 = 0; g4 < 4; ++g4) {
                const f32x4 gq4 = *(const LAS f32x4*)(F + F_GQ + st * 32 + 8 * g4 + 4 * hf);
                float w4[4];
#pragma unroll
                for (int e = 0; e < 4; ++e) { const int s = st * 32 + 8 * g4 + 4 * hf + e; const float arg = (s <= j) ? gq4[e] - Mj : -INFINITY; const float wv = __expf(arg) * acc[g4 * 4 + e]; w4[e] = wv; sum += wv; }
                u32x2 w; w.x = pk2(w4[0], w4[1]); w.y = pk2(w4[2], w4[3]);
                *(LAS u32x2*)(lds + WS + (j * LDK + st * 32 + 8 * g4 + 4 * hf) * 2) = w;
            }
            sum += __shfl_xor(sum, 32);
            if (hf == 0) F[F_DP + wave * 64 + j] = sum;
        } else if (wave == 3) {
            float s2 = 0.f;
#pragma unroll
            for (int k8 = 0; k8 < 16; ++k8) { const u32x4 w = *(const LAS u32x4*)(lds + QS + (lane * LDQ + k8 * 8) * 2);
                const f32x4 n0 = *(const LAS f32x4*)(F + F_NV + k8 * 8), n1 = *(const LAS f32x4*)(F + F_NV + k8 * 8 + 4);
                s2 += bflo(w[0]) * n0.x + bfhi(w[0]) * n0.y + bflo(w[1]) * n0.z + bfhi(w[1]) * n0.w + bflo(w[2]) * n1.x + bfhi(w[2]) * n1.y + bflo(w[3]) * n1.z + bfhi(w[3]) * n1.w; }
            F[F_NQ + lane] = s2;
        } else {
#pragma unroll
            for (int kk = 0; kk < 8; ++kk) {
                const bf16x8 a = *(const LAS bf16x8*)(lds + CS + ((vt * 32 + l31) * LDQ + kk * 16 + hf * 8) * 2);
                const bf16x8 bq = *(const LAS bf16x8*)(lds + QS + ((jt4 * 32 + l31) * LDQ + kk * 16 + hf * 8) * 2);
                accH = MFMA32(a, bq, accH);
            }
        }
        BAR_LDS();
        if (wave >= 4) {
            f32x16 acc2;
#pragma unroll
            for (int r = 0; r < 16; ++r) acc2[r] = 0.f;
            const int nk = jt4 ? 4 : 2;
            const int vsw4 = (((vt * 32 + l31) >> 3) & 7) << 3;
            for (int kk = 0; kk < nk; ++kk) {
                const bf16x8 a = *(const LAS bf16x8*)(lds + VTS + ((vt * 32 + l31) * LDK + ((kk * 16 + hf * 8) ^ vsw4)) * 2);
                const bf16x8 bw = *(const LAS bf16x8*)(lds + WS + ((jt4 * 32 + l31) * LDK + kk * 16 + hf * 8) * 2);
                acc2 = MFMA32(a, bw, acc2);
            }
            if (seq) {
                const int j = jt4 * 32 + l31;
                const float wi = F[F_WI + j];
                const float dsum = j < 32 ? F[F_DP + j] : F[F_DP + 64 + j] + F[F_DP + 128 + j];
                const float den = dsum + wi * F[F_NQ + j];
                const float inv = rcpf_(fmaxf(fabsf(den), __expf(-(F[F_BC + j] + F[F_MJ + j]))));
                const int pp = c * 64 + j, t = dir ? Tlen - 1 - pp : pp;
                bf16* dst = Hout + ((size_t)b * T_ + t) * 1024 + h * 128 + vh * 64 + vt * 32 + 4 * hf;
#pragma unroll
                for (int g4 = 0; g4 < 4; ++g4) { u32x2 w;
                    w.x = pk2((acc2[g4 * 4] + wi * accH[g4 * 4]) * inv, (acc2[g4 * 4 + 1] + wi * accH[g4 * 4 + 1]) * inv);
                    w.y = pk2((acc2[g4 * 4 + 2] + wi * accH[g4 * 4 + 2]) * inv, (acc2[g4 * 4 + 3] + wi * accH[g4 * 4 + 3]) * inv);
                    *(u32x2*)(dst + 8 * g4) = w; }
            }
        } else {
            const float s_old = F[F_SC + 1];
            const int kt = wave;
#pragma unroll
            for (int r = 0; r < 16; ++r) { accC[0][r] *= s_old; accC[1][r] *= s_old; }
#pragma unroll
            for (int kk = 0; kk < 4; ++kk) {
                const bf16x8 a = *(const LAS bf16x8*)(lds + KTS + ((kt * 32 + l31) * LDK + ((kk * 16 + hf * 8) ^ (kt << 4))) * 2);
                const bf16x8 b0 = *(const LAS bf16x8*)(lds + VTW + ((l31) * LDK + ((kk * 16 + hf * 8) ^ vsw)) * 2);
                const bf16x8 b1 = *(const LAS bf16x8*)(lds + VTW + ((32 + l31) * LDK + ((kk * 16 + hf * 8) ^ (vsw + 32))) * 2);
                accC[0] = MFMA32(a, b0, accC[0]); accC[1] = MFMA32(a, b1, accC[1]);
            }
#pragma unroll
            for (int v2 = 0; v2 < 2; ++v2)
#pragma unroll
                for (int g4 = 0; g4 < 4; ++g4) { u32x2 w; w.x = pk2(accC[v2][g4 * 4], accC[v2][g4 * 4 + 1]); w.y = pk2(accC[v2][g4 * 4 + 2], accC[v2][g4 * 4 + 3]);
                    *(LAS u32x2*)(lds + CS + ((v2 * 32 + l31) * LDQ + kt * 32 + 8 * g4 + 4 * hf) * 2) = w; }
            if (tid < 128) {
                float nn = s_old * F[F_NV + tid];
                const int ksw = ((tid >> 5) & 3) << 4;
#pragma unroll
                for (int s8 = 0; s8 < 8; ++s8) { const u32x4 w = *(const LAS u32x4*)(lds + KTS + (tid * LDK + ((s8 * 8) ^ ksw)) * 2);
                    const f32x4 k0 = *(const LAS f32x4*)(F + F_WK + s8 * 8), k1 = *(const LAS f32x4*)(F + F_WK + s8 * 8 + 4);
                    nn += bflo(w[0]) * k0.x + bfhi(w[0]) * k0.y + bflo(w[1]) * k0.z + bfhi(w[1]) * k0.w + bflo(w[2]) * k1.x + bfhi(w[2]) * k1.y + bflo(w[3]) * k1.z + bfhi(w[3]) * k1.w; }
                F[F_NV + tid] = nn;
            }
            if (tid == 0) F[F_SC + 0] = F[F_SC + 2];
        }
        BAR_LDS();
    }
}

constexpr int RWP_LD = 3584;
__device__ __forceinline__ size_t rw_row(int seq, int b, int p) { return seq ? (size_t)NCTX + (size_t)b * T_ + (size_t)((p & 63) * 64 + (p >> 6)) : (size_t)b * TC_ + p; }
typedef short bf16x8 __attribute__((ext_vector_type(8)));
#define MFMA16(a, b, c) __builtin_amdgcn_mfma_f32_16x16x32_bf16((a), (b), (c), 0, 0, 0)
__device__ __forceinline__ float tanh_fast(float x) { const float xc = fminf(fmaxf(x, -15.f), 15.f); return 1.f - 2.f * rcpf_(__expf(2.f * xc) + 1.f); }
namespace rp {
constexpr int RS = 0, KSH = 16384, XW = 32768, XA = XW + 4608, XG = XA + 4608, OUT = 49152, LDX = 72, LDG = 168;
}
__device__ __forceinline__ void rwkv_prep_tile(const Params& p, LAS unsigned char* lds, int tile) {
    using namespace rp;
    const int tid = threadIdx.x, lane = tid & 63, wave = __builtin_amdgcn_readfirstlane(tid >> 6);
    const bf16* u = (const bf16*)(p.ws + OFF_U);
    bf16* RWP = (bf16*)(p.ws + OFF_RWP);
    const float* mu = p.in[12];
    int seq, b, p0;
    if (tile < 128) { seq = 0; b = tile >> 4; p0 = (tile & 15) * 16; } else { const int t2 = tile - 128; seq = 1; b = t2 >> 8; p0 = (t2 & 255) * 16; }
    const int Tlen = seq ? T_ : TC_;
    const size_t srow0 = (seq ? (size_t)NCTX + (size_t)b * T_ : (size_t)b * TC_) + p0;
    {
        const int cgp = tid & 255, half = tid >> 8;
        if (cgp < 244) {
            const int col = cgp * 8;
            u32x4 rows[10];
#pragma unroll
            for (int i = 0; i < 10; ++i) { const int pos = p0 + half * 8 - 1 + i; const bool ok = pos >= 0 && pos < Tlen;
                rows[i] = ok ? *(const u32x4*)(u + rw_row(seq, b, ok ? pos : p0) * UC + MLC + col) : (u32x4){0u, 0u, 0u, 0u}; }
            float mp[8], mn[8];
#pragma unroll
            for (int e = 0; e < 8; ++e) { mp[e] = mu[col + e]; mn[e] = mu[1952 + col + e]; }
            float kkw[8];
#pragma unroll
            for (int e = 0; e < 8; ++e) kkw[e] = (col >= 512 && col < 1024) ? p.in[18][col - 512 + e] : 0.f;
#pragma unroll
            for (int i = 0; i < 8; ++i) {
                const int t = half * 8 + i;
                float s[8];
#pragma unroll
                for (int e = 0; e < 4; ++e) {
                    const float c0 = bflo(rows[i + 1][e]), c1 = bfhi(rows[i + 1][e]);
                    s[2 * e] = c0 + mp[2 * e] * (bflo(rows[i][e]) - c0) + mn[2 * e] * (bflo(rows[i + 2][e]) - c0);
                    s[2 * e + 1] = c1 + mp[2 * e + 1] * (bfhi(rows[i][e]) - c1) + mn[2 * e + 1] * (bfhi(rows[i + 2][e]) - c1);
                }
                if (col < 1536) {
                    u32x4 w; w.x = pk2(s[0], s[1]); w.y = pk2(s[2], s[3]); w.z = pk2(s[4], s[5]); w.w = pk2(s[6], s[7]);
                    *(u32x4*)(RWP + (srow0 + t) * RWP_LD + col) = w;
                    if (col < 1024) *(LAS u32x4*)(lds + (col < 512 ? RS : KSH) + (t * 512 + (col & 511)) * 2) = w;
                    if (col >= 512 && col < 1024) {
                        float ss = 0.f;
#pragma unroll
                        for (int e = 0; e < 8; ++e) { const float kk = s[e] * kkw[e]; ss += kk * kk; }
                        ss += __shfl_xor(ss, 1); ss += __shfl_xor(ss, 2); ss += __shfl_xor(ss, 4);
                        if ((cgp & 7) == 0) ((float*)(p.ws + OFF_INVN))[(srow0 + t) * 8 + ((col - 512) >> 6)] = rcpf_(fmaxf(sqrtf(ss), 1e-12f));
                    }
                } else if (col < 1664) {
                    const int d = (col - 1536) >> 6, rr = (col - 1536) & 63;
                    u32x4 w; w.x = pk2(tanh_fast(s[0]), tanh_fast(s[1])); w.y = pk2(tanh_fast(s[2]), tanh_fast(s[3])); w.z = pk2(tanh_fast(s[4]), tanh_fast(s[5])); w.w = pk2(tanh_fast(s[6]), tanh_fast(s[7]));
                    *(LAS u32x4*)(lds + XW + ((d * 16 + t) * LDX + rr) * 2) = w;
                } else if (col < 1792) {
                    const int d = (col - 1664) >> 6, rr = (col - 1664) & 63;
                    u32x4 w; w.x = pk2(s[0], s[1]); w.y = pk2(s[2], s[3]); w.z = pk2(s[4], s[5]); w.w = pk2(s[6], s[7]);
                    *(LAS u32x4*)(lds + XA + ((d * 16 + t) * LDX + rr) * 2) = w;
                } else {
                    u32x4 w; w.x = pk2(sigmoid_fast(s[0]), sigmoid_fast(s[1])); w.y = pk2(sigmoid_fast(s[2]), sigmoid_fast(s[3])); w.z = pk2(sigmoid_fast(s[4]), sigmoid_fast(s[5])); w.w = pk2(sigmoid_fast(s[6]), sigmoid_fast(s[7]));
                    *(LAS u32x4*)(lds + XG + (t * LDG + (col - 1792)) * 2) = w;
                }
            }
        }
    }
    {
        const int l15 = lane & 15, q = lane >> 4, head = wave;
        const bf16* LT = (const bf16*)(p.ws + OFF_LORA);
        float bp[2][4];
#pragma unroll
        for (int d = 0; d < 2; ++d)
#pragma unroll
            for (int r = 0; r < 4; ++r) bp[d][r] = 0.f;
        bf16x8 bw[2][2], ba[2][2], bg[5]; float ka_n, rk_n, w0_n[2], a0_n[2];
#define RP_LOADB(ci_) do { const int c_ = head * 64 + (ci_) * 16 + l15; \
            _Pragma("unroll") for (int d = 0; d < 2; ++d) { _Pragma("unroll") for (int s = 0; s < 2; ++s) { \
                bw[d][s] = *(const bf16x8*)(LT + ((size_t)(d * 512 + c_) * 64 + s * 32 + q * 8)); ba[d][s] = *(const bf16x8*)(LT + 65536 + ((size_t)(d * 512 + c_) * 64 + s * 32 + q * 8)); } \
                w0_n[d] = p.in[13][d * 512 + c_]; a0_n[d] = p.in[15][d * 512 + c_]; } \
            _Pragma("unroll") for (int s = 0; s < 5; ++s) bg[s] = *(const bf16x8*)(LT + 131072 + ((size_t)c_ * 160 + s * 32 + q * 8)); \
            ka_n = p.in[19][c_]; rk_n = p.in[20][c_]; } while (0)
        RP_LOADB(0);
        __syncthreads();
#pragma unroll 1
        for (int ci = 0; ci < 4; ++ci) {
            const int c = head * 64 + ci * 16 + l15;
            f32x4 accW[2], accA[2], accG = (f32x4){0.f, 0.f, 0.f, 0.f};
#pragma unroll
            for (int d = 0; d < 2; ++d) {
                accW[d] = (f32x4){0.f, 0.f, 0.f, 0.f}; accA[d] = (f32x4){0.f, 0.f, 0.f, 0.f};
#pragma unroll
                for (int s = 0; s < 2; ++s) {
                    accW[d] = MFMA16(*(const LAS bf16x8*)(lds + XW + ((d * 16 + l15) * LDX + s * 32 + q * 8) * 2), bw[d][s], accW[d]);
                    accA[d] = MFMA16(*(const LAS bf16x8*)(lds + XA + ((d * 16 + l15) * LDX + s * 32 + q * 8) * 2), ba[d][s], accA[d]); }
            }
#pragma unroll
            for (int s = 0; s < 5; ++s) accG = MFMA16(*(const LAS bf16x8*)(lds + XG + (l15 * LDG + s * 32 + q * 8) * 2), bg[s], accG);
            const float ka = ka_n, rk = rk_n, w0c[2] = {w0_n[0], w0_n[1]}, a0c[2] = {a0_n[0], a0_n[1]};
            if (ci < 3) RP_LOADB(ci + 1);
            float rkv[4];
#pragma unroll
            for (int r = 0; r < 4; ++r) { const int t = q * 4 + r; rkv[r] = bf2f(*(const LAS bf16*)(lds + RS + (t * 512 + c) * 2)) * bf2f(*(const LAS bf16*)(lds + KSH + (t * 512 + c) * 2)) * rk; }
#pragma unroll
            for (int d = 0; d < 2; ++d) {
#pragma unroll
                for (int r = 0; r < 4; ++r) {
                    const int t = q * 4 + r;
                    const float lw = accW[d][r] + w0c[d];
                    const float ld = -0.6065306597126334f * sigmoid_fast(lw);
                    const float a = sigmoid_fast(accA[d][r] + a0c[d]);
                    *(LAS bf16*)(lds + OUT + ((2 * d) * 8192 + t * 512 + c) * 2) = (bf16)f2bf(ld);
                    *(LAS bf16*)(lds + OUT + ((2 * d + 1) * 8192 + t * 512 + c) * 2) = (bf16)f2bf(a);
                    bp[d][r] += rkv[r] * (1.f + (a - 1.f) * ka);
                }
            }
#pragma unroll
            for (int r = 0; r < 4; ++r) *(LAS bf16*)(lds + OUT + (4 * 8192 + (q * 4 + r) * 512 + c) * 2) = (bf16)f2bf(accG[r]);
        }
#undef RP_LOADB
        if (seq) {
#pragma unroll
            for (int d = 0; d < 2; ++d)
#pragma unroll
                for (int r = 0; r < 4; ++r) {
                    float v = bp[d][r];
                    v += __shfl_xor(v, 1); v += __shfl_xor(v, 2); v += __shfl_xor(v, 4); v += __shfl_xor(v, 8);
                    if (l15 == 0) ((float*)(p.ws + OFF_BON))[((size_t)d * NLAT + (size_t)b * T_ + p0 + q * 4 + r) * 8 + head] = v;
                }
        }
    }
    __syncthreads();
#pragma unroll
    for (int i = 0; i < 8; ++i) {
        const int pc = tid + i * NT, t = pc >> 8, rem = pc & 255, qq = rem >> 6, c8 = (rem & 63) * 8;
        *(u32x4*)(RWP + (srow0 + t) * RWP_LD + 1536 + qq * 512 + c8) = *(const LAS u32x4*)(lds + OUT + (qq * 8192 + t * 512 + c8) * 2);
    }
    if (seq) {
#pragma unroll
        for (int i = 0; i < 2; ++i) {
            const int pc = tid + i * NT, t = pc >> 6, c8 = (pc & 63) * 8;
            *(u32x4*)((bf16*)(p.ws + OFF_G) + ((size_t)b * T_ + p0 + t) * 512 + c8) = *(const LAS u32x4*)(lds + OUT + (4 * 8192 + t * 512 + c8) * 2);
        }
    }
    __syncthreads();
}

typedef float f32x2 __attribute__((ext_vector_type(2)));
__device__ __forceinline__ float dpp_sum8(float x) {
    x += __int_as_float(__builtin_amdgcn_update_dpp(0, __float_as_int(x), 0xB1, 0xF, 0xF, true));
    x += __int_as_float(__builtin_amdgcn_update_dpp(0, __float_as_int(x), 0x4E, 0xF, 0xF, true));
    x += __int_as_float(__builtin_amdgcn_update_dpp(0, __float_as_int(x), 0x141, 0xF, 0xF, true));
    return x;
}
namespace rs { constexpr int NS = 32, OPS = 0, VV = 2 * NS * 320 * 4, YB = VV + 2 * NS * 32 * 4, XSCR = YB + 2 * NS * 32 * 4, NCH = (TC_ + T_) / NS; }
struct RsRaw { u32x4 r, k, ld, a, v; float invn; };
__device__ __forceinline__ void rs_load(const bf16* RWP, const float* INVN, int cc, int b, int h, int dir, int vh, int st, RsRaw& R) {
    const int seq = cc >= TC_ / rs::NS, c = seq ? cc - TC_ / rs::NS : cc, Tlen = seq ? T_ : TC_;
    const int step = st >> 3, kq = st & 7;
    const int pos = dir ? Tlen - 1 - (c * rs::NS + step) : c * rs::NS + step;
    const size_t srow = (seq ? (size_t)NCTX + (size_t)b * T_ : (size_t)b * TC_) + pos;
    const bf16* rowp = RWP + srow * RWP_LD + h * 64 + kq * 8;
    R.r = *(const u32x4*)(rowp); R.k = *(const u32x4*)(rowp + 512);
    R.ld = *(const u32x4*)(rowp + 1536 + dir * 1024); R.a = *(const u32x4*)(rowp + 2048 + dir * 1024);
    R.v = *(const u32x4*)(RWP + srow * RWP_LD + 1024 + h * 64 + vh * 32 + (kq & 3) * 8);
    R.invn = INVN[srow * 8 + h];
}
template <bool XCVT>
__device__ __forceinline__ void rwkv_scan_item(const Params& p, LAS unsigned char* lds0, int item) {
    using namespace rs;
    const int tid = threadIdx.x, lane = tid & 63, wave = __builtin_amdgcn_readfirstlane(tid >> 6);
    const int dir = item & 1, vh = (item >> 1) & 1, h = (item >> 2) & 7, b = item >> 5;
    const bf16* RWP = (const bf16*)(p.ws + OFF_RWP); const float* INVN = (const float*)(p.ws + OFF_INVN);
    float* Y = p.out + (size_t)dir * NLAT * 512;
    const int st = tid - 256, skq = st & 7, sstep = st >> 3;
    float kkw[8], kaw[8];
    RsRaw R;
    if (wave >= 4) {
#pragma unroll
        for (int e = 0; e < 8; ++e) { kkw[e] = p.in[18][h * 64 + skq * 8 + e]; kaw[e] = p.in[19][h * 64 + skq * 8 + e]; }
        rs_load(RWP, INVN, 0, b, h, dir, vh, st, R);
    }
    f32x2 S[4];
#pragma unroll
    for (int i = 0; i < 4; ++i) S[i] = (f32x2){0.f, 0.f};
    const int v8 = lane >> 3, kq = lane & 7, vrow = wave * 8 + v8;
    __syncthreads();
    for (int cc = -1; cc <= NCH; ++cc) {
        LAS unsigned char* lds = lds0; asm volatile("" : "+v"(lds));
        if (wave >= 4) {
            if (cc >= 1 + TC_ / NS) {
                const int c1 = cc - 1 - TC_ / NS, pos = dir ? T_ - 1 - (c1 * NS + sstep) : c1 * NS + sstep;
                const f32x4 yv = *(const LAS f32x4*)((const LAS float*)(lds + YB) + (((cc - 1) & 1) * NS + sstep) * 32 + skq * 4);
                *(f32x4*)(Y + ((size_t)b * T_ + (size_t)((pos & 63) * 64 + (pos >> 6))) * 512 + h * 64 + vh * 32 + skq * 4) = yv;
            }
            if (cc + 1 < NCH) {
                const int buf = (cc + 1) & 1;
                LAS float* o = (LAS float*)(lds + OPS) + ((buf * NS + sstep) * 8 + skq) * 40;
                float nk[8], w[8], bb[8], kt[8], rr[8];
#pragma unroll
                for (int e = 0; e < 4; ++e) {
                    const float k0 = bflo(R.k[e]), k1 = bfhi(R.k[e]), a0 = bflo(R.a[e]), a1 = bfhi(R.a[e]);
                    const float n0 = k0 * kkw[2 * e] * R.invn, n1 = k1 * kkw[2 * e + 1] * R.invn;
                    nk[2 * e] = -n0; nk[2 * e + 1] = -n1; bb[2 * e] = n0 * a0; bb[2 * e + 1] = n1 * a1;
                    w[2 * e] = __expf(bflo(R.ld[e])); w[2 * e + 1] = __expf(bfhi(R.ld[e]));
                    kt[2 * e] = k0 * (1.f + (a0 - 1.f) * kaw[2 * e]); kt[2 * e + 1] = k1 * (1.f + (a1 - 1.f) * kaw[2 * e + 1]);
                    rr[2 * e] = bflo(R.r[e]); rr[2 * e + 1] = bfhi(R.r[e]);
                }
                *(LAS f32x4*)(o + 0) = (f32x4){nk[0], nk[1], nk[2], nk[3]}; *(LAS f32x4*)(o + 4) = (f32x4){nk[4], nk[5], nk[6], nk[7]};
                *(LAS f32x4*)(o + 8) = (f32x4){w[0], w[1], w[2], w[3]}; *(LAS f32x4*)(o + 12) = (f32x4){w[4], w[5], w[6], w[7]};
                *(LAS f32x4*)(o + 16) = (f32x4){bb[0], bb[1], bb[2], bb[3]}; *(LAS f32x4*)(o + 20) = (f32x4){bb[4], bb[5], bb[6], bb[7]};
                *(LAS f32x4*)(o + 24) = (f32x4){kt[0], kt[1], kt[2], kt[3]}; *(LAS f32x4*)(o + 28) = (f32x4){kt[4], kt[5], kt[6], kt[7]};
                *(LAS f32x4*)(o + 32) = (f32x4){rr[0], rr[1], rr[2], rr[3]}; *(LAS f32x4*)(o + 36) = (f32x4){rr[4], rr[5], rr[6], rr[7]};
                if (skq < 4) {
                    LAS float* vo = (LAS float*)(lds + VV) + (buf * NS + sstep) * 32 + skq * 8;
                    *(LAS f32x4*)(vo) = (f32x4){bflo(R.v[0]), bfhi(R.v[0]), bflo(R.v[1]), bfhi(R.v[1])};
                    *(LAS f32x4*)(vo + 4) = (f32x4){bflo(R.v[2]), bfhi(R.v[2]), bflo(R.v[3]), bfhi(R.v[3])};
                }
            }
            if (cc + 2 < NCH) rs_load(RWP, INVN, cc + 2, b, h, dir, vh, st, R);
            if (XCVT && cc >= 0 && (cc & 1) == 0) {
                const int it = (blockIdx.x * 4 + (wave - 4)) + 1024 * (cc >> 1);
                if (it < EXP_ITEMS) expert_item(p, (LAS float*)(lds + XSCR + (wave - 4) * 8448), it, lane);
            }
        } else if (cc >= 0 && cc < NCH) {
            const int buf = cc & 1;
            const LAS float* ob = (const LAS float*)(lds + OPS) + (buf * NS * 8 + kq) * 40;
            const LAS float* vb = (const LAS float*)(lds + VV) + buf * NS * 32 + vrow;
            LAS float* yl = (LAS float*)(lds + YB) + buf * NS * 32 + vrow;
            struct Ops { f32x4 n0, n1, w0, w1, b0, b1, k0, k1, r0, r1; float vv; };
#define RS_LOAD(P, i) do { const LAS float* o = ob + (i) * 320; P.n0 = *(const LAS f32x4*)(o); P.n1 = *(const LAS f32x4*)(o + 4); P.w0 = *(const LAS f32x4*)(o + 8); P.w1 = *(const LAS f32x4*)(o + 12); \
        P.b0 = *(const LAS f32x4*)(o + 16); P.b1 = *(const LAS f32x4*)(o + 20); P.k0 = *(const LAS f32x4*)(o + 24); P.k1 = *(const LAS f32x4*)(o + 28); P.r0 = *(const LAS f32x4*)(o + 32); P.r1 = *(const LAS f32x4*)(o + 36); P.vv = vb[(i) * 32]; } while (0)
#define RS_YDONE(i) do { yl[(i) * 32] = dpp_sum8(yp.x + yp.y); } while (0)
#define RS_STEP(P, i, FIN) do { \
        const f32x2 sa2 = (S[0] * (f32x2){P.n0.x, P.n0.y} + S[1] * (f32x2){P.n0.z, P.n0.w}) + (S[2] * (f32x2){P.n1.x, P.n1.y} + S[3] * (f32x2){P.n1.z, P.n1.w}); \
        if (FIN) RS_YDONE((i) - 1); \
        const float sa = dpp_sum8(sa2.x + sa2.y); const f32x2 sav = (f32x2){sa, sa}, vvv = (f32x2){P.vv, P.vv}; \
        S[0] = S[0] * (f32x2){P.w0.x, P.w0.y} + sav * (f32x2){P.b0.x, P.b0.y} + vvv * (f32x2){P.k0.x, P.k0.y}; \
        S[1] = S[1] * (f32x2){P.w0.z, P.w0.w} + sav * (f32x2){P.b0.z, P.b0.w} + vvv * (f32x2){P.k0.z, P.k0.w}; \
        S[2] = S[2] * (f32x2){P.w1.x, P.w1.y} + sav * (f32x2){P.b1.x, P.b1.y} + vvv * (f32x2){P.k1.x, P.k1.y}; \
        S[3] = S[3] * (f32x2){P.w1.z, P.w1.w} + sav * (f32x2){P.b1.z, P.b1.w} + vvv * (f32x2){P.k1.z, P.k1.w}; \
        yp = (S[0] * (f32x2){P.r0.x, P.r0.y} + S[1] * (f32x2){P.r0.z, P.r0.w}) + (S[2] * (f32x2){P.r1.x, P.r1.y} + S[3] * (f32x2){P.r1.z, P.r1.w}); \
    } while (0)
            Ops A, B;
            f32x2 yp;
            RS_LOAD(A, 0);
            RS_LOAD(B, 1);
            RS_STEP(A, 0, false);
            RS_LOAD(A, 2);
            RS_STEP(B, 1, true);
#pragma unroll 1
            for (int i = 2; i < NS; i += 2) {
                RS_LOAD(B, i + 1);
                RS_STEP(A, i, true);
                RS_LOAD(A, i + 2);
                RS_STEP(B, i + 1, true);
            }
            RS_YDONE(NS - 1);
#undef RS_LOAD
#undef RS_STEP
#undef RS_YDONE
        }
        __syncthreads();
    }
}

namespace rc {
constexpr int SET = 10752;
constexpr int RH = 0, BKT = 2304, VT = 6400, GAM = 10496;
constexpr int AH = 3 * SET, BH = AH + 2304, KH = BH + 2304, AHT = KH + 2304  , ABK = AHT + 2 * 4096  , AAK = ABK + 2 * 1024  , AABT = AAK + 2 * 1024, TT = AABT + 1024, W2T = TT + 1024,
              P1T = W2T + 1024, YB = P1T + 2304, END = YB + 4096;
constexpr int NCH = (TC_ + T_) / 16;
}
struct RcRaw { u32x2 r, k, a, v, ld; float invn; };
__device__ __forceinline__ void rc_load(const bf16* RWP, const float* INVN, int cc, int b, int h, int dir, int ei, int ekq, RcRaw& R) {
    const int seq = cc >= TC_ / 16, c = seq ? cc - TC_ / 16 : cc, Tlen = seq ? T_ : TC_;
    const size_t srow = (seq ? (size_t)NCTX + (size_t)b * T_ : (size_t)b * TC_) + (dir ? Tlen - 1 - (c * 16 + ei) : c * 16 + ei);
    const bf16* rowp = RWP + srow * RWP_LD + h * 64 + ekq * 4;
    R.r = *(const u32x2*)(rowp); R.k = *(const u32x2*)(rowp + 512); R.v = *(const u32x2*)(rowp + 1024);
    R.ld = *(const u32x2*)(rowp + 1536 + dir * 1024); R.a = *(const u32x2*)(rowp + 2048 + dir * 1024);
    R.invn = INVN[srow * 8 + h];
}
__device__ __forceinline__ float scan16_row(float x) {
    x += __int_as_float(__builtin_amdgcn_update_dpp(0, __float_as_int(x), 0x111, 0xF, 0xF, true));
    x += __int_as_float(__builtin_amdgcn_update_dpp(0, __float_as_int(x), 0x112, 0xF, 0xF, true));
    x += __int_as_float(__builtin_amdgcn_update_dpp(0, __float_as_int(x), 0x114, 0xF, 0xF, true));
    x += __int_as_float(__builtin_amdgcn_update_dpp(0, __float_as_int(x), 0x118, 0xF, 0xF, true));
    return x;
}
__device__ __forceinline__ void rwkv_chunk_item(const Params& p, LAS unsigned char* lds0, int item) {
    using namespace rc;
    const int tid = threadIdx.x, lane = tid & 63, wave = __builtin_amdgcn_readfirstlane(tid >> 6), l15 = lane & 15, q = lane >> 4;
    const int dir = item & 1, h = (item >> 1) & 7, b = item >> 4;
    const bf16* RWP = (const bf16*)(p.ws + OFF_RWP); const float* INVN = (const float*)(p.ws + OFF_INVN);
    bf16* Y = (bf16*)p.out + (size_t)dir * NLAT * 512;
    __syncthreads();
    for (int i = tid; i < END / 4; i += NT) ((LAS unsigned*)lds0)[i] = 0u;
    const int ei = lane & 15, ekq = (wave & 3) * 4 + (lane >> 4);
    RcRaw R;
    const f32x4 kkw = *(const f32x4*)(p.in[18] + h * 64 + ekq * 4), kaw = *(const f32x4*)(p.in[19] + h * 64 + ekq * 4);
    f32x4 acc[4];
#pragma unroll
    for (int t = 0; t < 4; ++t) acc[t] = (f32x4){0.f, 0.f, 0.f, 0.f};
    __syncthreads();
    for (int cc = -4; cc < NCH; ++cc) {
        LAS unsigned char* lds = lds0; asm volatile("" : "+v"(lds));
        int l15o = l15, qo = q; asm volatile("" : "+v"(l15o), "+v"(qo));
        const int c2 = cc + 2, c1 = cc + 1;
        if (wave < 4) {
            if (c2 >= 0 && c2 < NCH) {
                LAS unsigned char* S2 = lds + (c2 % 3) * SET;
                const float l0 = bflo(R.ld.x), l1 = bfhi(R.ld.x), l2 = bflo(R.ld.y), l3 = bfhi(R.ld.y);
                const float ldi[4] = {l0, l1, l2, l3};
                const float cl[4] = {scan16_row(l0), scan16_row(l1), scan16_row(l2), scan16_row(l3)};
                const float rr[4] = {bflo(R.r.x), bfhi(R.r.x), bflo(R.r.y), bfhi(R.r.y)}, kv[4] = {bflo(R.k.x), bfhi(R.k.x), bflo(R.k.y), bfhi(R.k.y)};
                const float av[4] = {bflo(R.a.x), bfhi(R.a.x), bflo(R.a.y), bfhi(R.a.y)};
                float rh[4], ah[4], bh[4], kh[4], e1[4];
#pragma unroll
                for (int e = 0; e < 4; ++e) {
                    e1[e] = __expf(cl[e]); const float e2 = __expf(-cl[e]), e3 = __expf(cl[e] - ldi[e]);
                    const float kkv = kv[e] * kkw[e] * R.invn;
                    rh[e] = rr[e] * e1[e]; ah[e] = -kkv * e3; bh[e] = kkv * av[e] * e2; kh[e] = kv[e] * (1.f + (av[e] - 1.f) * kaw[e]) * e2;
                }
                const int k0 = ekq * 4;
                { u32x2 w; w.x = pk2(rh[0], rh[1]); w.y = pk2(rh[2], rh[3]); *(LAS u32x2*)(S2 + RH + (ei * 72 + k0) * 2) = w; }
                { u32x2 w; w.x = pk2(ah[0], ah[1]); w.y = pk2(ah[2], ah[3]); *(LAS u32x2*)(lds + AH + (ei * 72 + k0) * 2) = w; }
                { u32x2 w; w.x = pk2(bh[0], bh[1]); w.y = pk2(bh[2], bh[3]); *(LAS u32x2*)(lds + BH + (ei * 72 + k0) * 2) = w; }
                { u32x2 w; w.x = pk2(kh[0], kh[1]); w.y = pk2(kh[2], kh[3]); *(LAS u32x2*)(lds + KH + (ei * 72 + k0) * 2) = w; }
                const int bq = (ei >> 2) * 8 + (ei & 3);
                LAS unsigned char* aht = lds + AHT + (c2 & 1) * 4096;
#pragma unroll
                for (int e = 0; e < 4; ++e) {
                    *(LAS bf16*)(aht + ((k0 + e) * 32 + ei) * 2) = (bf16)f2bf(ah[e]);
                    *(LAS bf16*)(S2 + BKT + ((k0 + e) * 32 + bq) * 2) = (bf16)f2bf(bh[e]);
                    *(LAS bf16*)(S2 + BKT + ((k0 + e) * 32 + bq + 4) * 2) = (bf16)f2bf(kh[e]);
                }
                *(LAS bf16*)(S2 + VT + ((k0 + 0) * 32 + ei) * 2) = (bf16)(R.v.x & 0xffffu); *(LAS bf16*)(S2 + VT + ((k0 + 1) * 32 + ei) * 2) = (bf16)(R.v.x >> 16);
                *(LAS bf16*)(S2 + VT + ((k0 + 2) * 32 + ei) * 2) = (bf16)(R.v.y & 0xffffu); *(LAS bf16*)(S2 + VT + ((k0 + 3) * 32 + ei) * 2) = (bf16)(R.v.y >> 16);
                if (ei == 15) *(LAS f32x4*)(S2 + GAM + k0 * 4) = (f32x4){e1[0], e1[1], e1[2], e1[3]};
            }
            if (cc + 3 >= 0 && cc + 3 < NCH) rc_load(RWP, INVN, cc + 3, b, h, dir, ei, ekq, R);
            if (wave == 0 && c1 >= 0 && c1 < NCH) {
                int lo = lane; asm volatile("" : "+v"(lo));
                const int ci = lo >> 2, part = lo & 3;
                float t[4];
#pragma unroll
                for (int e = 0; e < 4; ++e) t[e] = (part + 4 * e == ci) ? 1.f : 0.f;
#pragma unroll
                for (int m = 15; m >= 1; --m) {
                    const int src = __float_as_int(t[m >> 2]);
                    float tm;
                    switch (m & 3) {
                        case 0: tm = __int_as_float(__builtin_amdgcn_update_dpp(0, src, 0x00, 0xF, 0xF, true)); break;
                        case 1: tm = __int_as_float(__builtin_amdgcn_update_dpp(0, src, 0x55, 0xF, 0xF, true)); break;
                        case 2: tm = __int_as_float(__builtin_amdgcn_update_dpp(0, src, 0xAA, 0xF, 0xF, true)); break;
                        default: tm = __int_as_float(__builtin_amdgcn_update_dpp(0, src, 0xFF, 0xF, 0xF, true)); break;
                    }
                    const f32x4 a4 = *(const LAS f32x4*)((const LAS float*)(lds + AABT) + m * 16 + part * 4);
#pragma unroll
                    for (int e = 0; e < 4; ++e) if (4 * e < m) t[e] = fmaf(a4[e], tm, t[e]);
                }
#pragma unroll
                for (int e = 0; e < 4; ++e) *(LAS bf16*)(lds + TT + (ci * 32 + part + 4 * e) * 2) = (bf16)f2bf(t[e]);
            }
        } else if (cc >= 0) {
            const LAS unsigned char* S0 = lds + (cc % 3) * SET;
            const int vt = wave - 4;
            f32x4 sat = (f32x4){0.f, 0.f, 0.f, 0.f};
            {
                const bf16x8 a = *(const LAS bf16x8*)(lds + W2T + (l15 * 32 + q * 8) * 2);
                const bf16x8 bv = *(const LAS bf16x8*)(S0 + VT + ((vt * 16 + l15) * 32 + q * 8) * 2);
                sat = MFMA16(a, bv, sat);
            }
            f32x4 yt = (f32x4){0.f, 0.f, 0.f, 0.f};
#pragma unroll
            for (int s = 0; s < 2; ++s) {
                u32x4 sb; sb.x = pk2(acc[2 * s][0], acc[2 * s][1]); sb.y = pk2(acc[2 * s][2], acc[2 * s][3]); sb.z = pk2(acc[2 * s + 1][0], acc[2 * s + 1][1]); sb.w = pk2(acc[2 * s + 1][2], acc[2 * s + 1][3]);
                const bf16x8 sB = __builtin_bit_cast(bf16x8, sb);
                u32x4 pa; { const u32x2 lo = *(const LAS u32x2*)(lds + P1T + (l15 * 72 + 32 * s + 4 * q) * 2), hi = *(const LAS u32x2*)(lds + P1T + (l15 * 72 + 32 * s + 16 + 4 * q) * 2); pa = (u32x4){lo.x, lo.y, hi.x, hi.y}; }
                u32x4 ra; { const u32x2 lo = *(const LAS u32x2*)(S0 + RH + (l15 * 72 + 32 * s + 4 * q) * 2), hi = *(const LAS u32x2*)(S0 + RH + (l15 * 72 + 32 * s + 16 + 4 * q) * 2); ra = (u32x4){lo.x, lo.y, hi.x, hi.y}; }
                sat = MFMA16(__builtin_bit_cast(bf16x8, pa), sB, sat);
                yt = MFMA16(__builtin_bit_cast(bf16x8, ra), sB, yt);
            }
            const u32x2 vv = *(const LAS u32x2*)(S0 + VT + ((vt * 16 + l15) * 32 + 4 * q) * 2);
            u32x4 b2; b2.x = pk2(sat[0], sat[1]); b2.y = pk2(sat[2], sat[3]); b2.z = vv.x; b2.w = vv.y;
            const bf16x8 B2 = __builtin_bit_cast(bf16x8, b2);
            yt = MFMA16(*(const LAS bf16x8*)(lds + ABK + (cc & 1) * 1024 + (l15 * 32 + q * 8) * 2), B2, yt);
#pragma unroll
            for (int kt = 0; kt < 4; ++kt) {
                acc[kt] = MFMA16(*(const LAS bf16x8*)(S0 + BKT + ((kt * 16 + l15) * 32 + q * 8) * 2), B2, acc[kt]);
                acc[kt] = acc[kt] * *(const LAS f32x4*)(S0 + GAM + (kt * 16 + 4 * q) * 4);
            }
            LAS float* yb = (LAS float*)(lds + YB) + vt * 16 + l15;
#pragma unroll
            for (int r = 0; r < 4; ++r) yb[(4 * q + r) * 64] = yt[r];
        }
        BAR_LDS();
        if (wave < 4) {
            if (c2 >= 0 && c2 < NCH) {
                const LAS unsigned char* S2 = lds + (c2 % 3) * SET;
                const int ia = wave == 3 ? AH : (wave == 1 ? KH : BH);
                f32x4 d = (f32x4){0.f, 0.f, 0.f, 0.f};
#pragma unroll
                for (int s = 0; s < 2; ++s) {
                    const bf16x8 a = *(const LAS bf16x8*)(lds + ia + (l15 * 72 + s * 32 + q * 8) * 2);
                    bf16x8 bb;
                    if (wave < 2) bb = *(const LAS bf16x8*)(S2 + RH + (l15 * 72 + s * 32 + q * 8) * 2);
                    else if (wave == 2) bb = *(const LAS bf16x8*)(lds + AH + (l15 * 72 + s * 32 + q * 8) * 2);
                    else bb = *(const LAS bf16x8*)(lds + KH + (l15 * 72 + s * 32 + q * 8) * 2);
                    d = MFMA16(a, bb, d);
                }
                if (wave < 2) {
                    float o[4];
#pragma unroll
                    for (int r = 0; r < 4; ++r) o[r] = (4 * qo + r <= l15o) ? d[r] : 0.f;
                    u32x2 w; w.x = pk2(o[0], o[1]); w.y = pk2(o[2], o[3]);
                    *(LAS u32x2*)(lds + ABK + (c2 & 1) * 1024 + (l15 * 32 + q * 8 + wave * 4) * 2) = w;
                } else if (wave == 2) {
                    f32x4 o;
#pragma unroll
                    for (int r = 0; r < 4; ++r) o[r] = (4 * qo + r < l15o) ? d[r] : 0.f;
#pragma unroll
                    for (int r = 0; r < 4; ++r) *(LAS float*)(lds + AABT + (l15 * 16 + r * 4 + q) * 4) = o[r];
                } else {
                    float o[4];
#pragma unroll
                    for (int r = 0; r < 4; ++r) o[r] = (l15o < 4 * qo + r) ? d[r] : 0.f;
                    u32x2 w; w.x = pk2(o[0], o[1]); w.y = pk2(o[2], o[3]);
                    *(LAS u32x2*)(lds + AAK + (c2 & 1) * 1024 + (l15 * 32 + 4 * q) * 2) = w;
                }
            }
        } else {
            if (c1 >= 0 && c1 < NCH) {
                const bf16x8 bt = *(const LAS bf16x8*)(lds + TT + (l15 * 32 + q * 8) * 2);
                const int mt = wave - 4;
                f32x4 d = (f32x4){0.f, 0.f, 0.f, 0.f};
                d = MFMA16(*(const LAS bf16x8*)(lds + AHT + (c1 & 1) * 4096 + ((mt * 16 + l15) * 32 + q * 8) * 2), bt, d);
                { u32x2 w; w.x = pk2(d[0], d[1]); w.y = pk2(d[2], d[3]); *(LAS u32x2*)(lds + P1T + (l15 * 72 + mt * 16 + 4 * q) * 2) = w; }
                if (wave == 4) {
                    f32x4 d2 = (f32x4){0.f, 0.f, 0.f, 0.f};
                    d2 = MFMA16(*(const LAS bf16x8*)(lds + AAK + (c1 & 1) * 1024 + (l15 * 32 + q * 8) * 2), bt, d2);
                    u32x2 w; w.x = pk2(d2[0], d2[1]); w.y = pk2(d2[2], d2[3]);
                    *(LAS u32x2*)(lds + W2T + (l15 * 32 + 4 * q) * 2) = w;
                }
            }
            if (cc >= TC_ / 16) {
                const int t2 = tid - 256, fi = t2 >> 4, part = t2 & 15;
                const int cl1 = cc - TC_ / 16, pos = dir ? T_ - 1 - (cl1 * 16 + fi) : cl1 * 16 + fi;
                const f32x4 yv = *(const LAS f32x4*)((const LAS float*)(lds + YB) + fi * 64 + part * 4);
                u32x2 yw; yw.x = pk2(yv.x, yv.y); yw.y = pk2(yv.z, yv.w);
                *(u32x2*)(Y + ((size_t)b * T_ + (size_t)((pos & 63) * 64 + (pos >> 6))) * 512 + h * 64 + part * 4) = yw;
            }
        }
        BAR_LDS();
    }
}

__device__ __forceinline__ void phase_combine(const Params& p) {
    const int lane = threadIdx.x & 63, wave = threadIdx.x >> 6;
    const int gw = blockIdx.x * NW + wave, NGW = gridDim.x * NW;
    const bf16* u = (const bf16*)(p.ws + OFF_U); const bf16* HFB = (const bf16*)(p.ws + OFF_MIX);
    const bf16* Y = (const bf16*)p.out; const float* BON = (const float*)(p.ws + OFF_BON);
    const bf16* RWP = (const bf16*)(p.ws + OFF_RWP); const bf16* Gb = (const bf16*)(p.ws + OFF_G);
    const float* ml_norm_g = p.in[11]; const float* ln_g = p.in[21]; const float* ln_b = p.in[22];
    bf16* mix = (bf16*)(p.ws + OFF_MIX);
    const int c8 = lane * 8;
    for (int rl = gw; rl < NLAT; rl += NGW) {
        const int b = rl / T_, t = rl % T_, pp = (t & 63) * 64 + (t >> 6);
        const size_t lrow = (size_t)b * T_ + pp;
        const u32x4 hf = *(const u32x4*)(HFB + (size_t)rl * 1024 + c8), hb = *(const u32x4*)(HFB + (size_t)rl * 1024 + 512 + c8);
        const u32x4 zo = rl < ZOX_ROWS ? *(const u32x4*)((const bf16*)(p.ws + OFF_ZOX) + (size_t)rl * 512 + c8) : *(const u32x4*)(u + ((size_t)NCTX + rl) * UC + 1536 + c8);
        float hs[8], ss = 0.f;
#pragma unroll
        for (int e = 0; e < 4; ++e) { hs[2 * e] = bflo(hf[e]) + bflo(hb[e]); hs[2 * e + 1] = bfhi(hf[e]) + bfhi(hb[e]); ss += hs[2 * e] * hs[2 * e] + hs[2 * e + 1] * hs[2 * e + 1]; }
        ss += __shfl_xor(ss, 1); ss += __shfl_xor(ss, 2); ss += __shfl_xor(ss, 4); ss += __shfl_xor(ss, 8);
        const float rs_ = rsqrtf(ss * (1.f / 128.f) + 1e-6f);
        float o[8];
#pragma unroll
        for (int e = 0; e < 4; ++e) { o[2 * e] = hs[2 * e] * rs_ * ml_norm_g[c8 + 2 * e] * sigmoidf_(bflo(zo[e])); o[2 * e + 1] = hs[2 * e + 1] * rs_ * ml_norm_g[c8 + 2 * e + 1] * sigmoidf_(bfhi(zo[e])); }
        { u32x4 w; w.x = pk2(o[0], o[1]); w.y = pk2(o[2], o[3]); w.z = pk2(o[4], o[5]); w.w = pk2(o[6], o[7]); *(u32x4*)(mix + (size_t)rl * D_ + c8) = w; }
        const u32x4 yf = *(const u32x4*)(Y + (size_t)rl * 512 + c8), yb = *(const u32x4*)(Y + ((size_t)NLAT + rl) * 512 + c8);
        float y[8];
#pragma unroll
        for (int e = 0; e < 4; ++e) { y[2 * e] = bflo(yf[e]) + bflo(yb[e]); y[2 * e + 1] = bfhi(yf[e]) + bfhi(yb[e]); }
        float sm = 0.f;
#pragma unroll
        for (int e = 0; e < 8; ++e) sm += y[e];
        sm += __shfl_xor(sm, 1); sm += __shfl_xor(sm, 2); sm += __shfl_xor(sm, 4);
        const float mean = sm * (1.f / 64.f);
        float sv = 0.f;
#pragma unroll
        for (int e = 0; e < 8; ++e) { y[e] -= mean; sv += y[e] * y[e]; }
        sv += __shfl_xor(sv, 1); sv += __shfl_xor(sv, 2); sv += __shfl_xor(sv, 4);
        const float rstd = rsqrtf(sv * (1.f / 64.f) + 64e-5f);
        const int head = lane >> 3;
        const float bonus = BON[lrow * 8 + head] + BON[((size_t)NLAT + lrow) * 8 + head];
        const u32x4 vs = *(const u32x4*)(RWP + ((size_t)NCTX + lrow) * RWP_LD + 1024 + c8), gg = *(const u32x4*)(Gb + lrow * 512 + c8);
#pragma unroll
        for (int e = 0; e < 4; ++e) {
            o[2 * e] = (y[2 * e] * rstd * ln_g[c8 + 2 * e] + ln_b[c8 + 2 * e] + bonus * bflo(vs[e])) * bflo(gg[e]);
            o[2 * e + 1] = (y[2 * e + 1] * rstd * ln_g[c8 + 2 * e + 1] + ln_b[c8 + 2 * e + 1] + bonus * bfhi(vs[e])) * bfhi(gg[e]);
        }
        { u32x4 w; w.x = pk2(o[0], o[1]); w.y = pk2(o[2], o[3]); w.z = pk2(o[4], o[5]); w.w = pk2(o[6], o[7]); *(u32x4*)(mix + (size_t)rl * D_ + 512 + c8) = w; }
    }
}

__device__ __forceinline__ void phase_norm2(const Params& p, LAS unsigned char* lds) {
    const int tid = threadIdx.x, wave = tid >> 6;
    const int gw = blockIdx.x * NW + wave, NGW = gridDim.x * NW;
    const float* g = p.in[24]; const float* router_w = p.in[25]; const float* mod = (const float*)(p.ws + OFF_MOD);
    const float* h = p.out;
    unsigned char* xn2 = p.ws + OFF_XN2;
    float* aff = (float*)(p.ws + OFF_AFF);
    LAS float* RWT = (LAS float*)lds;
    __syncthreads();
    for (int i = tid; i < 16384; i += NT) RWT[(i & 15) * 1024 + (i >> 4)] = router_w[i];
    __syncthreads();
#pragma unroll 1
    for (int rl = gw; rl < NLAT; rl += NGW) {
        int lane = tid & 63; asm volatile("" : "+v"(lane));
        const int b = rl / T_, t = rl % T_;
        const float* sh2 = mod + b * MOD6 + 3 * D_, *sc2 = sh2 + D_;
        f32x4 o[4]; float s = 0.f;
#pragma unroll
        for (int j = 0; j < 4; ++j) { o[j] = *(const f32x4*)(h + (size_t)rl * D_ + j * 256 + lane * 4); s += (o[j].x * o[j].x + o[j].y * o[j].y) + (o[j].z * o[j].z + o[j].w * o[j].w); }
        const float rstd = rsqrtf(wave_sum(s) * (1.f / D_) + 1e-6f);
#pragma unroll
        for (int j = 0; j < 4; ++j) {
            const int d = j * 256 + lane * 4;
            const f32x4 gg = *(const f32x4*)(g + d), ss = *(const f32x4*)(sc2 + d), hh = *(const f32x4*)(sh2 + d);
            o[j] = o[j] * rstd * gg * (ss + 1.f) + hh;
            *(unsigned*)(xn2 + (size_t)rl * D_ + d) = pk4_f8(o[j].x, o[j].y, o[j].z, o[j].w);
        }
        float lg[16];
        const LAS float* RW = RWT + lane * 4;
#pragma unroll
        for (int e = 0; e < 16; ++e) {
            float a0 = 0.f;
#pragma unroll
            for (int j = 0; j < 4; ++j) { const f32x4 w4 = *(const LAS f32x4*)(RW + e * 1024 + j * 256); a0 += (o[j].x * w4.x + o[j].y * w4.y) + (o[j].z * w4.z + o[j].w * w4.w); }
            lg[e] = a0;
        }
        float x8[8], x4[4], x2[2], x1;
#pragma unroll
        for (int i = 0; i < 8; ++i) { const bool up = lane & 32; const float send = up ? lg[i] : lg[i + 8], keep = up ? lg[i + 8] : lg[i]; x8[i] = keep + __shfl_xor(send, 32); }
#pragma unroll
        for (int i = 0; i < 4; ++i) { const bool up = lane & 16; const float send = up ? x8[i] : x8[i + 4], keep = up ? x8[i + 4] : x8[i]; x4[i] = keep + __shfl_xor(send, 16); }
#pragma unroll
        for (int i = 0; i < 2; ++i) { const bool up = lane & 8; const float send = up ? x4[i] : x4[i + 2], keep = up ? x4[i + 2] : x4[i]; x2[i] = keep + __shfl_xor(send, 8); }
        { const bool up = lane & 4; const float send = up ? x2[0] : x2[1], keep = up ? x2[1] : x2[0]; x1 = keep + __shfl_xor(send, 4); }
        x1 += __shfl_xor(x1, 2); x1 += __shfl_xor(x1, 1);
        float mx = x1;
        mx = fmaxf(mx, __shfl_xor(mx, 4)); mx = fmaxf(mx, __shfl_xor(mx, 8)); mx = fmaxf(mx, __shfl_xor(mx, 16)); mx = fmaxf(mx, __shfl_xor(mx, 32));
        const float ex = expf(x1 - mx);
        float sm = ex;
        sm += __shfl_xor(sm, 4); sm += __shfl_xor(sm, 8); sm += __shfl_xor(sm, 16); sm += __shfl_xor(sm, 32);
        const int e = ((lane >> 5) & 1) * 8 + ((lane >> 4) & 1) * 4 + ((lane >> 3) & 1) * 2 + ((lane >> 2) & 1);
        if ((lane & 3) == 0) aff[((size_t)b * E_ + e) * T_ + t] = ex / sm;
    }
}

__device__ __forceinline__ void phase_topk(const Params& p, LAS unsigned char* lds) {
    LAS unsigned* hist = (LAS unsigned*)lds;
    LAS unsigned* wsum = hist + 256;
    LAS unsigned* bc = wsum + 8;
    const float* aff = (const float*)(p.ws + OFF_AFF);
    int* idx = (int*)(p.ws + OFF_IDX); float* gate = (float*)(p.ws + OFF_GATE); int* sel = (int*)(p.ws + OFF_SEL);
    const int tid = threadIdx.x, lane = tid & 63, wave = tid >> 6;
    for (int be = blockIdx.x; be < B_ * E_; be += gridDim.x) {
        const int b = be / E_, e = be % E_;
        unsigned key[8];
        { const u32x4 k0 = *(const u32x4*)(aff + (size_t)be * T_ + tid * 8), k1 = *(const u32x4*)(aff + (size_t)be * T_ + tid * 8 + 4);
          key[0] = k0.x; key[1] = k0.y; key[2] = k0.z; key[3] = k0.w; key[4] = k1.x; key[5] = k1.y; key[6] = k1.z; key[7] = k1.w; }
        unsigned prefix = 0u, need = CAP;
#pragma unroll 1
        for (int pass = 0; pass < 4; ++pass) {
            const int shift = 24 - 8 * pass;
            __syncthreads();
            if (tid < 256) hist[tid] = 0u;
            __syncthreads();
#pragma unroll
            for (int i = 0; i < 8; ++i) if (pass == 0 || (key[i] >> (shift + 8)) == prefix) __hip_atomic_fetch_add(&hist[(key[i] >> shift) & 255u], 1u, __ATOMIC_RELAXED, __HIP_MEMORY_SCOPE_WORKGROUP);
            __syncthreads();
            if (wave == 0) {
                const unsigned h0 = hist[4 * lane], h1 = hist[4 * lane + 1], h2 = hist[4 * lane + 2], h3 = hist[4 * lane + 3];
                const unsigned s = h0 + h1 + h2 + h3;
                unsigned suf = s;
#pragma unroll
                for (int o = 1; o < 64; o <<= 1) { const unsigned t = __shfl_down(suf, o); if (lane + o < 64) suf += t; }
                const unsigned above = suf - s;
                if (above < need && need <= suf) {
                    unsigned c = above, bin, nn;
                    if (c + h3 >= need) { bin = 4 * lane + 3; nn = need - c; }
                    else { c += h3; if (c + h2 >= need) { bin = 4 * lane + 2; nn = need - c; }
                    else { c += h2; if (c + h1 >= need) { bin = 4 * lane + 1; nn = need - c; }
                    else { c += h1; bin = 4 * lane; nn = need - c; } } }
                    bc[0] = bin; bc[1] = nn;
                }
            }
            __syncthreads();
            prefix = (prefix << 8) | bc[0]; need = bc[1];
        }
        unsigned cg = 0u, ce = 0u;
#pragma unroll
        for (int i = 0; i < 8; ++i) { cg += key[i] > prefix ? 1u : 0u; ce += key[i] == prefix ? 1u : 0u; }
        unsigned pk = cg | (ce << 16), inc = pk;
#pragma unroll
        for (int o = 1; o < 64; o <<= 1) { const unsigned t = __shfl_up(inc, o); if (lane >= o) inc += t; }
        __syncthreads();
        if (lane == 63) wsum[wave] = inc;
        __syncthreads();
        unsigned base = 0u;
#pragma unroll
        for (int w = 0; w < 8; ++w) base += w < wave ? wsum[w] : 0u;
        unsigned excl = base + inc - pk;
        unsigned gtb = excl & 0xffffu, eqb = excl >> 16;
#pragma unroll
        for (int i = 0; i < 8; ++i) {
            const int t = tid * 8 + i;
            const bool isg = key[i] > prefix, ise = key[i] == prefix;
            const bool take = isg || (ise && eqb < need);
            const int slot = (int)(gtb + (eqb < need ? eqb : need));
            if (take) { idx[e * 4096 + b * CAP + slot] = b * T_ + t; gate[e * 4096 + b * CAP + slot] = __uint_as_float(key[i]); }
            sel[(size_t)be * T_ + t] = take ? slot : -1;
            gtb += isg ? 1u : 0u; eqb += ise ? 1u : 0u;
        }
    }
}

__device__ __forceinline__ void phase_gather(const Params& p) {
    const int lane = threadIdx.x & 63, wave = threadIdx.x >> 6;
    const int gw = blockIdx.x * NW + wave, NGW = gridDim.x * NW;
    const unsigned char* xn2 = p.ws + OFF_XN2; const int* idx = (const int*)(p.ws + OFF_IDX);
    unsigned char* xs = p.ws + OFF_XS;
    for (int r = gw; r < E_ * 4096; r += NGW) *(u32x4*)(xs + (size_t)r * D_ + lane * 16) = *(const u32x4*)(xn2 + (size_t)idx[r] * D_ + lane * 16);
}

__device__ __forceinline__ void phase_final(const Params& p) {
    const int lane = threadIdx.x & 63, wave = threadIdx.x >> 6;
    const int gw = blockIdx.x * NW + wave, NGW = gridDim.x * NW;
    const float* mod = (const float*)(p.ws + OFF_MOD); const float* fg = p.in[29];
    const bf16* ys = (const bf16*)(p.ws + OFF_YS); const int* sel = (const int*)(p.ws + OFF_SEL); const float* aff = (const float*)(p.ws + OFF_AFF);
    float* out = p.out;
    int cs = -1; float cg = 0.f;
    if (gw < NLAT && lane < 16) { const size_t o = ((size_t)(gw / T_) * E_ + lane) * T_ + gw % T_; cs = sel[o]; cg = aff[o]; }
    for (int rl = gw; rl < NLAT; rl += NGW) {
        const int b = rl / T_;
        const int myslot = cs; const float mygate = cg;
        { const int rn = rl + NGW; if (rn < NLAT && lane < 16) { const size_t o = ((size_t)(rn / T_) * E_ + lane) * T_ + rn % T_; cs = sel[o]; cg = aff[o]; } }
        f32x4 hv[4];
#pragma unroll
        for (int j = 0; j < 4; ++j) hv[j] = *(const f32x4*)(out + (size_t)rl * D_ + j * 256 + lane * 4);
        f32x4 acc[4];
#pragma unroll
        for (int j = 0; j < 4; ++j) acc[j] = (f32x4){0.f, 0.f, 0.f, 0.f};
        unsigned mm = (unsigned)__ballot(myslot >= 0) & 0xffffu;
        while (mm) {
            int ee[4]; float gg[4]; const bf16* yr[4];
#pragma unroll
            for (int i = 0; i < 4; ++i) { const bool v = mm != 0u; ee[i] = v ? __builtin_ctz(mm) : ee[0]; mm = v ? (mm & (mm - 1u)) : 0u;
                const int sl = __shfl(myslot, ee[i]); const float gt = __shfl(mygate, ee[i]); gg[i] = v ? gt : 0.f;
                yr[i] = ys + ((size_t)ee[i] * 4096 + b * CAP + sl) * D_ + lane * 4; }
            u32x2 w[4][4];
#pragma unroll
            for (int i = 0; i < 4; ++i)
#pragma unroll
                for (int j = 0; j < 4; ++j) w[i][j] = *(const u32x2*)(yr[i] + j * 256);
#pragma unroll
            for (int i = 0; i < 4; ++i)
#pragma unroll
                for (int j = 0; j < 4; ++j) { acc[j].x += gg[i] * bflo(w[i][j].x); acc[j].y += gg[i] * bfhi(w[i][j].x); acc[j].z += gg[i] * bflo(w[i][j].y); acc[j].w += gg[i] * bfhi(w[i][j].y); }
        }
        const float* g2 = mod + b * MOD6 + 5 * D_;
        f32x4 o[4]; float s2 = 0.f;
#pragma unroll
        for (int j = 0; j < 4; ++j) { const int d = j * 256 + lane * 4; o[j] = hv[j] + *(const f32x4*)(g2 + d) * acc[j];
            s2 += (o[j].x * o[j].x + o[j].y * o[j].y) + (o[j].z * o[j].z + o[j].w * o[j].w); }
        const float rstd = rsqrtf(wave_sum(s2) * (1.f / D_) + 1e-6f);
#pragma unroll
        for (int j = 0; j < 4; ++j) { const int d = j * 256 + lane * 4; *(f32x4*)(out + (size_t)rl * D_ + d) = o[j] * rstd * *(const f32x4*)(fg + d); }
    }
}


#define GAS __attribute__((address_space(1)))
#define XB_TMO      128
#define XB_XCNT(j)  (256  + 64 * (j))
#define XB_XSUB(j)  (1280 + 64 * (j))
#define XB_XGEN(j)  (2304 + 64 * (j))
#define XB_TOP      3328
#define XB_TOPGEN   3392
#define XCD_BAR_WORDS 3456
#define XB_SPIN_CAP (1u << 24)

__device__ __forceinline__ unsigned xb_ld(unsigned* p)              { return __hip_atomic_load(p, __ATOMIC_RELAXED, __HIP_MEMORY_SCOPE_AGENT); }
__device__ __forceinline__ unsigned xb_add(unsigned* p, unsigned v) { return __hip_atomic_fetch_add(p, v, __ATOMIC_RELAXED, __HIP_MEMORY_SCOPE_AGENT); }
__device__ __forceinline__ unsigned xb_xcc_id() { return (unsigned)__builtin_amdgcn_s_getreg((3 << 11) | 20) & 0xFu; }
#define XB_SPIN(cond, bar) do { unsigned _sp = 0; while (cond) { __builtin_amdgcn_s_sleep(1); \
    if ((++_sp & 255u) == 0u) { if (xb_ld(&(bar)[XB_TMO])) break; if (_sp > XB_SPIN_CAP) { atomicAdd(&(bar)[XB_TMO], 1u); break; } } } } while (0)

struct XcdBarrier {
    unsigned* bar; unsigned x;
    volatile LAS unsigned* st;
};

__device__ __forceinline__ XcdBarrier xcd_barrier_post(unsigned* bar, volatile LAS unsigned* st) {
    XcdBarrier b; b.bar = bar; b.x = xb_xcc_id(); b.st = st;
    if (threadIdx.x == 0) (void)xb_add(&bar[XB_XCNT(b.x)], 1u);
    return b;
}
__device__ __forceinline__ void xcd_barrier_complete(unsigned* bar, unsigned x, unsigned& nloc, unsigned& nx) {
    const unsigned G = gridDim.x * gridDim.y * gridDim.z;
    unsigned sum, cnt, mine, sp = 0u;
    for (;;) {
        sum = 0u; cnt = 0u; mine = 0u;
#pragma unroll
        for (unsigned j = 0; j < 16; ++j) { const unsigned c = xb_ld(&bar[XB_XCNT(j)]); sum += c; cnt += (c > 0u) ? 1u : 0u; mine = (j == x) ? c : mine; }
        if (sum == G) break;
        __builtin_amdgcn_s_sleep(1);
        if ((++sp & 255u) == 0u) { if (xb_ld(&bar[XB_TMO])) break; if (sp > XB_SPIN_CAP) { atomicAdd(&bar[XB_TMO], 1u); break; } }
    }
    nloc = mine > 0u ? mine : 1u; nx = cnt > 0u ? cnt : 1u;
}

__device__ __forceinline__ void xcd_barrier(const XcdBarrier& b) {
    asm volatile("s_waitcnt vmcnt(0)" ::: "memory");
    __syncthreads();
    if (threadIdx.x == 0) {
        unsigned* bar = b.bar;
        __builtin_amdgcn_s_waitcnt(0);
        unsigned nloc = b.st[0], nx = b.st[1];
        if (nloc == 0u) { xcd_barrier_complete(bar, b.x, nloc, nx); b.st[0] = nloc; b.st[1] = nx; }
        const unsigned old = xb_add(&bar[XB_XSUB(b.x)], 1u);
        const unsigned gen = old / nloc;
        if (old + 1u == (gen + 1u) * nloc) {
            __builtin_amdgcn_fence(__ATOMIC_RELEASE, "agent");
            asm volatile("s_waitcnt vmcnt(0)" ::: "memory");
            const unsigned og = xb_add(&bar[XB_TOP], 1u);
            const unsigned tg = og / nx;
            if (og + 1u == (tg + 1u) * nx) xb_add(&bar[XB_TOPGEN], 1u);
            else XB_SPIN(xb_ld(&bar[XB_TOPGEN]) == tg, bar);
            __builtin_amdgcn_fence(__ATOMIC_ACQUIRE, "agent");
            xb_add(&bar[XB_XGEN(b.x)], 1u);
            asm volatile("s_waitcnt vmcnt(0)" ::: "memory");
        } else {
            XB_SPIN(xb_ld(&bar[XB_XGEN(b.x)]) == gen, bar);
            __builtin_amdgcn_fence(__ATOMIC_ACQUIRE, "agent");
            asm volatile("s_waitcnt vmcnt(0)" ::: "memory");
        }
    }
    __syncthreads();
}


__device__ __forceinline__ void phase_expert_dynamic(const Params& p, LAS unsigned char* lds, volatile LAS unsigned* misc, unsigned* xctr) {
    const int lane = threadIdx.x & 63, wave = threadIdx.x >> 6; LAS float* scr = (LAS float*)(lds + wave * 16384);
    constexpr int XCH = 64;
    static_assert(EXP_ITEMS % XCH == 0, "chunking");
    __syncthreads();
    if (threadIdx.x == 0) misc[8] = xb_add(xctr, 1u);
    __syncthreads();
    unsigned cur = misc[8];
#pragma unroll 1
    while (cur < (unsigned)(EXP_ITEMS / XCH)) {
        unsigned nxt = 0u; if (threadIdx.x == 0) nxt = xb_add(xctr, 1u);
        const int it0 = (int)cur * XCH + wave;
        XRaw Ra, Rb;
        expert_load(p, it0, lane, Ra);
#pragma unroll 1
        for (int j = 0; j < XCH / NW; j += 2) {
            expert_load(p, it0 + (j + 1) * NW, lane, Rb);
            expert_finish(p, scr, it0 + j * NW, lane, Ra);
            if (j + 2 < XCH / NW) expert_load(p, it0 + (j + 2) * NW, lane, Ra);
            expert_finish(p, scr, it0 + (j + 1) * NW, lane, Rb);
        }
        __syncthreads();
        if (threadIdx.x == 0) misc[8] = nxt;
        __syncthreads();
        cur = misc[8];
    }
}

constexpr int N_PHASES = 17;
__global__ void __launch_bounds__(NT) mega(Params p) {
    extern __shared__ __attribute__((aligned(16))) unsigned char lds_raw[];
    LAS unsigned char* lds = (LAS unsigned char*)lds_raw;
    cg::grid_group grid = cg::this_grid();
    unsigned char* ws = p.ws;
    const int G = gridDim.x;
    const int lo = p.ph_lo, hi = p.ph_hi;
    volatile LAS unsigned* misc = (volatile LAS unsigned*)(lds + LDS_BYTES - 64);
    if (threadIdx.x < 16) misc[threadIdx.x] = 0u;
    __syncthreads();
    XcdBarrier bar; bar.bar = (unsigned*)(ws + OFF_BAR); bar.x = 0; bar.st = nullptr;
    if (hi - lo > 1) bar = xcd_barrier_post((unsigned*)(ws + OFF_BAR), misc);
#ifndef PHMASK
#define PHMASK 0xFFFFFFFFu
#endif
#define IN(k) (((PHMASK >> (k)) & 1) && lo <= (k) && (k) < hi)
#define SEAM(k) do { if (IN(k) && IN((k) + 1)) { if ((k) == 0 && G != 256) grid.sync(); else xcd_barrier(bar); } } while (0)
#ifndef PROBE_PH
#define PROBE_PH (-1)
#endif
#define RUNPH(k, ...) do { if (IN(k)) { __VA_ARGS__; if (PROBE_PH == (k)) { xcd_barrier(bar); __VA_ARGS__; } } } while (0)
    RUNPH(0, phase_prep(p, lds));
    SEAM(0);
    RUNPH(1, phase_norm1(p));
    SEAM(1);
    RUNPH(2, { pg8::Gemm g{(const bf16*)(ws + OFF_XN1), (const bf16*)(ws + OFF_WIN), NROW, UC, D_}; pg8::StaticOrder S; S.init(NROW, UC, G, blockIdx.x);
                 EpiU E{(bf16*)(ws + OFF_U), UC}; pg8::gemm_phase<EpiU, pg8::StaticOrder, true, true>(lds, g, S, E); });
    SEAM(2);
    RUNPH(3, phase_qk(p));
    RUNPH(4, {
        constexpr int NTILE = 128 + 2048;
        for (int t = blockIdx.x; t < NTILE; t += G) rwkv_prep_tile(p, lds, t);
    });
    SEAM(4);
    RUNPH(5, {
        unsigned* mdone = (unsigned*)(ws + OFF_BAR) + 3520; unsigned* xctr = mdone + 64;
        if (G == 256) {
            if (blockIdx.x < 128) rwkv_chunk_item(p, lds, blockIdx.x);
            else { mlstm_item(p, lds, blockIdx.x - 128); __syncthreads(); if (threadIdx.x == 0) { __threadfence(); xb_add(mdone, 1u); } }
            if (threadIdx.x == 0) { while (xb_ld(mdone) < 128u) __builtin_amdgcn_s_sleep(8); }
            __syncthreads();
        } else {
            for (int it = blockIdx.x; it < 128; it += G) mlstm_item(p, lds, it);
            __syncthreads();
            for (int it = blockIdx.x; it < 128; it += G) rwkv_chunk_item(p, lds, it);
            xcd_barrier(bar);
        }
        phase_expert_dynamic(p, lds, misc, xctr);
    });
    SEAM(5);
    RUNPH(6, phase_combine(p));
    SEAM(6);
    RUNPH(7, { pg8::Gemm g{(const bf16*)(ws + OFF_MIX), (const bf16*)(ws + OFF_WOUT), NLAT, D_, D_}; pg8::StaticOrder S; S.init(NLAT, D_, G, blockIdx.x);
                 EpiH E{p.in[0], (const float*)(ws + OFF_MOD), p.out}; pg8::gemm_phase<EpiH, pg8::StaticOrder, true, true>(lds, g, S, E); });
    SEAM(7);
    RUNPH(9, phase_norm2(p, lds));
    SEAM(9);
    RUNPH(10, phase_topk(p, lds));
    SEAM(10);
#pragma unroll 1
    for (int gi = 0; gi < NG; ++gi) {
        RUNPH(12 + 2 * gi, {
            pg8::Gemm g{(const bf16*)(ws + OFF_XN2), (const bf16*)(ws + OFF_W13 + (size_t)gi * EG * 5632 * D_), EG * 4096, EG * 5632, D_ / 2, 0x7A7A7A7A, 0x7F7F7F7F, (const int*)(ws + OFF_IDX) + (size_t)gi * EG * 4096};
            ExpertOrder S{22, G, (int)blockIdx.x}; EpiHid E{ws + OFF_HID, 22};
            pg8::gemm_phase<EpiHid, ExpertOrder, true, true, true, true>(lds, g, S, E); });
        SEAM(12 + 2 * gi);
        RUNPH(13 + 2 * gi, {
            pg8::Gemm g{(const bf16*)(ws + OFF_HID), (const bf16*)(ws + OFF_W2 + (size_t)gi * EG * D_ * DE), EG * 4096, EG * D_, DE / 2, 0x79797979, 0x7C7C7C7C};
            ExpertOrder S{4, G, (int)blockIdx.x}; EpiYs E{(bf16*)(ws + OFF_YS) + (size_t)gi * EG * 4096 * D_, (const float*)(ws + OFF_GATE) + (size_t)gi * EG * 4096, 4};
            pg8::gemm_phase<EpiYs, ExpertOrder, true, true, true>(lds, g, S, E); });
        SEAM(13 + 2 * gi);
    }
    if (IN(16)) phase_final(p);
}
}

#ifndef MK_SPLIT
#define MK_SPLIT 0
#endif
extern "C" void kernel_launch(void* const* d_in, const int* in_sizes, int n_in, void* d_out, int out_size, void* d_ws, size_t ws_size, hipStream_t stream) {
    static int grid = 0;
    if (grid == 0) {
        int dev = 0, cus = 0, per_cu = 0;
        (void)hipGetDevice(&dev);
        (void)hipDeviceGetAttribute(&cus, hipDeviceAttributeMultiprocessorCount, dev);
        (void)hipFuncSetAttribute((const void*)mega, hipFuncAttributeMaxDynamicSharedMemorySize, LDS_BYTES);
        (void)hipOccupancyMaxActiveBlocksPerMultiprocessor(&per_cu, (const void*)mega, NT, LDS_BYTES);
        if (per_cu < 1) { fprintf(stderr, "kernel_launch: occupancy query reports %d blocks per CU\n", per_cu); per_cu = 1; }
        grid = cus * 1;
        if (ws_size < WS_END) { fprintf(stderr, "kernel_launch: workspace too small (%zu < %zu)\n", ws_size, (size_t)WS_END); grid = -1; }
    }
    if (grid < 0) return;
    if (hipMemsetAsync((char*)d_ws + OFF_BAR, 0, 16384, stream) != hipSuccess) { fprintf(stderr, "kernel_launch: memset of the barrier words failed\n"); return; }
    Params p{};
    for (int i = 0; i < 30; ++i) p.in[i] = (const float*)d_in[i];
    p.out = (float*)d_out; p.ws = (unsigned char*)d_ws;
#if MK_SPLIT
    for (int ph = 0; ph < N_PHASES; ++ph) { p.ph_lo = ph; p.ph_hi = ph + 1; hipLaunchKernelGGL(mega, dim3(grid), dim3(NT), LDS_BYTES, stream, p); }
#else
    p.ph_lo = 0; p.ph_hi = N_PHASES;
    void* args[] = {&p};
    hipError_t e = hipLaunchCooperativeKernel((const void*)mega, dim3(grid), dim3(NT), args, LDS_BYTES, stream);
    if (e != hipSuccess) fprintf(stderr, "cooperative launch failed: %s (grid %d)\n", hipGetErrorString(e), grid);
#endif
}
```

```cpp
#include <hip/hip_runtime.h>
#include <hip/hip_cooperative_groups.h>
#include <stdint.h>
#include <cstdio>
namespace cg = cooperative_groups;

namespace pg8 {
#define PG8_LAS __attribute__((address_space(3)))
typedef unsigned short bf16_t;
typedef short bf16x8 __attribute__((ext_vector_type(8)));
typedef float f32x4 __attribute__((ext_vector_type(4)));
typedef unsigned u32x4 __attribute__((ext_vector_type(4)));
constexpr int BM = 256, BK = 64, HALF = 128, HTB = HALF * BK * 2  , STAGE_BYTES = 8 * HTB, NXCD = 8, WGM = 8;

__host__ __device__ __forceinline__ int lds_byte(int r, int c) { const int st = (r >> 4) * 2 + (c >> 5), rr = r & 15, cc = c & 31, ob = rr * 64 + cc * 2; return st * 1024 + (ob ^ (((ob >> 9) & 1) << 5)); }
__host__ __device__ __forceinline__ void stage_rc(int b, int& R, int& C) { const int st = b / 1024, sb = b % 1024, swz = sb ^ (((sb >> 9) & 1) << 5); R = (st >> 1) * 16 + swz / 64; C = (st & 1) * 32 + (swz % 64) / 2; }
__host__ __device__ __forceinline__ int perm32(int rho) { const int n = rho >> 4, i = rho & 15; return 8 * (i >> 2) + 4 * n + (i & 3); }

struct Unit { int pm, pn; };
struct Gemm { const bf16_t* A; const bf16_t* Bt; int M, N, K; int sa, sb; const int* gidx; };
typedef int i32x8 __attribute__((ext_vector_type(8)));
typedef int i32x4v __attribute__((ext_vector_type(4)));
__device__ __forceinline__ i32x8 cat8(bf16x8 a, bf16x8 b) { const i32x4v x = __builtin_bit_cast(i32x4v, a), y = __builtin_bit_cast(i32x4v, b); return __builtin_shufflevector(x, y, 0, 1, 2, 3, 4, 5, 6, 7); }

struct StaticOrder {
    int nM, nN, nwg, G, c;
    __host__ __device__ void init(int M, int N, int G_, int c_) { nM = M / BM; nN = N / BM; nwg = nM * nN; G = G_; c = c_; }
    __host__ __device__ bool next(int i, Unit& u) const {
        const long L = (long)i * G + c; if (L >= nwg) return false;
        int wgid = (int)L; { const int q = nwg / NXCD, r = nwg % NXCD, xcd = wgid % NXCD, off = wgid / NXCD; wgid = (xcd < r ? xcd * (q + 1) : r * (q + 1) + (xcd - r) * q) + off; }
        const int nig = WGM * nN, gid = wgid / nig, fm = gid * WGM, gsz = (nM - fm) < WGM ? (nM - fm) : WGM;
        u.pm = fm + ((wgid % nig) % gsz); u.pn = (wgid % nig) / gsz; return true;
    }
    __device__ __forceinline__ void a_ready(const Unit&) const {}
    __device__ __forceinline__ void done(const Unit&) const {}
};


template <class Epi, class Sched, bool ALIGN_EPI = false, bool SP2 = false, bool F8 = false, bool GATHER = false>
__device__ __forceinline__ void gemm_phase(PG8_LAS unsigned char* lds, const Gemm g, const Sched& S, const Epi& E) {
    const int tid = threadIdx.x, wid = __builtin_amdgcn_readfirstlane(tid >> 6), lane = tid & 63, wr = wid >> 2, wc = wid & 3, fr = lane & 15, fq = lane >> 4;
    const int K = g.K, nt = K / BK;
    unsigned voffA[2], voffB[2]; int gR[2]; unsigned gC[2];
#pragma unroll
    for (int i = 0; i < 2; ++i) { int R, C; stage_rc(tid * 16 + i * 8192, R, C); const int Rb = Epi::PERM ? ((R & ~31) + perm32(R & 31)) : R;
        voffA[i] = (unsigned)(R * K + C) * 2u; voffB[i] = (unsigned)(Rb * K + C) * 2u; gR[i] = R; gC[i] = (unsigned)C * 2u; }
    unsigned cG[2][2], nG[2][2];
#define PG8_GOFF(dst, pm_) do { _Pragma("unroll") for (int _h = 0; _h < 2; ++_h) _Pragma("unroll") for (int _i = 0; _i < 2; ++_i) dst[_h][_i] = (unsigned)g.gidx[(pm_) * BM + _h * HALF + gR[_i]] * (unsigned)(K * 2) + gC[_i]; } while (0)
    const size_t kstep = (size_t)(BK * 2);
    const size_t hstep = (size_t)HALF * K * 2;
    const size_t tstep = 2 * hstep;
    const unsigned ldsw = (unsigned)wid * 1024u;
    const int aoff = lds_byte(wr * 64 + fr, fq * 8), boff = lds_byte(wc * 32 + fr, fq * 8);
#define PG8_SA(b, h) (((b) * 2 + (h)) * HTB)
#define PG8_SB(b, h) ((4 + (b) * 2 + (h)) * HTB)
#define PG8_STAGE(bufoff, gbase, voff) do { _Pragma("unroll") for (int _i = 0; _i < 2; ++_i) \
        __builtin_amdgcn_global_load_lds((const unsigned*)((const char*)(gbase) + (voff)[_i]), (PG8_LAS unsigned*)(lds + (bufoff) + ldsw + _i * 8192), 16, 0, 0); } while (0)
#define PG8_STAGE_A(bufoff, abase, half, nx) do { if constexpr (GATHER) { _Pragma("unroll") for (int _i = 0; _i < 2; ++_i) { const unsigned _o = (nx) ? nG[half][_i] : cG[half][_i]; \
        __builtin_amdgcn_global_load_lds((const unsigned*)((const char*)(abase) + _o), (PG8_LAS unsigned*)(lds + (bufoff) + ldsw + _i * 8192), 16, 0, 0); } } \
        else PG8_STAGE(bufoff, (abase) + (half) * hstep, voffA); } while (0)
#define PG8_LDA(dst, b, h) do { _Pragma("unroll") for (int m = 0; m < 4; ++m) { if constexpr (F8) { dst##8[m].lo = *(const PG8_LAS i32x4v*)(lds + PG8_SA(b, h) + aoff + m * 2048); dst##8[m].hi = *(const PG8_LAS i32x4v*)(lds + PG8_SA(b, h) + aoff + m * 2048 + 1024); } \
        else { _Pragma("unroll") for (int k = 0; k < 2; ++k) dst[m][k] = *(const PG8_LAS bf16x8*)(lds + PG8_SA(b, h) + aoff + m * 2048 + k * 1024); } } } while (0)
#define PG8_LDB(dst, b, h) do { _Pragma("unroll") for (int n = 0; n < 2; ++n) { if constexpr (F8) { dst##8[n].lo = *(const PG8_LAS i32x4v*)(lds + PG8_SB(b, h) + boff + n * 2048); dst##8[n].hi = *(const PG8_LAS i32x4v*)(lds + PG8_SB(b, h) + boff + n * 2048 + 1024); } \
        else { _Pragma("unroll") for (int k = 0; k < 2; ++k) dst[n][k] = *(const PG8_LAS bf16x8*)(lds + PG8_SB(b, h) + boff + n * 2048 + k * 1024); } } } while (0)
#define PG8_MMA(ai, bj, At, Bt) do { __builtin_amdgcn_s_setprio(1); _Pragma("unroll") for (int m = 0; m < 4; ++m) _Pragma("unroll") for (int n = 0; n < 2; ++n) { \
        if constexpr (F8) asm volatile("v_mfma_scale_f32_16x16x128_f8f6f4 %0, %1, %2, %0, %3, %4 op_sel_hi:[0,0,0]" : "+v"(acc[ai][bj][m][n]) : "v"(Bt##8[n]), "v"(At##8[m]), "v"(f8sa), "v"(f8sb)); \
        else { _Pragma("unroll") for (int k = 0; k < 2; ++k) acc[ai][bj][m][n] = __builtin_amdgcn_mfma_f32_16x16x32_bf16(Bt[n][k], At[m][k], acc[ai][bj][m][n], 0, 0, 0); } } \
        __builtin_amdgcn_s_setprio(0); } while (0)
#define PG8_WAIT_V(n) asm volatile("s_waitcnt vmcnt(" #n ")" ::: "memory")
#define PG8_WAIT_L(n) asm volatile("s_waitcnt lgkmcnt(" #n ")" ::: "memory")
#define PG8_BAR __builtin_amdgcn_s_barrier()
#define PG8_SCHED __builtin_amdgcn_sched_barrier(0)
    Unit cur, nxt; int ui = 0;
    if (!S.next(0, cur)) return;
    f32x4 acc[2][2][4][2];
#pragma unroll
    for (int a = 0; a < 2; ++a)
#pragma unroll
        for (int b = 0; b < 2; ++b)
#pragma unroll
            for (int m = 0; m < 4; ++m)
#pragma unroll
                for (int n = 0; n < 2; ++n) acc[a][b][m][n] = (f32x4){0.f, 0.f, 0.f, 0.f};
    bf16x8 At[4][2], B0[2][2], B1[2][2];
    i32x8 At8[4], B08[2], B18[2];
    const int f8sa = g.sa, f8sb = g.sb;
    const char* cA = (const char*)g.A + (GATHER ? (size_t)0 : (size_t)cur.pm * tstep); const char* cB = (const char*)g.Bt + (size_t)cur.pn * tstep;
    if constexpr (GATHER) { PG8_GOFF(cG, cur.pm); }
    S.a_ready(cur);
    if constexpr (SP2) {
        PG8_STAGE(PG8_SB(0, 0), cB, voffB); PG8_STAGE(PG8_SB(0, 1), cB + hstep, voffB); PG8_STAGE_A(PG8_SA(0, 0), cA, 0, false); PG8_STAGE_A(PG8_SA(0, 1), cA, 1, false);
        if (wr == 1) PG8_BAR;
        PG8_WAIT_V(2); PG8_BAR;
        PG8_STAGE(PG8_SB(1, 0), cB + kstep, voffB); PG8_STAGE_A(PG8_SA(1, 0), cA + kstep, 0, false); PG8_STAGE(PG8_SB(1, 1), cB + hstep + kstep, voffB);
        PG8_WAIT_V(6); PG8_BAR;
    } else {
        PG8_STAGE(PG8_SB(0, 0), cB, voffB); PG8_STAGE_A(PG8_SA(0, 0), cA, 0, false); PG8_STAGE(PG8_SB(0, 1), cB + hstep, voffB); PG8_STAGE_A(PG8_SA(0, 1), cA, 1, false);
        if (wr == 1) PG8_BAR;
        PG8_WAIT_V(4); PG8_BAR;
        PG8_STAGE(PG8_SB(1, 0), cB + kstep, voffB); PG8_STAGE_A(PG8_SA(1, 0), cA + kstep, 0, false); PG8_STAGE(PG8_SB(1, 1), cB + hstep + kstep, voffB);
        PG8_WAIT_V(6); PG8_BAR;
    }
    for (;;) {
        const bool has_next = S.next(ui + 1, nxt);
        if constexpr (GATHER) { if (has_next) { PG8_GOFF(nG, nxt.pm); } else { _Pragma("unroll") for (int _h = 0; _h < 2; ++_h) _Pragma("unroll") for (int _i = 0; _i < 2; ++_i) nG[_h][_i] = cG[_h][_i]; } }
        const char* nA = (has_next && !GATHER) ? (const char*)g.A + (size_t)nxt.pm * tstep : cA; const char* nB = has_next ? (const char*)g.Bt + (size_t)nxt.pn * tstep : cB;
        for (int t = 0; t < nt; t += 2) {
            const bool last = (t == nt - 2);
            const char* a1 = cA + (size_t)(t + 1) * kstep;
            const char* a2 = last ? nA : cA + (size_t)(t + 2) * kstep; const char* b2 = last ? nB : cB + (size_t)(t + 2) * kstep;
            const char* a3 = a2 + kstep; const char* b3 = b2 + kstep;
            if (last && has_next) S.a_ready(nxt);
            if constexpr (SP2) {
            PG8_LDB(B0, 0, 0); PG8_LDB(B1, 0, 1); PG8_SCHED; PG8_LDA(At, 0, 0); PG8_STAGE_A(PG8_SA(1, 1), a1, 1, false);
            PG8_WAIT_V(8); PG8_WAIT_L(0); PG8_BAR; PG8_MMA(0, 0, At, B0); PG8_MMA(0, 1, At, B1); PG8_BAR; PG8_SCHED;
            PG8_LDA(At, 0, 1); PG8_STAGE(PG8_SB(0, 0), b2, voffB); PG8_STAGE(PG8_SB(0, 1), b2 + hstep, voffB); PG8_STAGE_A(PG8_SA(0, 0), a2, 0, last);
            PG8_WAIT_V(8); PG8_WAIT_L(0); PG8_BAR; PG8_MMA(1, 0, At, B0); PG8_MMA(1, 1, At, B1); PG8_BAR; PG8_SCHED;
            PG8_LDB(B0, 1, 0); PG8_LDB(B1, 1, 1); PG8_SCHED; PG8_LDA(At, 1, 0); PG8_STAGE_A(PG8_SA(0, 1), a2, 1, last);
            PG8_WAIT_V(8); PG8_WAIT_L(0); PG8_BAR; PG8_MMA(0, 0, At, B0); PG8_MMA(0, 1, At, B1); PG8_BAR; PG8_SCHED;
            PG8_LDA(At, 1, 1); PG8_STAGE(PG8_SB(1, 0), b3, voffB); PG8_STAGE(PG8_SB(1, 1), b3 + hstep, voffB); PG8_STAGE_A(PG8_SA(1, 0), a3, 0, last);
            PG8_WAIT_V(8); PG8_WAIT_L(0); PG8_BAR; PG8_MMA(1, 0, At, B0); PG8_MMA(1, 1, At, B1); PG8_BAR; PG8_SCHED;
            } else {
            PG8_LDB(B0, 0, 0); PG8_SCHED; PG8_LDA(At, 0, 0); PG8_STAGE_A(PG8_SA(1, 1), a1, 1, false);
            PG8_WAIT_L(8); PG8_BAR; PG8_WAIT_L(0); PG8_MMA(0, 0, At, B0); PG8_BAR; PG8_SCHED;
            PG8_LDB(B1, 0, 1); PG8_STAGE(PG8_SB(0, 0), b2, voffB);
            PG8_BAR; PG8_WAIT_L(0); PG8_MMA(0, 1, At, B1); PG8_BAR;
            PG8_LDA(At, 0, 1); PG8_STAGE_A(PG8_SA(0, 0), a2, 0, last);
            PG8_BAR; PG8_WAIT_L(0); PG8_MMA(1, 0, At, B0); PG8_BAR; PG8_SCHED;
            PG8_STAGE(PG8_SB(0, 1), b2 + hstep, voffB);
            PG8_WAIT_V(6); PG8_BAR; PG8_MMA(1, 1, At, B1); PG8_BAR;
            PG8_LDB(B0, 1, 0); PG8_SCHED; PG8_LDA(At, 1, 0); PG8_STAGE_A(PG8_SA(0, 1), a2, 1, last);
            PG8_WAIT_L(8); PG8_BAR; PG8_WAIT_L(0); PG8_MMA(0, 0, At, B0); PG8_BAR; PG8_SCHED;
            PG8_LDB(B1, 1, 1); PG8_STAGE(PG8_SB(1, 0), b3, voffB);
            PG8_BAR; PG8_WAIT_L(0); PG8_MMA(0, 1, At, B1); PG8_BAR;
            PG8_LDA(At, 1, 1); PG8_STAGE_A(PG8_SA(1, 0), a3, 0, last);
            PG8_BAR; PG8_WAIT_L(0); PG8_MMA(1, 0, At, B0); PG8_BAR; PG8_SCHED;
            PG8_STAGE(PG8_SB(1, 1), b3 + hstep, voffB);
            PG8_WAIT_V(6); PG8_BAR; PG8_MMA(1, 1, At, B1); PG8_BAR;
            }
        }
        if constexpr (ALIGN_EPI) { if (wr == 0) PG8_BAR; }
        if constexpr (!Epi::AFTER_DRAIN) { E(acc, cur, wr, wc, fr, fq); S.done(cur); }
        if (!has_next) break;
#pragma unroll
        for (int a = 0; a < 2; ++a)
#pragma unroll
            for (int b = 0; b < 2; ++b)
#pragma unroll
                for (int m = 0; m < 4; ++m)
#pragma unroll
                    for (int n = 0; n < 2; ++n) acc[a][b][m][n] = (f32x4){0.f, 0.f, 0.f, 0.f};
        cur = nxt; cA = nA; cB = nB; ++ui;
        if constexpr (GATHER) { _Pragma("unroll") for (int _h = 0; _h < 2; ++_h) _Pragma("unroll") for (int _i = 0; _i < 2; ++_i) cG[_h][_i] = nG[_h][_i]; }
        if constexpr (ALIGN_EPI) { if (wr == 1) PG8_BAR; }
    }
    PG8_WAIT_V(0);
    if constexpr (!ALIGN_EPI) { if (wr == 0) PG8_BAR; }
    PG8_BAR;
    if constexpr (Epi::AFTER_DRAIN) { E.fused(acc, cur, wr, wc, fr, fq, lds, wid, lane); S.done(cur); }
#undef PG8_SA
#undef PG8_SB
#undef PG8_STAGE
#undef PG8_STAGE_A
#undef PG8_GOFF
#undef PG8_LDA
#undef PG8_LDB
#undef PG8_MMA
#undef PG8_WAIT_V
#undef PG8_WAIT_L
#undef PG8_BAR
#undef PG8_SCHED
}

}

namespace {
#define LAS __attribute__((address_space(3)))
typedef unsigned short bf16;
typedef float f32x4 __attribute__((ext_vector_type(4)));
typedef unsigned u32x4 __attribute__((ext_vector_type(4)));
typedef unsigned u32x2 __attribute__((ext_vector_type(2)));
constexpr int NT = 512, NW = 8;
constexpr int B_ = 8, T_ = 4096, TC_ = 256, D_ = 1024;
constexpr int NCTX = B_ * TC_, NLAT = B_ * T_, NROW = NCTX + NLAT;
constexpr int PIN = 4016, UC = 4096, MLC = 2064;
constexpr int E_ = 16, CAP = 512, DE = 2816, EG = 16  , NG = E_ / EG;
constexpr int MOD6 = 6 * D_;
constexpr int LDS_BYTES = 152 * 1024;
constexpr size_t MiB = 1024 * 1024;
constexpr size_t OFF_MOD = 0, OFF_LORA = 256 * 1024, OFF_AFF = 1 * MiB, OFF_IDX = 3 * MiB, OFF_GATE = 3 * MiB + 512 * 1024, OFF_SEL = 4 * MiB, OFF_BON = 6 * MiB, OFF_INVN = 8 * MiB, OFF_BAR = 10 * MiB;
constexpr size_t OFF_WIN = 12 * MiB, OFF_WOUT = 20 * MiB;
constexpr size_t OFF_XN1 = 22 * MiB, OFF_U = 90 * MiB, OFF_RWP = 362 * MiB, OFF_G = 600 * MiB, OFF_MIX = 632 * MiB, OFF_ZOX = 696 * MiB, WS_END = 702 * MiB;
constexpr int ZOX_ROWS = 6144;
constexpr size_t OFF_W13 = 22 * MiB, OFF_W2 = 110 * MiB, OFF_XN2 = 154 * MiB, OFF_XS = 186 * MiB, OFF_HID = 250 * MiB, OFF_YS = 426 * MiB, OFF_H = 554 * MiB;
static_assert(OFF_H + (size_t)NLAT * D_ * 2 <= OFF_MIX && OFF_YS + (size_t)65536 * D_ * 2 <= OFF_H, "h");
static_assert(OFF_HID + (size_t)EG * 4096 * DE <= OFF_YS && OFF_YS + (size_t)65536 * D_ * 2 <= OFF_MIX && OFF_W13 + (size_t)E_ * 5632 * D_ <= OFF_W2 && OFF_W2 + (size_t)E_ * D_ * DE <= OFF_XN2 && OFF_XN2 + (size_t)NLAT * D_ <= OFF_XS && OFF_XS + (size_t)65536 * D_ <= OFF_HID && OFF_RWP + (size_t)NROW * 3584 * 2 <= OFF_G, "ws map");

struct Params { const float* in[30]; float* out; unsigned char* ws; int ph_lo, ph_hi; };

__device__ __forceinline__ float bf2f(bf16 v) { return __uint_as_float(((unsigned)v) << 16); }
typedef __bf16 bf16x2_t __attribute__((ext_vector_type(2)));
typedef float f32x2_t __attribute__((ext_vector_type(2)));
__device__ __forceinline__ unsigned pk2(float lo, float hi) { const bf16x2_t h2 = __builtin_convertvector((f32x2_t){lo, hi}, bf16x2_t); return __builtin_bit_cast(unsigned, h2); }
__device__ __forceinline__ unsigned f2bf(float f) { return pk2(f, 0.f) & 0xffffu; }
__device__ __forceinline__ float sigmoidf_(float x) { return 1.f / (1.f + __expf(-x)); }
__device__ __forceinline__ float siluf_(float x) { return x / (1.f + __expf(-x)); }
__device__ __forceinline__ float softplusf_(float x) { return fmaxf(x, 0.f) + log1pf(__expf(-fabsf(x))); }
__device__ __forceinline__ float wave_sum(float v) {
#pragma unroll
    for (int o = 1; o < 64; o <<= 1) v += __shfl_xor(v, o);
    return v;
}

__device__ __forceinline__ unsigned pk4_f8(float a, float b, float c, float d) {
    a = fminf(fmaxf(a, -448.f), 448.f); b = fminf(fmaxf(b, -448.f), 448.f); c = fminf(fmaxf(c, -448.f), 448.f); d = fminf(fmaxf(d, -448.f), 448.f);
    int r = __builtin_amdgcn_cvt_pk_fp8_f32(a, b, 0, false); r = __builtin_amdgcn_cvt_pk_fp8_f32(c, d, r, true); return (unsigned)r; }
__device__ __forceinline__ void transpose_item(const float* W, int N, int Nvalid, bf16* WT, int ldt, long row_off, LAS float* scr, int kb, int nb, int lane) {
    const int k0 = 64 * kb, n0 = 32 * nb;
    const bool ok = (n0 + (lane & 31)) < Nvalid;
#pragma unroll 8
    for (int i = 0; i < 32; ++i) { const int kk = 2 * i + (lane >> 5); scr[kk * 33 + (lane & 31)] = ok ? W[(size_t)(k0 + kk) * N + n0 + (lane & 31)] : 0.f; }
    asm volatile("s_waitcnt lgkmcnt(0)" ::: "memory");
    const int c = lane & 7;
#pragma unroll
    for (int j = 0; j < 4; ++j) { const int n = (lane >> 3) + 8 * j; const LAS float* s = scr + (8 * c) * 33 + n;
        u32x4 o; o.x = pk2(s[0 * 33], s[1 * 33]); o.y = pk2(s[2 * 33], s[3 * 33]); o.z = pk2(s[4 * 33], s[5 * 33]); o.w = pk2(s[6 * 33], s[7 * 33]);
        *(u32x4*)(WT + (size_t)(row_off + n0 + n) * ldt + k0 + 8 * c) = o; }
    asm volatile("s_waitcnt lgkmcnt(0)" ::: "memory");
}
struct XRaw { f32x4 v[8]; };
__device__ __forceinline__ void transpose_load_f8(const float* W, int N, int kb, int nb, int lane, XRaw& R) {
    const float* src = W + (size_t)(64 * kb + (lane >> 3)) * N + 32 * nb + (lane & 7) * 4;
#pragma unroll
    for (int i = 0; i < 8; ++i) R.v[i] = __builtin_nontemporal_load((const f32x4*)(src + (size_t)(8 * i) * N));
}
__device__ __forceinline__ void transpose_finish_f8(const XRaw& R, unsigned char* WT8, int ldt, long row_off, LAS float* scr, int kb, int nb, int lane, float scl) {
    const int k0 = 64 * kb, n0 = 32 * nb;
#pragma unroll
    for (int i = 0; i < 8; ++i) { LAS float* d = scr + (8 * i + (lane >> 3)) * 33 + (lane & 7) * 4; d[0] = R.v[i].x; d[1] = R.v[i].y; d[2] = R.v[i].z; d[3] = R.v[i].w; }
    asm volatile("s_waitcnt lgkmcnt(0)" ::: "memory");
    const int c = lane & 7;
#pragma unroll
    for (int j = 0; j < 4; ++j) { const int n = (lane >> 3) + 8 * j; const LAS float* s = scr + (8 * c) * 33 + n;
        u32x2 o; o.x = pk4_f8(s[0 * 33] * scl, s[1 * 33] * scl, s[2 * 33] * scl, s[3 * 33] * scl); o.y = pk4_f8(s[4 * 33] * scl, s[5 * 33] * scl, s[6 * 33] * scl, s[7 * 33] * scl);
        *(u32x2*)(WT8 + (size_t)(row_off + n0 + n) * ldt + k0 + 8 * c) = o; }
    asm volatile("s_waitcnt lgkmcnt(0)" ::: "memory");
}
__device__ __forceinline__ void phase_prep(const Params& p, LAS unsigned char* lds) {
    const int tid = threadIdx.x, lane = tid & 63, wave = tid >> 6, G = gridDim.x;
    unsigned char* ws = p.ws;
    {
        LAS float* sc = (LAS float*)lds;
        LAS float* red = sc + 9 * D_;
        const float* c = p.in[1]; const float* c_ctx = p.in[3]; const float* mod_w = p.in[4]; const float* mod_b = p.in[5];
        float* mod = (float*)(ws + OFF_MOD);
        bool staged = false;
        for (int item = blockIdx.x; item < MOD6 / 32; item += G) {
            if (!staged) { for (int i = tid; i < 9 * D_; i += NT) { const int r = i / D_, k = i % D_; sc[i] = siluf_(r < 8 ? c[r * D_ + k] : c_ctx[k]); } staged = true; }
            __syncthreads();
            const int kg = tid >> 5, cl = tid & 31, col = item * 32 + cl;
            float acc[9];
#pragma unroll
            for (int r = 0; r < 9; ++r) acc[r] = 0.f;
            for (int k = kg * 64; k < kg * 64 + 64; ++k) { const float w = mod_w[(size_t)k * MOD6 + col];
#pragma unroll
                for (int r = 0; r < 9; ++r) acc[r] += sc[r * D_ + k] * w; }
#pragma unroll
            for (int r = 0; r < 9; ++r) red[(kg * 9 + r) * 32 + cl] = acc[r];
            __syncthreads();
            if (tid < 32) {
#pragma unroll
                for (int r = 0; r < 9; ++r) { float s = 0.f; for (int g = 0; g < 16; ++g) s += red[(g * 9 + r) * 32 + tid]; mod[r * MOD6 + item * 32 + tid] = s + mod_b[item * 32 + tid]; }
            }
        }
        __syncthreads();
    }
    LAS float* scr = (LAS float*)(lds + wave * 16384);
    const int gw = blockIdx.x * NW + wave, NGW = G * NW;
    constexpr int I_IN = 16 * 128, I_OUT = 16 * 32;
    for (int it = gw; it < I_IN + I_OUT; it += NGW) {
        if (it < I_IN) transpose_item(p.in[7], PIN, PIN, (bf16*)(ws + OFF_WIN), D_, 0, scr, it / 128, it % 128, lane);
        else { const int r = it - I_IN; transpose_item(p.in[23], D_, D_, (bf16*)(ws + OFF_WOUT), D_, 0, scr, r / 32, r % 32, lane); }
    }
    {
        bf16* LT = (bf16*)(ws + OFF_LORA);
        const float* w_up = p.in[14]; const float* a_up = p.in[16]; const float* g_up = p.in[17];
        for (int i = blockIdx.x * NT + tid; i < 212992; i += G * NT) {
            float v;
            if (i < 131072) { const int j = i & 65535, d = j >> 15, c = (j >> 6) & 511, r = j & 63; v = (i < 65536 ? w_up : a_up)[(d * 64 + r) * 512 + c]; }
            else { const int j = i - 131072, c = j / 160, r = j % 160; v = g_up[r * 512 + c]; }
            LT[i] = (bf16)f2bf(v);
        }
    }
}
constexpr int EXP_ITEMS = E_ * (2 * 16 * 88 + 44 * 32);
__device__ __forceinline__ void expert_load(const Params& p, int it, int lane, XRaw& R) {
    constexpr int I_E13 = 16 * 88, I_E2 = 44 * 32;
    const int e = it / (2 * I_E13 + I_E2); int r = it % (2 * I_E13 + I_E2);
    if (r < 2 * I_E13) { const int which = r / I_E13; r %= I_E13; transpose_load_f8((which ? p.in[27] : p.in[26]) + (size_t)e * D_ * DE, DE, r / 88, r % 88, lane, R); }
    else { r -= 2 * I_E13; transpose_load_f8(p.in[28] + (size_t)e * DE * D_, D_, r / 32, r % 32, lane, R); }
}
__device__ __forceinline__ void expert_finish(const Params& p, LAS float* scr, int it, int lane, const XRaw& R) {
    constexpr int I_E13 = 16 * 88, I_E2 = 44 * 32;
    unsigned char* ws = p.ws;
    const int e = it / (2 * I_E13 + I_E2); int r = it % (2 * I_E13 + I_E2);
    if (r < 2 * I_E13) {
        const int which = r / I_E13; r %= I_E13; const int kb = r / 88, nb = r % 88, n0 = nb * 32;
        const long row_off = (long)e * 5632 + (n0 / 128) * 256 + (n0 % 128) + which * 128 - n0;
        transpose_finish_f8(R, ws + OFF_W13, D_, row_off, scr, kb, nb, lane, 32.f);
    } else {
        r -= 2 * I_E13;
        transpose_finish_f8(R, ws + OFF_W2, DE, (long)e * D_, scr, r / 32, r % 32, lane, 64.f);
    }
}
__device__ __forceinline__ void expert_item(const Params& p, LAS float* scr, int it, int lane) { XRaw R; expert_load(p, it, lane, R); expert_finish(p, scr, it, lane, R); }
__device__ __forceinline__ void phase_expert_prep(const Params& p, LAS unsigned char* lds) {
    const int tid = threadIdx.x, lane = tid & 63, wave = tid >> 6, G = gridDim.x;
    LAS float* scr = (LAS float*)(lds + wave * 16384);
    const int gw = blockIdx.x * NW + wave, NGW = G * NW;
    for (int it = gw; it < EXP_ITEMS; it += NGW) expert_item(p, scr, it, lane);
}

__device__ __forceinline__ void phase_norm1(const Params& p) {
    const int lane = threadIdx.x & 63, wave = threadIdx.x >> 6;
    const int gw = blockIdx.x * NW + wave, NGW = gridDim.x * NW;
    const float* g = p.in[6]; const float* mod = (const float*)(p.ws + OFF_MOD);
    bf16* xn = (bf16*)(p.ws + OFF_XN1);
    for (int row = gw; row < NROW; row += NGW) {
        const float* src; int mr;
        if (row < NCTX) { src = p.in[2] + (size_t)row * D_; mr = 8; } else { const int rl = row - NCTX; src = p.in[0] + (size_t)rl * D_; mr = rl / T_; }
        f32x4 v[4]; float s = 0.f;
#pragma unroll
        for (int j = 0; j < 4; ++j) { v[j] = *(const f32x4*)(src + j * 256 + lane * 4); s += (v[j].x * v[j].x + v[j].y * v[j].y) + (v[j].z * v[j].z + v[j].w * v[j].w); }
        const float rstd = rsqrtf(wave_sum(s) * (1.f / D_) + 1e-6f);
        const float* sh = mod + mr * MOD6, *scl = sh + D_;
#pragma unroll
        for (int j = 0; j < 4; ++j) {
            const int d = j * 256 + lane * 4;
            const f32x4 gg = *(const f32x4*)(g + d), ss = *(const f32x4*)(scl + d), hh = *(const f32x4*)(sh + d);
            const f32x4 o = v[j] * rstd * gg * (ss + 1.f) + hh;
            u32x2 w; w.x = pk2(o.x, o.y); w.y = pk2(o.z, o.w);
            *(u32x2*)(xn + (size_t)row * D_ + d) = w;
        }
    }
}

struct EpiU {
    static constexpr bool PERM = true, AFTER_DRAIN = false;
    bf16* C; int ldc;
    __device__ __forceinline__ void operator()(const pg8::f32x4 (&acc)[2][2][4][2], const pg8::Unit& u, int wr, int wc, int fr, int fq) const {
        const int row0 = u.pm * 256 + wr * 64 + fr, col0 = u.pn * 256 + wc * 32 + 8 * fq;
#pragma unroll
        for (int ai = 0; ai < 2; ++ai)
#pragma unroll
            for (int m = 0; m < 4; ++m) { bf16* rowp = C + (size_t)(row0 + ai * 128 + m * 16) * ldc + col0;
#pragma unroll
                for (int bj = 0; bj < 2; ++bj) { const pg8::f32x4 v0 = acc[ai][bj][m][0], v1 = acc[ai][bj][m][1];
                    u32x4 w; w.x = pk2(v0[0], v0[1]); w.y = pk2(v0[2], v0[3]); w.z = pk2(v1[0], v1[1]); w.w = pk2(v1[2], v1[3]);
                    __builtin_nontemporal_store(w, (u32x4*)(rowp + bj * 128)); } }
    }
};
struct EpiH {
    static constexpr bool PERM = true, AFTER_DRAIN = false;
    const float* x; const float* mod; bf16* h;
    __device__ __forceinline__ void operator()(const pg8::f32x4 (&acc)[2][2][4][2], const pg8::Unit& u, int wr, int wc, int fr, int fq) const {
        const int row0 = u.pm * 256 + wr * 64 + fr, col0 = u.pn * 256 + wc * 32 + 8 * fq;
        const float* g1 = mod + ((u.pm * 256) / T_) * MOD6 + 2 * D_;
#pragma unroll
        for (int ai = 0; ai < 2; ++ai)
#pragma unroll
            for (int m = 0; m < 4; ++m) { const size_t off = (size_t)(row0 + ai * 128 + m * 16) * D_ + col0;
#pragma unroll
                for (int bj = 0; bj < 2; ++bj) { const int cc = bj * 128;
                    const pg8::f32x4 x0 = *(const pg8::f32x4*)(x + off + cc), x1 = *(const pg8::f32x4*)(x + off + cc + 4), g0 = *(const pg8::f32x4*)(g1 + col0 + cc), g1v = *(const pg8::f32x4*)(g1 + col0 + cc + 4);
                    const pg8::f32x4 v0 = x0 + g0 * acc[ai][bj][m][0], v1 = x1 + g1v * acc[ai][bj][m][1];
                    u32x4 w; w.x = pk2(v0[0], v0[1]); w.y = pk2(v0[2], v0[3]); w.z = pk2(v1[0], v1[1]); w.w = pk2(v1[2], v1[3]);
                    *(u32x4*)(h + off + cc) = w; } }
    }
};
struct EpiHid {
    static constexpr bool PERM = true, AFTER_DRAIN = false;
    unsigned char* hid; int nN;
    __device__ __forceinline__ void operator()(const pg8::f32x4 (&acc)[2][2][4][2], const pg8::Unit& u, int, int, int, int) const {
        int t = threadIdx.x; asm volatile("" : "+v"(t));
        const int wid = t >> 6, wr = wid >> 2, wc = wid & 3, fr = t & 15, fq = (t >> 4) & 3;
        const int row0 = u.pm * 256 + wr * 64 + fr, col0 = (u.pn % nN) * 128 + wc * 32 + 8 * fq;
#pragma unroll
        for (int ai = 0; ai < 2; ++ai)
#pragma unroll
            for (int m = 0; m < 4; ++m) {
                float o[8];
#pragma unroll
                for (int n = 0; n < 2; ++n)
#pragma unroll
                    for (int j = 0; j < 4; ++j) { const float a = acc[ai][0][m][n][j]; o[n * 4 + j] = a * __builtin_amdgcn_rcpf(1.f + __expf(-a)) * acc[ai][1][m][n][j] * 8.f; }
                u32x2 w; w.x = pk4_f8(o[0], o[1], o[2], o[3]); w.y = pk4_f8(o[4], o[5], o[6], o[7]);
                *(u32x2*)(hid + (size_t)(row0 + ai * 128 + m * 16) * DE + col0) = w; }
    }
};
struct EpiYs {
    static constexpr bool PERM = true, AFTER_DRAIN = false;
    bf16* ys; const float* gate; int nN;
    __device__ __forceinline__ void operator()(const pg8::f32x4 (&acc)[2][2][4][2], const pg8::Unit& u, int, int, int, int) const {
        int t = threadIdx.x; asm volatile("" : "+v"(t));
        const int wid = t >> 6, wr = wid >> 2, wc = wid & 3, fr = t & 15, fq = (t >> 4) & 3;
        const int row0 = u.pm * 256 + wr * 64 + fr, col0 = (u.pn % nN) * 256 + wc * 32 + 8 * fq;
#pragma unroll
        for (int ai = 0; ai < 2; ++ai)
#pragma unroll
            for (int m = 0; m < 4; ++m) { const int row = row0 + ai * 128 + m * 16; bf16* rowp = ys + (size_t)row * D_ + col0;
#pragma unroll
                for (int bj = 0; bj < 2; ++bj) { const pg8::f32x4 v0 = acc[ai][bj][m][0], v1 = acc[ai][bj][m][1];
                    u32x4 w; w.x = pk2(v0[0], v0[1]); w.y = pk2(v0[2], v0[3]); w.z = pk2(v1[0], v1[1]); w.w = pk2(v1[2], v1[3]);
                    *(u32x4*)(rowp + bj * 128) = w; } }
    }
};
struct ExpertOrder {
    int nN, G, c;
    __device__ bool next(int i, pg8::Unit& u) const {
        if (G == 256) {
            const int xcd = c & 7, l = c >> 3, uidx = i * 32 + l;
            if (uidx >= (EG / 8) * 16 * nN) return false;
            const int es = uidx / (16 * nN), r2 = uidx % (16 * nN), el = xcd + 8 * es;
            const int rg = r2 / (8 * nN), rem = r2 % (8 * nN);
            u.pm = el * 16 + rg * 8 + (rem & 7); u.pn = el * nN + (rem >> 3); return true;
        }
        const long L = (long)i * G + c; if (L >= (long)EG * 16 * nN) return false;
        const int e = (int)(L / (16 * nN)), rem = (int)(L % (16 * nN));
        u.pm = e * 16 + (rem & 15); u.pn = e * nN + (rem >> 4); return true;
    }
    __device__ __forceinline__ void a_ready(const pg8::Unit&) const {}
    __device__ __forceinline__ void done(const pg8::Unit&) const {}
};

__device__ __forceinline__ float bflo(unsigned w) { return __uint_as_float(w << 16); }
__device__ __forceinline__ float bfhi(unsigned w) { return __uint_as_float(w & 0xffff0000u); }
#define BAR_LDS() do { asm volatile("s_waitcnt lgkmcnt(0)" ::: "memory"); __builtin_amdgcn_s_barrier(); asm volatile("" ::: "memory"); } while (0)
__device__ __forceinline__ float rcpf_(float x) { return __builtin_amdgcn_rcpf(x); }
__device__ __forceinline__ float silu_fast(float x) { return x * rcpf_(1.f + __expf(-x)); }
__device__ __forceinline__ float sigmoid_fast(float x) { return rcpf_(1.f + __expf(-x)); }
__device__ __forceinline__ void phase_qk(const Params& p) {
    const int lane = threadIdx.x & 63, wave = threadIdx.x >> 6;
    const int gw = blockIdx.x * NW + wave, NGW = gridDim.x * NW;
    const bf16* u = (const bf16*)(p.ws + OFF_U);
    bf16* QK = (bf16*)(p.ws + OFF_XN1);
    const float* cw = p.in[8]; const float* cb = p.in[9];
    const int c0 = lane * 16;
    float w0[16], w1[16], w2[16], bb[16];
#pragma unroll
    for (int e = 0; e < 16; ++e) { w0[e] = cw[c0 + e]; w1[e] = cw[1024 + c0 + e]; w2[e] = cw[2048 + c0 + e]; bb[e] = cb[c0 + e]; }
    const float scl = c0 >= 512 ? 0.08838834764831845f : 1.f;
    const bool wsplit = gridDim.x == 256;
    const int rstep = wsplit ? 5 * 1024 : NGW, rcnt = wsplit ? (blockIdx.x < 128 ? 2 : 3) : 1;
    const int rbase = wsplit ? (blockIdx.x < 128 ? gw * 2 : 2048 + (gw - 1024) * 3) : gw;
    for (int row0 = rbase; row0 < NROW; row0 += rstep)
    for (int rj = 0; rj < rcnt; ++rj) {
        const int row = row0 + rj; if (row >= NROW) break;
        int t, Tlen;
        if (row < NCTX) { t = row % TC_; Tlen = TC_; } else { t = (row - NCTX) % T_; Tlen = T_; }
        if (row >= NCTX && row < NCTX + ZOX_ROWS) *(u32x4*)((bf16*)(p.ws + OFF_ZOX) + (size_t)(row - NCTX) * 512 + lane * 8) = *(const u32x4*)(u + (size_t)row * UC + 1536 + lane * 8);
        const bf16* src = u + (size_t)row * UC + c0;
        u32x4 zc[2], zp[2], zn[2];
#pragma unroll
        for (int i = 0; i < 2; ++i) {
            zc[i] = *(const u32x4*)(src + i * 8);
            zp[i] = t > 0 ? *(const u32x4*)(src - UC + i * 8) : (u32x4){0u, 0u, 0u, 0u};
            zn[i] = t < Tlen - 1 ? *(const u32x4*)(src + UC + i * 8) : (u32x4){0u, 0u, 0u, 0u};
        }
#pragma unroll
        for (int i = 0; i < 2; ++i) {
            float o[8];
#pragma unroll
            for (int e = 0; e < 4; ++e) {
                const int c = i * 8 + e * 2;
                o[e * 2] = silu_fast(bflo(zp[i][e]) * w0[c] + bflo(zc[i][e]) * w1[c] + bflo(zn[i][e]) * w2[c] + bb[c]) * scl;
                o[e * 2 + 1] = silu_fast(bfhi(zp[i][e]) * w0[c + 1] + bfhi(zc[i][e]) * w1[c + 1] + bfhi(zn[i][e]) * w2[c + 1] + bb[c + 1]) * scl;
            }
            u32x4 w; w.x = pk2(o[0], o[1]); w.y = pk2(o[2], o[3]); w.z = pk2(o[4], o[5]); w.w = pk2(o[6], o[7]);
            *(u32x4*)(QK + (size_t)row * 1024 + c0 + i * 8) = w;
        }
    }
}

typedef short bf16x8 __attribute__((ext_vector_type(8)));
typedef float f32x16 __attribute__((ext_vector_type(16)));
#define MFMA32(a, b, c) __builtin_amdgcn_mfma_f32_32x32x16_bf16((a), (b), (c), 0, 0, 0)
namespace ml {
constexpr int QS = 0, KS = 17408, KTS = 34816, VTS = 53248, VTW = 62464, WS = 71680, CS = 80896, FB = 98304;
constexpr int F_GQ = 0, F_MJ = 64, F_WI = 128, F_WK = 192, F_BC = 256, F_NV = 320, F_NQ = 448, F_DP = 512, F_SC = 704;
constexpr int LDQ = 136, LDK = 72;
}
struct MlRaw { u32x4 q[4]; u32x4 v; bf16 gi, gf; };
__device__ __forceinline__ void ml_load(const bf16* QK, const bf16* u, size_t rowbase, int Tlen, int c, int dir, int h, int vh, int tid, int gi, int gf, MlRaw& R) {
    const int j = tid >> 3, cg = tid & 7;
    const int pp = c * 64 + j, t = dir ? Tlen - 1 - pp : pp;
    const bf16* src = QK + (rowbase + t) * 1024 + (cg < 4 ? h * 128 + cg * 32 : 512 + h * 128 + (cg - 4) * 32);
#pragma unroll
    for (int i = 0; i < 4; ++i) R.q[i] = *(const u32x4*)(src + i * 8);
    R.v = *(const u32x4*)(u + (rowbase + t) * UC + 1024 + h * 128 + vh * 64 + cg * 8);
    R.gi = 0; R.gf = 0;
    if (tid < 64) {
        const int p2 = c * 64 + tid, t2 = dir ? Tlen - 1 - p2 : p2;
        R.gi = u[(rowbase + t2) * UC + 2048 + gi]; R.gf = u[(rowbase + t2) * UC + 2048 + gf];
    }
}
__device__ __forceinline__ void mlstm_item(const Params& p, LAS unsigned char* lds0, int item) {
    using namespace ml;
    LAS unsigned char* lds = lds0;
    LAS float* F = (LAS float*)(lds + FB);
    const bf16* u = (const bf16*)(p.ws + OFF_U); const bf16* QK = (const bf16*)(p.ws + OFF_XN1);
    const float* gate_b = p.in[10];
    const int tid = threadIdx.x, lane = tid & 63, wave = __builtin_amdgcn_readfirstlane(tid >> 6), l31 = lane & 31, hf = lane >> 5;
    const int dir = item & 1, vh = (item >> 1) & 1, h = (item >> 2) & 3, b = item >> 4;
    const int gi = (dir ? 2 : 0) * 4 + h, gf = (dir ? 3 : 1) * 4 + h;
    const float gbi = gate_b[gi], gbf = gate_b[gf];
    bf16* Hout = (bf16*)(p.ws + OFF_MIX) + dir * 512;
    __syncthreads();
    for (int i = tid; i < 64 * LDQ / 2; i += NT) ((LAS unsigned*)(lds + CS))[i] = 0u;
    if (tid < 128) F[F_NV + tid] = 0.f;
    if (tid == 0) F[F_SC + 0] = 0.f;
    f32x16 accC[2];
#pragma unroll
    for (int r = 0; r < 16; ++r) { accC[0][r] = 0.f; accC[1][r] = 0.f; }
    MlRaw R;
    ml_load(QK, u, (size_t)b * TC_, TC_, 0, dir, h, vh, tid, gi, gf, R);
    __syncthreads();
    for (int ci = 0; ci < 68; ++ci) {
        lds = lds0; asm volatile("" : "+v"(lds));
        F = (LAS float*)(lds + FB);
        const int seq = ci >= 4, c = seq ? ci - 4 : ci, Tlen = seq ? T_ : TC_;
        if (wave == 0) {
            const float m = F[F_SC + 0];
            const float li = bf2f(R.gi) + gbi, lfv = -softplusf_(-(bf2f(R.gf) + gbf));
#define DPPF(x, ctrl, rmask, oldv) __int_as_float(__builtin_amdgcn_update_dpp(__float_as_int(oldv), __float_as_int(x), ctrl, rmask, 0xF, false))
            float bsum = lfv;
            bsum += DPPF(bsum, 0x111, 0xF, 0.f); bsum += DPPF(bsum, 0x112, 0xF, 0.f); bsum += DPPF(bsum, 0x114, 0xF, 0.f); bsum += DPPF(bsum, 0x118, 0xF, 0.f);
            bsum += DPPF(bsum, 0x142, 0xA, 0.f); bsum += DPPF(bsum, 0x143, 0xC, 0.f);
            const float g = li - bsum;
            float pm = g;
            const float ninf = -INFINITY;
            pm = fmaxf(pm, DPPF(pm, 0x111, 0xF, ninf)); pm = fmaxf(pm, DPPF(pm, 0x112, 0xF, ninf)); pm = fmaxf(pm, DPPF(pm, 0x114, 0xF, ninf)); pm = fmaxf(pm, DPPF(pm, 0x118, 0xF, ninf));
            pm = fmaxf(pm, DPPF(pm, 0x142, 0xA, ninf)); pm = fmaxf(pm, DPPF(pm, 0x143, 0xC, ninf));
#undef DPPF
            const float Mj = fmaxf(m, pm);
            const float M63 = __shfl(Mj, 63), bL = __shfl(bsum, 63);
            F[F_GQ + lane] = g; F[F_MJ + lane] = Mj; F[F_WI + lane] = __expf(m - Mj); F[F_WK + lane] = __expf(g - M63); F[F_BC + lane] = bsum;
            if (lane == 0) { F[F_SC + 1] = __expf(m - M63); F[F_SC + 2] = bL + M63; }
        }
        {
            const int j = tid >> 3, cg = tid & 7, k0 = (cg & 3) * 32;
#pragma unroll
            for (int i = 0; i < 4; ++i) *(LAS u32x4*)(lds + (cg < 4 ? QS : KS) + (j * LDQ + k0 + i * 8) * 2) = R.q[i];
            if (cg >= 4) {
                const int jc = j ^ ((cg & 3) << 4);
#pragma unroll
                for (int i = 0; i < 4; ++i)
#pragma unroll
                    for (int e = 0; e < 4; ++e) { const unsigned w = R.q[i][e];
                        *(LAS bf16*)(lds + KTS + ((k0 + i * 8 + e * 2) * LDK + jc) * 2) = (bf16)(w & 0xffffu);
                        *(LAS bf16*)(lds + KTS + ((k0 + i * 8 + e * 2 + 1) * LDK + jc) * 2) = (bf16)(w >> 16); }
            }
            const int jv = j ^ (cg << 3);
#pragma unroll
            for (int e = 0; e < 4; ++e) { const unsigned w = R.v[e];
                *(LAS bf16*)(lds + VTS + ((cg * 8 + e * 2) * LDK + jv) * 2) = (bf16)(w & 0xffffu);
                *(LAS bf16*)(lds + VTS + ((cg * 8 + e * 2 + 1) * LDK + jv) * 2) = (bf16)(w >> 16); }
        }
        BAR_LDS();
        {
            const int j = tid >> 3, cg = tid & 7, jv = j ^ (cg << 3); const float wk = F[F_WK + j];
#pragma unroll
            for (int e = 0; e < 4; ++e) { const unsigned w = R.v[e];
                *(LAS bf16*)(lds + VTW + ((cg * 8 + e * 2) * LDK + jv) * 2) = (bf16)f2bf(bflo(w) * wk);
                *(LAS bf16*)(lds + VTW + ((cg * 8 + e * 2 + 1) * LDK + jv) * 2) = (bf16)f2bf(bfhi(w) * wk); }
        }
        if (ci + 1 < 68) { const int s2 = (ci + 1) >= 4, c2 = s2 ? ci + 1 - 4 : ci + 1;
            ml_load(QK, u, s2 ? (size_t)NCTX + (size_t)b * T_ : (size_t)b * TC_, s2 ? T_ : TC_, c2, dir, h, vh, tid, gi, gf, R); }
        f32x16 accH;
#pragma unroll
        for (int r = 0; r < 16; ++r) accH[r] = 0.f;
        const int vt = (wave - 4) >> 1, jt4 = (wave - 4) & 1;
        const int vsw = ((l31 >> 3) & 3) << 3;
        if (wave < 3) {
            const int st = wave == 2 ? 1 : 0, jt = wave == 0 ? 0 : 1;
            f32x16 acc;
#pragma unroll
            for (int r = 0; r < 16; ++r) acc[r] = 0.f;
#pragma unroll
            for (int kk = 0; kk < 8; ++kk) {
                const bf16x8 a = *(const LAS bf16x8*)(lds + KS + ((st * 32 + l31) * LDQ + kk * 16 + hf * 8) * 2);
                const bf16x8 bq = *(const LAS bf16x8*)(lds + QS + ((jt * 32 + l31) * LDQ + kk * 16 + hf * 8) * 2);
                acc = MFMA32(a, bq, acc);
            }
            const int j = jt * 32 + l31; const float Mj = F[F_MJ + j];
            float sum = 0.f;
#pragma unroll
            for (int g4 = 0; g4 < 4; ++g4) {
                const f32x4 gq4 = *(const LAS f32x4*)(F + F_GQ + st * 32 + 8 * g4 + 4 * hf);
                float w4[4];
#pragma unroll
                for (int e = 0; e < 4; ++e) { const int s = st * 32 + 8 * g4 + 4 * hf + e; const float arg = (s <= j) ? gq4[e] - Mj : -INFINITY; const float wv = __expf(arg) * acc[g4 * 4 + e]; w4[e] = wv; sum += wv; }
                u32x2 w; w.x = pk2(w4[0], w4[1]); w.y = pk2(w4[2], w4[3]);
                *(LAS u32x2*)(lds + WS + (j * LDK + st * 32 + 8 * g4 + 4 * hf) * 2) = w;
            }
            sum += __shfl_xor(sum, 32);
            if (hf == 0) F[F_DP + wave * 64 + j] = sum;
        } else if (wave == 3) {
            float s2 = 0.f;
#pragma unroll
            for (int k8 = 0; k8 < 16; ++k8) { const u32x4 w = *(const LAS u32x4*)(lds + QS + (lane * LDQ + k8 * 8) * 2);
                const f32x4 n0 = *(const LAS f32x4*)(F + F_NV + k8 * 8), n1 = *(const LAS f32x4*)(F + F_NV + k8 * 8 + 4);
                s2 += bflo(w[0]) * n0.x + bfhi(w[0]) * n0.y + bflo(w[1]) * n0.z + bfhi(w[1]) * n0.w + bflo(w[2]) * n1.x + bfhi(w[2]) * n1.y + bflo(w[3]) * n1.z + bfhi(w[3]) * n1.w; }
            F[F_NQ + lane] = s2;
        } else {
#pragma unroll
            for (int kk = 0; kk < 8; ++kk) {
                const bf16x8 a = *(const LAS bf16x8*)(lds + CS + ((vt * 32 + l31) * LDQ + kk * 16 + hf * 8) * 2);
                const bf16x8 bq = *(const LAS bf16x8*)(lds + QS + ((jt4 * 32 + l31) * LDQ + kk * 16 + hf * 8) * 2);
                accH = MFMA32(a, bq, accH);
            }
        }
        BAR_LDS();
        if (wave >= 4) {
            f32x16 acc2;
#pragma unroll
            for (int r = 0; r < 16; ++r) acc2[r] = 0.f;
            const int nk = jt4 ? 4 : 2;
            const int vsw4 = (((vt * 32 + l31) >> 3) & 7) << 3;
            for (int kk = 0; kk < nk; ++kk) {
                const bf16x8 a = *(const LAS bf16x8*)(lds + VTS + ((vt * 32 + l31) * LDK + ((kk * 16 + hf * 8) ^ vsw4)) * 2);
                const bf16x8 bw = *(const LAS bf16x8*)(lds + WS + ((jt4 * 32 + l31) * LDK + kk * 16 + hf * 8) * 2);
                acc2 = MFMA32(a, bw, acc2);
            }
            if (seq) {
                const int j = jt4 * 32 + l31;
                const float wi = F[F_WI + j];
                const float dsum = j < 32 ? F[F_DP + j] : F[F_DP + 64 + j] + F[F_DP + 128 + j];
                const float den = dsum + wi * F[F_NQ + j];
                const float inv = rcpf_(fmaxf(fabsf(den), __expf(-(F[F_BC + j] + F[F_MJ + j]))));
                const int pp = c * 64 + j, t = dir ? Tlen - 1 - pp : pp;
                bf16* dst = Hout + ((size_t)b * T_ + t) * 1024 + h * 128 + vh * 64 + vt * 32 + 4 * hf;
#pragma unroll
                for (int g4 = 0; g4 < 4; ++g4) { u32x2 w;
                    w.x = pk2((acc2[g4 * 4] + wi * accH[g4 * 4]) * inv, (acc2[g4 * 4 + 1] + wi * accH[g4 * 4 + 1]) * inv);
                    w.y = pk2((acc2[g4 * 4 + 2] + wi * accH[g4 * 4 + 2]) * inv, (acc2[g4 * 4 + 3] + wi * accH[g4 * 4 + 3]) * inv);
                    *(u32x2*)(dst + 8 * g4) = w; }
            }
        } else {
            const float s_old = F[F_SC + 1];
            const int kt = wave;
#pragma unroll
            for (int r = 0; r < 16; ++r) { accC[0][r] *= s_old; accC[1][r] *= s_old; }
#pragma unroll
            for (int kk = 0; kk < 4; ++kk) {
                const bf16x8 a = *(const LAS bf16x8*)(lds + KTS + ((kt * 32 + l31) * LDK + ((kk * 16 + hf * 8) ^ (kt << 4))) * 2);
                const bf16x8 b0 = *(const LAS bf16x8*)(lds + VTW + ((l31) * LDK + ((kk * 16 + hf * 8) ^ vsw)) * 2);
                const bf16x8 b1 = *(const LAS bf16x8*)(lds + VTW + ((32 + l31) * LDK + ((kk * 16 + hf * 8) ^ (vsw + 32))) * 2);
                accC[0] = MFMA32(a, b0, accC[0]); accC[1] = MFMA32(a, b1, accC[1]);
            }
#pragma unroll
            for (int v2 = 0; v2 < 2; ++v2)
#pragma unroll
                for (int g4 = 0; g4 < 4; ++g4) { u32x2 w; w.x = pk2(accC[v2][g4 * 4], accC[v2][g4 * 4 + 1]); w.y = pk2(accC[v2][g4 * 4 + 2], accC[v2][g4 * 4 + 3]);
                    *(LAS u32x2*)(lds + CS + ((v2 * 32 + l31) * LDQ + kt * 32 + 8 * g4 + 4 * hf) * 2) = w; }
            if (tid < 128) {
                float nn = s_old * F[F_NV + tid];
                const int ksw = ((tid >> 5) & 3) << 4;
#pragma unroll
                for (int s8 = 0; s8 < 8; ++s8) { const u32x4 w = *(const LAS u32x4*)(lds + KTS + (tid * LDK + ((s8 * 8) ^ ksw)) * 2);
                    const f32x4 k0 = *(const LAS f32x4*)(F + F_WK + s8 * 8), k1 = *(const LAS f32x4*)(F + F_WK + s8 * 8 + 4);
                    nn += bflo(w[0]) * k0.x + bfhi(w[0]) * k0.y + bflo(w[1]) * k0.z + bfhi(w[1]) * k0.w + bflo(w[2]) * k1.x + bfhi(w[2]) * k1.y + bflo(w[3]) * k1.z + bfhi(w[3]) * k1.w; }
                F[F_NV + tid] = nn;
            }
            if (tid == 0) F[F_SC + 0] = F[F_SC + 2];
        }
        BAR_LDS();
    }
}

constexpr int RWP_LD = 3584;
__device__ __forceinline__ size_t rw_row(int seq, int b, int p) { return seq ? (size_t)NCTX + (size_t)b * T_ + (size_t)((p & 63) * 64 + (p >> 6)) : (size_t)b * TC_ + p; }
typedef short bf16x8 __attribute__((ext_vector_type(8)));
#define MFMA16(a, b, c) __builtin_amdgcn_mfma_f32_16x16x32_bf16((a), (b), (c), 0, 0, 0)
__device__ __forceinline__ float tanh_fast(float x) { const float xc = fminf(fmaxf(x, -15.f), 15.f); return 1.f - 2.f * rcpf_(__expf(2.f * xc) + 1.f); }
namespace rp {
constexpr int RS = 0, KSH = 16384, XW = 32768, XA = XW + 4608, XG = XA + 4608, OUT = 49152, LDX = 72, LDG = 168;
}
__device__ __forceinline__ void rwkv_prep_tile(const Params& p, LAS unsigned char* lds, int tile) {
    using namespace rp;
    const int tid = threadIdx.x, lane = tid & 63, wave = __builtin_amdgcn_readfirstlane(tid >> 6);
    const bf16* u = (const bf16*)(p.ws + OFF_U);
    bf16* RWP = (bf16*)(p.ws + OFF_RWP);
    const float* mu = p.in[12];
    int seq, b, p0;
    if (tile < 128) { seq = 0; b = tile >> 4; p0 = (tile & 15) * 16; } else { const int t2 = tile - 128; seq = 1; b = t2 >> 8; p0 = (t2 & 255) * 16; }
    const int Tlen = seq ? T_ : TC_;
    const size_t srow0 = (seq ? (size_t)NCTX + (size_t)b * T_ : (size_t)b * TC_) + p0;
    {
        const int cgp = tid & 255, half = tid >> 8;
        if (cgp < 244) {
            const int col = cgp * 8;
            u32x4 rows[10];
#pragma unroll
            for (int i = 0; i < 10; ++i) { const int pos = p0 + half * 8 - 1 + i; const bool ok = pos >= 0 && pos < Tlen;
                rows[i] = ok ? *(const u32x4*)(u + rw_row(seq, b, ok ? pos : p0) * UC + MLC + col) : (u32x4){0u, 0u, 0u, 0u}; }
            float mp[8], mn[8];
#pragma unroll
            for (int e = 0; e < 8; ++e) { mp[e] = mu[col + e]; mn[e] = mu[1952 + col + e]; }
            float kkw[8];
#pragma unroll
            for (int e = 0; e < 8; ++e) kkw[e] = (col >= 512 && col < 1024) ? p.in[18][col - 512 + e] : 0.f;
#pragma unroll
            for (int i = 0; i < 8; ++i) {
                const int t = half * 8 + i;
                float s[8];
#pragma unroll
                for (int e = 0; e < 4; ++e) {
                    const float c0 = bflo(rows[i + 1][e]), c1 = bfhi(rows[i + 1][e]);
                    s[2 * e] = c0 + mp[2 * e] * (bflo(rows[i][e]) - c0) + mn[2 * e] * (bflo(rows[i + 2][e]) - c0);
                    s[2 * e + 1] = c1 + mp[2 * e + 1] * (bfhi(rows[i][e]) - c1) + mn[2 * e + 1] * (bfhi(rows[i + 2][e]) - c1);
                }
                if (col < 1536) {
                    u32x4 w; w.x = pk2(s[0], s[1]); w.y = pk2(s[2], s[3]); w.z = pk2(s[4], s[5]); w.w = pk2(s[6], s[7]);
                    *(u32x4*)(RWP + (srow0 + t) * RWP_LD + col) = w;
                    if (col < 1024) *(LAS u32x4*)(lds + (col < 512 ? RS : KSH) + (t * 512 + (col & 511)) * 2) = w;
                    if (col >= 512 && col < 1024) {
                        float ss = 0.f;
#pragma unroll
                        for (int e = 0; e < 8; ++e) { const float kk = s[e] * kkw[e]; ss += kk * kk; }
                        ss += __shfl_xor(ss, 1); ss += __shfl_xor(ss, 2); ss += __shfl_xor(ss, 4);
                        if ((cgp & 7) == 0) ((float*)(p.ws + OFF_INVN))[(srow0 + t) * 8 + ((col - 512) >> 6)] = rcpf_(fmaxf(sqrtf(ss), 1e-12f));
                    }
                } else if (col < 1664) {
                    const int d = (col - 1536) >> 6, rr = (col - 1536) & 63;
                    u32x4 w; w.x = pk2(tanh_fast(s[0]), tanh_fast(s[1])); w.y = pk2(tanh_fast(s[2]), tanh_fast(s[3])); w.z = pk2(tanh_fast(s[4]), tanh_fast(s[5])); w.w = pk2(tanh_fast(s[6]), tanh_fast(s[7]));
                    *(LAS u32x4*)(lds + XW + ((d * 16 + t) * LDX + rr) * 2) = w;
                } else if (col < 1792) {
                    const int d = (col - 1664) >> 6, rr = (col - 1664) & 63;
                    u32x4 w; w.x = pk2(s[0], s[1]); w.y = pk2(s[2], s[3]); w.z = pk2(s[4], s[5]); w.w = pk2(s[6], s[7]);
                    *(LAS u32x4*)(lds + XA + ((d * 16 + t) * LDX + rr) * 2) = w;
                } else {
                    u32x4 w; w.x = pk2(sigmoid_fast(s[0]), sigmoid_fast(s[1])); w.y = pk2(sigmoid_fast(s[2]), sigmoid_fast(s[3])); w.z = pk2(sigmoid_fast(s[4]), sigmoid_fast(s[5])); w.w = pk2(sigmoid_fast(s[6]), sigmoid_fast(s[7]));
                    *(LAS u32x4*)(lds + XG + (t * LDG + (col - 1792)) * 2) = w;
                }
            }
        }
    }
    {
        const int l15 = lane & 15, q = lane >> 4, head = wave;
        const bf16* LT = (const bf16*)(p.ws + OFF_LORA);
        float bp[2][4];
#pragma unroll
        for (int d = 0; d < 2; ++d)
#pragma unroll
            for (int r = 0; r < 4; ++r) bp[d][r] = 0.f;
        bf16x8 bw[2][2], ba[2][2], bg[5]; float ka_n, rk_n, w0_n[2], a0_n[2];
#define RP_LOADB(ci_) do { const int c_ = head * 64 + (ci_) * 16 + l15; \
            _Pragma("unroll") for (int d = 0; d < 2; ++d) { _Pragma("unroll") for (int s = 0; s < 2; ++s) { \
                bw[d][s] = *(const bf16x8*)(LT + ((size_t)(d * 512 + c_) * 64 + s * 32 + q * 8)); ba[d][s] = *(const bf16x8*)(LT + 65536 + ((size_t)(d * 512 + c_) * 64 + s * 32 + q * 8)); } \
                w0_n[d] = p.in[13][d * 512 + c_]; a0_n[d] = p.in[15][d * 512 + c_]; } \
            _Pragma("unroll") for (int s = 0; s < 5; ++s) bg[s] = *(const bf16x8*)(LT + 131072 + ((size_t)c_ * 160 + s * 32 + q * 8)); \
            ka_n = p.in[19][c_]; rk_n = p.in[20][c_]; } while (0)
        RP_LOADB(0);
        __syncthreads();
#pragma unroll 1
        for (int ci = 0; ci < 4; ++ci) {
            const int c = head * 64 + ci * 16 + l15;
            f32x4 accW[2], accA[2], accG = (f32x4){0.f, 0.f, 0.f, 0.f};
#pragma unroll
            for (int d = 0; d < 2; ++d) {
                accW[d] = (f32x4){0.f, 0.f, 0.f, 0.f}; accA[d] = (f32x4){0.f, 0.f, 0.f, 0.f};
#pragma unroll
                for (int s = 0; s < 2; ++s) {
                    accW[d] = MFMA16(*(const LAS bf16x8*)(lds + XW + ((d * 16 + l15) * LDX + s * 32 + q * 8) * 2), bw[d][s], accW[d]);
                    accA[d] = MFMA16(*(const LAS bf16x8*)(lds + XA + ((d * 16 + l15) * LDX + s * 32 + q * 8) * 2), ba[d][s], accA[d]); }
            }
#pragma unroll
            for (int s = 0; s < 5; ++s) accG = MFMA16(*(const LAS bf16x8*)(lds + XG + (l15 * LDG + s * 32 + q * 8) * 2), bg[s], accG);
            const float ka = ka_n, rk = rk_n, w0c[2] = {w0_n[0], w0_n[1]}, a0c[2] = {a0_n[0], a0_n[1]};
            if (ci < 3) RP_LOADB(ci + 1);
            float rkv[4];
#pragma unroll
            for (int r = 0; r < 4; ++r) { const int t = q * 4 + r; rkv[r] = bf2f(*(const LAS bf16*)(lds + RS + (t * 512 + c) * 2)) * bf2f(*(const LAS bf16*)(lds + KSH + (t * 512 + c) * 2)) * rk; }
#pragma unroll
            for (int d = 0; d < 2; ++d) {
#pragma unroll
                for (int r = 0; r < 4; ++r) {
                    const int t = q * 4 + r;
                    const float lw = accW[d][r] + w0c[d];
                    const float ld = -0.6065306597126334f * sigmoid_fast(lw);
                    const float a = sigmoid_fast(accA[d][r] + a0c[d]);
                    *(LAS bf16*)(lds + OUT + ((2 * d) * 8192 + t * 512 + c) * 2) = (bf16)f2bf(ld);
                    *(LAS bf16*)(lds + OUT + ((2 * d + 1) * 8192 + t * 512 + c) * 2) = (bf16)f2bf(a);
                    bp[d][r] += rkv[r] * (1.f + (a - 1.f) * ka);
                }
            }
#pragma unroll
            for (int r = 0; r < 4; ++r) *(LAS bf16*)(lds + OUT + (4 * 8192 + (q * 4 + r) * 512 + c) * 2) = (bf16)f2bf(accG[r]);
        }
#undef RP_LOADB
        if (seq) {
#pragma unroll
            for (int d = 0; d < 2; ++d)
#pragma unroll
                for (int r = 0; r < 4; ++r) {
                    float v = bp[d][r];
                    v += __shfl_xor(v, 1); v += __shfl_xor(v, 2); v += __shfl_xor(v, 4); v += __shfl_xor(v, 8);
                    if (l15 == 0) ((float*)(p.ws + OFF_BON))[((size_t)d * NLAT + (size_t)b * T_ + p0 + q * 4 + r) * 8 + head] = v;
                }
        }
    }
    __syncthreads();
#pragma unroll
    for (int i = 0; i < 8; ++i) {
        const int pc = tid + i * NT, t = pc >> 8, rem = pc & 255, qq = rem >> 6, c8 = (rem & 63) * 8;
        *(u32x4*)(RWP + (srow0 + t) * RWP_LD + 1536 + qq * 512 + c8) = *(const LAS u32x4*)(lds + OUT + (qq * 8192 + t * 512 + c8) * 2);
    }
    if (seq) {
#pragma unroll
        for (int i = 0; i < 2; ++i) {
            const int pc = tid + i * NT, t = pc >> 6, c8 = (pc & 63) * 8;
            *(u32x4*)((bf16*)(p.ws + OFF_G) + ((size_t)b * T_ + p0 + t) * 512 + c8) = *(const LAS u32x4*)(lds + OUT + (4 * 8192 + t * 512 + c8) * 2);
        }
    }
    __syncthreads();
}

typedef float f32x2 __attribute__((ext_vector_type(2)));
__device__ __forceinline__ float dpp_sum8(float x) {
    x += __int_as_float(__builtin_amdgcn_update_dpp(0, __float_as_int(x), 0xB1, 0xF, 0xF, true));
    x += __int_as_float(__builtin_amdgcn_update_dpp(0, __float_as_int(x), 0x4E, 0xF, 0xF, true));
    x += __int_as_float(__builtin_amdgcn_update_dpp(0, __float_as_int(x), 0x141, 0xF, 0xF, true));
    return x;
}
namespace rs { constexpr int NS = 32, OPS = 0, VV = 2 * NS * 320 * 4, YB = VV + 2 * NS * 32 * 4, XSCR = YB + 2 * NS * 32 * 4, NCH = (TC_ + T_) / NS; }
struct RsRaw { u32x4 r, k, ld, a, v; float invn; };
__device__ __forceinline__ void rs_load(const bf16* RWP, const float* INVN, int cc, int b, int h, int dir, int vh, int st, RsRaw& R) {
    const int seq = cc >= TC_ / rs::NS, c = seq ? cc - TC_ / rs::NS : cc, Tlen = seq ? T_ : TC_;
    const int step = st >> 3, kq = st & 7;
    const int pos = dir ? Tlen - 1 - (c * rs::NS + step) : c * rs::NS + step;
    const size_t srow = (seq ? (size_t)NCTX + (size_t)b * T_ : (size_t)b * TC_) + pos;
    const bf16* rowp = RWP + srow * RWP_LD + h * 64 + kq * 8;
    R.r = *(const u32x4*)(rowp); R.k = *(const u32x4*)(rowp + 512);
    R.ld = *(const u32x4*)(rowp + 1536 + dir * 1024); R.a = *(const u32x4*)(rowp + 2048 + dir * 1024);
    R.v = *(const u32x4*)(RWP + srow * RWP_LD + 1024 + h * 64 + vh * 32 + (kq & 3) * 8);
    R.invn = INVN[srow * 8 + h];
}
template <bool XCVT>
__device__ __forceinline__ void rwkv_scan_item(const Params& p, LAS unsigned char* lds0, int item) {
    using namespace rs;
    const int tid = threadIdx.x, lane = tid & 63, wave = __builtin_amdgcn_readfirstlane(tid >> 6);
    const int dir = item & 1, vh = (item >> 1) & 1, h = (item >> 2) & 7, b = item >> 5;
    const bf16* RWP = (const bf16*)(p.ws + OFF_RWP); const float* INVN = (const float*)(p.ws + OFF_INVN);
    float* Y = p.out + (size_t)dir * NLAT * 512;
    const int st = tid - 256, skq = st & 7, sstep = st >> 3;
    float kkw[8], kaw[8];
    RsRaw R;
    if (wave >= 4) {
#pragma unroll
        for (int e = 0; e < 8; ++e) { kkw[e] = p.in[18][h * 64 + skq * 8 + e]; kaw[e] = p.in[19][h * 64 + skq * 8 + e]; }
        rs_load(RWP, INVN, 0, b, h, dir, vh, st, R);
    }
    f32x2 S[4];
#pragma unroll
    for (int i = 0; i < 4; ++i) S[i] = (f32x2){0.f, 0.f};
    const int v8 = lane >> 3, kq = lane & 7, vrow = wave * 8 + v8;
    __syncthreads();
    for (int cc = -1; cc <= NCH; ++cc) {
        LAS unsigned char* lds = lds0; asm volatile("" : "+v"(lds));
        if (wave >= 4) {
            if (cc >= 1 + TC_ / NS) {
                const int c1 = cc - 1 - TC_ / NS, pos = dir ? T_ - 1 - (c1 * NS + sstep) : c1 * NS + sstep;
                const f32x4 yv = *(const LAS f32x4*)((const LAS float*)(lds + YB) + (((cc - 1) & 1) * NS + sstep) * 32 + skq * 4);
                *(f32x4*)(Y + ((size_t)b * T_ + (size_t)((pos & 63) * 64 + (pos >> 6))) * 512 + h * 64 + vh * 32 + skq * 4) = yv;
            }
            if (cc + 1 < NCH) {
                const int buf = (cc + 1) & 1;
                LAS float* o = (LAS float*)(lds + OPS) + ((buf * NS + sstep) * 8 + skq) * 40;
                float nk[8], w[8], bb[8], kt[8], rr[8];
#pragma unroll
                for (int e = 0; e < 4; ++e) {
                    const float k0 = bflo(R.k[e]), k1 = bfhi(R.k[e]), a0 = bflo(R.a[e]), a1 = bfhi(R.a[e]);
                    const float n0 = k0 * kkw[2 * e] * R.invn, n1 = k1 * kkw[2 * e + 1] * R.invn;
                    nk[2 * e] = -n0; nk[2 * e + 1] = -n1; bb[2 * e] = n0 * a0; bb[2 * e + 1] = n1 * a1;
                    w[2 * e] = __expf(bflo(R.ld[e])); w[2 * e + 1] = __expf(bfhi(R.ld[e]));
                    kt[2 * e] = k0 * (1.f + (a0 - 1.f) * kaw[2 * e]); kt[2 * e + 1] = k1 * (1.f + (a1 - 1.f) * kaw[2 * e + 1]);
                    rr[2 * e] = bflo(R.r[e]); rr[2 * e + 1] = bfhi(R.r[e]);
                }
                *(LAS f32x4*)(o + 0) = (f32x4){nk[0], nk[1], nk[2], nk[3]}; *(LAS f32x4*)(o + 4) = (f32x4){nk[4], nk[5], nk[6], nk[7]};
                *(LAS f32x4*)(o + 8) = (f32x4){w[0], w[1], w[2], w[3]}; *(LAS f32x4*)(o + 12) = (f32x4){w[4], w[5], w[6], w[7]};
                *(LAS f32x4*)(o + 16) = (f32x4){bb[0], bb[1], bb[2], bb[3]}; *(LAS f32x4*)(o + 20) = (f32x4){bb[4], bb[5], bb[6], bb[7]};
                *(LAS f32x4*)(o + 24) = (f32x4){kt[0], kt[1], kt[2], kt[3]}; *(LAS f32x4*)(o + 28) = (f32x4){kt[4], kt[5], kt[6], kt[7]};
                *(LAS f32x4*)(o + 32) = (f32x4){rr[0], rr[1], rr[2], rr[3]}; *(LAS f32x4*)(o + 36) = (f32x4){rr[4], rr[5], rr[6], rr[7]};
                if (skq < 4) {
                    LAS float* vo = (LAS float*)(lds + VV) + (buf * NS + sstep) * 32 + skq * 8;
                    *(LAS f32x4*)(vo) = (f32x4){bflo(R.v[0]), bfhi(R.v[0]), bflo(R.v[1]), bfhi(R.v[1])};
                    *(LAS f32x4*)(vo + 4) = (f32x4){bflo(R.v[2]), bfhi(R.v[2]), bflo(R.v[3]), bfhi(R.v[3])};
                }
            }
            if (cc + 2 < NCH) rs_load(RWP, INVN, cc + 2, b, h, dir, vh, st, R);
            if (XCVT && cc >= 0 && (cc & 1) == 0) {
                const int it = (blockIdx.x * 4 + (wave - 4)) + 1024 * (cc >> 1);
                if (it < EXP_ITEMS) expert_item(p, (LAS float*)(lds + XSCR + (wave - 4) * 8448), it, lane);
            }
        } else if (cc >= 0 && cc < NCH) {
            const int buf = cc & 1;
            const LAS float* ob = (const LAS float*)(lds + OPS) + (buf * NS * 8 + kq) * 40;
            const LAS float* vb = (const LAS float*)(lds + VV) + buf * NS * 32 + vrow;
            LAS float* yl = (LAS float*)(lds + YB) + buf * NS * 32 + vrow;
            struct Ops { f32x4 n0, n1, w0, w1, b0, b1, k0, k1, r0, r1; float vv; };
#define RS_LOAD(P, i) do { const LAS float* o = ob + (i) * 320; P.n0 = *(const LAS f32x4*)(o); P.n1 = *(const LAS f32x4*)(o + 4); P.w0 = *(const LAS f32x4*)(o + 8); P.w1 = *(const LAS f32x4*)(o + 12); \
        P.b0 = *(const LAS f32x4*)(o + 16); P.b1 = *(const LAS f32x4*)(o + 20); P.k0 = *(const LAS f32x4*)(o + 24); P.k1 = *(const LAS f32x4*)(o + 28); P.r0 = *(const LAS f32x4*)(o + 32); P.r1 = *(const LAS f32x4*)(o + 36); P.vv = vb[(i) * 32]; } while (0)
#define RS_YDONE(i) do { yl[(i) * 32] = dpp_sum8(yp.x + yp.y); } while (0)
#define RS_STEP(P, i, FIN) do { \
        const f32x2 sa2 = (S[0] * (f32x2){P.n0.x, P.n0.y} + S[1] * (f32x2){P.n0.z, P.n0.w}) + (S[2] * (f32x2){P.n1.x, P.n1.y} + S[3] * (f32x2){P.n1.z, P.n1.w}); \
        if (FIN) RS_YDONE((i) - 1); \
        const float sa = dpp_sum8(sa2.x + sa2.y); const f32x2 sav = (f32x2){sa, sa}, vvv = (f32x2){P.vv, P.vv}; \
        S[0] = S[0] * (f32x2){P.w0.x, P.w0.y} + sav * (f32x2){P.b0.x, P.b0.y} + vvv * (f32x2){P.k0.x, P.k0.y}; \
        S[1] = S[1] * (f32x2){P.w0.z, P.w0.w} + sav * (f32x2){P.b0.z, P.b0.w} + vvv * (f32x2){P.k0.z, P.k0.w}; \
        S[2] = S[2] * (f32x2){P.w1.x, P.w1.y} + sav * (f32x2){P.b1.x, P.b1.y} + vvv * (f32x2){P.k1.x, P.k1.y}; \
        S[3] = S[3] * (f32x2){P.w1.z, P.w1.w} + sav * (f32x2){P.b1.z, P.b1.w} + vvv * (f32x2){P.k1.z, P.k1.w}; \
        yp = (S[0] * (f32x2){P.r0.x, P.r0.y} + S[1] * (f32x2){P.r0.z, P.r0.w}) + (S[2] * (f32x2){P.r1.x, P.r1.y} + S[3] * (f32x2){P.r1.z, P.r1.w}); \
    } while (0)
            Ops A, B;
            f32x2 yp;
            RS_LOAD(A, 0);
            RS_LOAD(B, 1);
            RS_STEP(A, 0, false);
            RS_LOAD(A, 2);
            RS_STEP(B, 1, true);
#pragma unroll 1
            for (int i = 2; i < NS; i += 2) {
                RS_LOAD(B, i + 1);
                RS_STEP(A, i, true);
                RS_LOAD(A, i + 2);
                RS_STEP(B, i + 1, true);
            }
            RS_YDONE(NS - 1);
#undef RS_LOAD
#undef RS_STEP
#undef RS_YDONE
        }
        __syncthreads();
    }
}

namespace rc {
constexpr int SET = 10752;
constexpr int RH = 0, BKT = 2304, VT = 6400, GAM = 10496;
constexpr int AH = 3 * SET, BH = AH + 2304, KH = BH + 2304, AHT = KH + 2304  , ABK = AHT + 2 * 4096  , AAK = ABK + 2 * 1024  , AABT = AAK + 2 * 1024, TT = AABT + 1024, W2T = TT + 1024,
              P1T = W2T + 1024, YB = P1T + 2304, END = YB + 4096;
constexpr int NCH = (TC_ + T_) / 16;
}
struct RcRaw { u32x2 r, k, a, v, ld; float invn; };
__device__ __forceinline__ void rc_load(const bf16* RWP, const float* INVN, int cc, int b, int h, int dir, int ei, int ekq, RcRaw& R) {
    const int seq = cc >= TC_ / 16, c = seq ? cc - TC_ / 16 : cc, Tlen = seq ? T_ : TC_;
    const size_t srow = (seq ? (size_t)NCTX + (size_t)b * T_ : (size_t)b * TC_) + (dir ? Tlen - 1 - (c * 16 + ei) : c * 16 + ei);
    const bf16* rowp = RWP + srow * RWP_LD + h * 64 + ekq * 4;
    R.r = *(const u32x2*)(rowp); R.k = *(const u32x2*)(rowp + 512); R.v = *(const u32x2*)(rowp + 1024);
    R.ld = *(const u32x2*)(rowp + 1536 + dir * 1024); R.a = *(const u32x2*)(rowp + 2048 + dir * 1024);
    R.invn = INVN[srow * 8 + h];
}
__device__ __forceinline__ float scan16_row(float x) {
    x += __int_as_float(__builtin_amdgcn_update_dpp(0, __float_as_int(x), 0x111, 0xF, 0xF, true));
    x += __int_as_float(__builtin_amdgcn_update_dpp(0, __float_as_int(x), 0x112, 0xF, 0xF, true));
    x += __int_as_float(__builtin_amdgcn_update_dpp(0, __float_as_int(x), 0x114, 0xF, 0xF, true));
    x += __int_as_float(__builtin_amdgcn_update_dpp(0, __float_as_int(x), 0x118, 0xF, 0xF, true));
    return x;
}
__device__ __forceinline__ void rwkv_chunk_item(const Params& p, LAS unsigned char* lds0, int item) {
    using namespace rc;
    const int tid = threadIdx.x, lane = tid & 63, wave = __builtin_amdgcn_readfirstlane(tid >> 6), l15 = lane & 15, q = lane >> 4;
    const int dir = item & 1, h = (item >> 1) & 7, b = item >> 4;
    const bf16* RWP = (const bf16*)(p.ws + OFF_RWP); const float* INVN = (const float*)(p.ws + OFF_INVN);
    bf16* Y = (bf16*)p.out + (size_t)dir * NLAT * 512;
    __syncthreads();
    for (int i = tid; i < END / 4; i += NT) ((LAS unsigned*)lds0)[i] = 0u;
    const int ei = lane & 15, ekq = (wave & 3) * 4 + (lane >> 4);
    RcRaw R;
    const f32x4 kkw = *(const f32x4*)(p.in[18] + h * 64 + ekq * 4), kaw = *(const f32x4*)(p.in[19] + h * 64 + ekq * 4);
    f32x4 acc[4];
#pragma unroll
    for (int t = 0; t < 4; ++t) acc[t] = (f32x4){0.f, 0.f, 0.f, 0.f};
    __syncthreads();
    for (int cc = -4; cc < NCH; ++cc) {
        LAS unsigned char* lds = lds0; asm volatile("" : "+v"(lds));
        int l15o = l15, qo = q; asm volatile("" : "+v"(l15o), "+v"(qo));
        const int c2 = cc + 2, c1 = cc + 1;
        if (wave < 4) {
            if (c2 >= 0 && c2 < NCH) {
                LAS unsigned char* S2 = lds + (c2 % 3) * SET;
                const float l0 = bflo(R.ld.x), l1 = bfhi(R.ld.x), l2 = bflo(R.ld.y), l3 = bfhi(R.ld.y);
                const float ldi[4] = {l0, l1, l2, l3};
                const float cl[4] = {scan16_row(l0), scan16_row(l1), scan16_row(l2), scan16_row(l3)};
                const float rr[4] = {bflo(R.r.x), bfhi(R.r.x), bflo(R.r.y), bfhi(R.r.y)}, kv[4] = {bflo(R.k.x), bfhi(R.k.x), bflo(R.k.y), bfhi(R.k.y)};
                const float av[4] = {bflo(R.a.x), bfhi(R.a.x), bflo(R.a.y), bfhi(R.a.y)};
                float rh[4], ah[4], bh[4], kh[4], e1[4];
#pragma unroll
                for (int e = 0; e < 4; ++e) {
                    e1[e] = __expf(cl[e]); const float e2 = __expf(-cl[e]), e3 = __expf(cl[e] - ldi[e]);
                    const float kkv = kv[e] * kkw[e] * R.invn;
                    rh[e] = rr[e] * e1[e]; ah[e] = -kkv * e3; bh[e] = kkv * av[e] * e2; kh[e] = kv[e] * (1.f + (av[e] - 1.f) * kaw[e]) * e2;
                }
                const int k0 = ekq * 4;
                { u32x2 w; w.x = pk2(rh[0], rh[1]); w.y = pk2(rh[2], rh[3]); *(LAS u32x2*)(S2 + RH + (ei * 72 + k0) * 2) = w; }
                { u32x2 w; w.x = pk2(ah[0], ah[1]); w.y = pk2(ah[2], ah[3]); *(LAS u32x2*)(lds + AH + (ei * 72 + k0) * 2) = w; }
                { u32x2 w; w.x = pk2(bh[0], bh[1]); w.y = pk2(bh[2], bh[3]); *(LAS u32x2*)(lds + BH + (ei * 72 + k0) * 2) = w; }
                { u32x2 w; w.x = pk2(kh[0], kh[1]); w.y = pk2(kh[2], kh[3]); *(LAS u32x2*)(lds + KH + (ei * 72 + k0) * 2) = w; }
                const int bq = (ei >> 2) * 8 + (ei & 3);
                LAS unsigned char* aht = lds + AHT + (c2 & 1) * 4096;
#pragma unroll
                for (int e = 0; e < 4; ++e) {
                    *(LAS bf16*)(aht + ((k0 + e) * 32 + ei) * 2) = (bf16)f2bf(ah[e]);
                    *(LAS bf16*)(S2 + BKT + ((k0 + e) * 32 + bq) * 2) = (bf16)f2bf(bh[e]);
                    *(LAS bf16*)(S2 + BKT + ((k0 + e) * 32 + bq + 4) * 2) = (bf16)f2bf(kh[e]);
                }
                *(LAS bf16*)(S2 + VT + ((k0 + 0) * 32 + ei) * 2) = (bf16)(R.v.x & 0xffffu); *(LAS bf16*)(S2 + VT + ((k0 + 1) * 32 + ei) * 2) = (bf16)(R.v.x >> 16);
                *(LAS bf16*)(S2 + VT + ((k0 + 2) * 32 + ei) * 2) = (bf16)(R.v.y & 0xffffu); *(LAS bf16*)(S2 + VT + ((k0 + 3) * 32 + ei) * 2) = (bf16)(R.v.y >> 16);
                if (ei == 15) *(LAS f32x4*)(S2 + GAM + k0 * 4) = (f32x4){e1[0], e1[1], e1[2], e1[3]};
            }
            if (cc + 3 >= 0 && cc + 3 < NCH) rc_load(RWP, INVN, cc + 3, b, h, dir, ei, ekq, R);
            if (wave == 0 && c1 >= 0 && c1 < NCH) {
                int lo = lane; asm volatile("" : "+v"(lo));
                const int ci = lo >> 2, part = lo & 3;
                float t[4];
#pragma unroll
                for (int e = 0; e < 4; ++e) t[e] = (part + 4 * e == ci) ? 1.f : 0.f;
#pragma unroll
                for (int m = 15; m >= 1; --m) {
                    const int src = __float_as_int(t[m >> 2]);
                    float tm;
                    switch (m & 3) {
                        case 0: tm = __int_as_float(__builtin_amdgcn_update_dpp(0, src, 0x00, 0xF, 0xF, true)); break;
                        case 1: tm = __int_as_float(__builtin_amdgcn_update_dpp(0, src, 0x55, 0xF, 0xF, true)); break;
                        case 2: tm = __int_as_float(__builtin_amdgcn_update_dpp(0, src, 0xAA, 0xF, 0xF, true)); break;
                        default: tm = __int_as_float(__builtin_amdgcn_update_dpp(0, src, 0xFF, 0xF, 0xF, true)); break;
                    }
                    const f32x4 a4 = *(const LAS f32x4*)((const LAS float*)(lds + AABT) + m * 16 + part * 4);
#pragma unroll
                    for (int e = 0; e < 4; ++e) if (4 * e < m) t[e] = fmaf(a4[e], tm, t[e]);
                }
#pragma unroll
                for (int e = 0; e < 4; ++e) *(LAS bf16*)(lds + TT + (ci * 32 + part + 4 * e) * 2) = (bf16)f2bf(t[e]);
            }
        } else if (cc >= 0) {
            const LAS unsigned char* S0 = lds + (cc % 3) * SET;
            const int vt = wave - 4;
            f32x4 sat = (f32x4){0.f, 0.f, 0.f, 0.f};
            {
                const bf16x8 a = *(const LAS bf16x8*)(lds + W2T + (l15 * 32 + q * 8) * 2);
                const bf16x8 bv = *(const LAS bf16x8*)(S0 + VT + ((vt * 16 + l15) * 32 + q * 8) * 2);
                sat = MFMA16(a, bv, sat);
            }
            f32x4 yt = (f32x4){0.f, 0.f, 0.f, 0.f};
#pragma unroll
            for (int s = 0; s < 2; ++s) {
                u32x4 sb; sb.x = pk2(acc[2 * s][0], acc[2 * s][1]); sb.y = pk2(acc[2 * s][2], acc[2 * s][3]); sb.z = pk2(acc[2 * s + 1][0], acc[2 * s + 1][1]); sb.w = pk2(acc[2 * s + 1][2], acc[2 * s + 1][3]);
                const bf16x8 sB = __builtin_bit_cast(bf16x8, sb);
                u32x4 pa; { const u32x2 lo = *(const LAS u32x2*)(lds + P1T + (l15 * 72 + 32 * s + 4 * q) * 2), hi = *(const LAS u32x2*)(lds + P1T + (l15 * 72 + 32 * s + 16 + 4 * q) * 2); pa = (u32x4){lo.x, lo.y, hi.x, hi.y}; }
                u32x4 ra; { const u32x2 lo = *(const LAS u32x2*)(S0 + RH + (l15 * 72 + 32 * s + 4 * q) * 2), hi = *(const LAS u32x2*)(S0 + RH + (l15 * 72 + 32 * s + 16 + 4 * q) * 2); ra = (u32x4){lo.x, lo.y, hi.x, hi.y}; }
                sat = MFMA16(__builtin_bit_cast(bf16x8, pa), sB, sat);
                yt = MFMA16(__builtin_bit_cast(bf16x8, ra), sB, yt);
            }
            const u32x2 vv = *(const LAS u32x2*)(S0 + VT + ((vt * 16 + l15) * 32 + 4 * q) * 2);
            u32x4 b2; b2.x = pk2(sat[0], sat[1]); b2.y = pk2(sat[2], sat[3]); b2.z = vv.x; b2.w = vv.y;
            const bf16x8 B2 = __builtin_bit_cast(bf16x8, b2);
            yt = MFMA16(*(const LAS bf16x8*)(lds + ABK + (cc & 1) * 1024 + (l15 * 32 + q * 8) * 2), B2, yt);
#pragma unroll
            for (int kt = 0; kt < 4; ++kt) {
                acc[kt] = MFMA16(*(const LAS bf16x8*)(S0 + BKT + ((kt * 16 + l15) * 32 + q * 8) * 2), B2, acc[kt]);
                acc[kt] = acc[kt] * *(const LAS f32x4*)(S0 + GAM + (kt * 16 + 4 * q) * 4);
            }
            LAS float* yb = (LAS float*)(lds + YB) + vt * 16 + l15;
#pragma unroll
            for (int r = 0; r < 4; ++r) yb[(4 * q + r) * 64] = yt[r];
        }
        BAR_LDS();
        if (wave < 4) {
            if (c2 >= 0 && c2 < NCH) {
                const LAS unsigned char* S2 = lds + (c2 % 3) * SET;
                const int ia = wave == 3 ? AH : (wave == 1 ? KH : BH);
                f32x4 d = (f32x4){0.f, 0.f, 0.f, 0.f};
#pragma unroll
                for (int s = 0; s < 2; ++s) {
                    const bf16x8 a = *(const LAS bf16x8*)(lds + ia + (l15 * 72 + s * 32 + q * 8) * 2);
                    bf16x8 bb;
                    if (wave < 2) bb = *(const LAS bf16x8*)(S2 + RH + (l15 * 72 + s * 32 + q * 8) * 2);
                    else if (wave == 2) bb = *(const LAS bf16x8*)(lds + AH + (l15 * 72 + s * 32 + q * 8) * 2);
                    else bb = *(const LAS bf16x8*)(lds + KH + (l15 * 72 + s * 32 + q * 8) * 2);
                    d = MFMA16(a, bb, d);
                }
                if (wave < 2) {
                    float o[4];
#pragma unroll
                    for (int r = 0; r < 4; ++r) o[r] = (4 * qo + r <= l15o) ? d[r] : 0.f;
                    u32x2 w; w.x = pk2(o[0], o[1]); w.y = pk2(o[2], o[3]);
                    *(LAS u32x2*)(lds + ABK + (c2 & 1) * 1024 + (l15 * 32 + q * 8 + wave * 4) * 2) = w;
                } else if (wave == 2) {
                    f32x4 o;
#pragma unroll
                    for (int r = 0; r < 4; ++r) o[r] = (4 * qo + r < l15o) ? d[r] : 0.f;
#pragma unroll
                    for (int r = 0; r < 4; ++r) *(LAS float*)(lds + AABT + (l15 * 16 + r * 4 + q) * 4) = o[r];
                } else {
                    float o[4];
#pragma unroll
                    for (int r = 0; r < 4; ++r) o[r] = (l15o < 4 * qo + r) ? d[r] : 0.f;
                    u32x2 w; w.x = pk2(o[0], o[1]); w.y = pk2(o[2], o[3]);
                    *(LAS u32x2*)(lds + AAK + (c2 & 1) * 1024 + (l15 * 32 + 4 * q) * 2) = w;
                }
            }
        } else {
            if (c1 >= 0 && c1 < NCH) {
                const bf16x8 bt = *(const LAS bf16x8*)(lds + TT + (l15 * 32 + q * 8) * 2);
                const int mt = wave - 4;
                f32x4 d = (f32x4){0.f, 0.f, 0.f, 0.f};
                d = MFMA16(*(const LAS bf16x8*)(lds + AHT + (c1 & 1) * 4096 + ((mt * 16 + l15) * 32 + q * 8) * 2), bt, d);
                { u32x2 w; w.x = pk2(d[0], d[1]); w.y = pk2(d[2], d[3]); *(LAS u32x2*)(lds + P1T + (l15 * 72 + mt * 16 + 4 * q) * 2) = w; }
                if (wave == 4) {
                    f32x4 d2 = (f32x4){0.f, 0.f, 0.f, 0.f};
                    d2 = MFMA16(*(const LAS bf16x8*)(lds + AAK + (c1 & 1) * 1024 + (l15 * 32 + q * 8) * 2), bt, d2);
                    u32x2 w; w.x = pk2(d2[0], d2[1]); w.y = pk2(d2[2], d2[3]);
                    *(LAS u32x2*)(lds + W2T + (l15 * 32 + 4 * q) * 2) = w;
                }
            }
            if (cc >= TC_ / 16) {
                const int t2 = tid - 256, fi = t2 >> 4, part = t2 & 15;
                const int cl1 = cc - TC_ / 16, pos = dir ? T_ - 1 - (cl1 * 16 + fi) : cl1 * 16 + fi;
                const f32x4 yv = *(const LAS f32x4*)((const LAS float*)(lds + YB) + fi * 64 + part * 4);
                u32x2 yw; yw.x = pk2(yv.x, yv.y); yw.y = pk2(yv.z, yv.w);
                *(u32x2*)(Y + ((size_t)b * T_ + (size_t)((pos & 63) * 64 + (pos >> 6))) * 512 + h * 64 + part * 4) = yw;
            }
        }
        BAR_LDS();
    }
}

__device__ __forceinline__ void phase_combine(const Params& p) {
    const int lane = threadIdx.x & 63, wave = threadIdx.x >> 6;
    const int gw = blockIdx.x * NW + wave, NGW = gridDim.x * NW;
    const bf16* u = (const bf16*)(p.ws + OFF_U); const bf16* HFB = (const bf16*)(p.ws + OFF_MIX);
    const bf16* Y = (const bf16*)p.out; const float* BON = (const float*)(p.ws + OFF_BON);
    const bf16* RWP = (const bf16*)(p.ws + OFF_RWP); const bf16* Gb = (const bf16*)(p.ws + OFF_G);
    const float* ml_norm_g = p.in[11]; const float* ln_g = p.in[21]; const float* ln_b = p.in[22];
    bf16* mix = (bf16*)(p.ws + OFF_MIX);
    const int c8 = lane * 8;
    for (int rl = gw; rl < NLAT; rl += NGW) {
        const int b = rl / T_, t = rl % T_, pp = (t & 63) * 64 + (t >> 6);
        const size_t lrow = (size_t)b * T_ + pp;
        const u32x4 hf = *(const u32x4*)(HFB + (size_t)rl * 1024 + c8), hb = *(const u32x4*)(HFB + (size_t)rl * 1024 + 512 + c8);
        const u32x4 zo = rl < ZOX_ROWS ? *(const u32x4*)((const bf16*)(p.ws + OFF_ZOX) + (size_t)rl * 512 + c8) : *(const u32x4*)(u + ((size_t)NCTX + rl) * UC + 1536 + c8);
        float hs[8], ss = 0.f;
#pragma unroll
        for (int e = 0; e < 4; ++e) { hs[2 * e] = bflo(hf[e]) + bflo(hb[e]); hs[2 * e + 1] = bfhi(hf[e]) + bfhi(hb[e]); ss += hs[2 * e] * hs[2 * e] + hs[2 * e + 1] * hs[2 * e + 1]; }
        ss += __shfl_xor(ss, 1); ss += __shfl_xor(ss, 2); ss += __shfl_xor(ss, 4); ss += __shfl_xor(ss, 8);
        const float rs_ = rsqrtf(ss * (1.f / 128.f) + 1e-6f);
        float o[8];
#pragma unroll
        for (int e = 0; e < 4; ++e) { o[2 * e] = hs[2 * e] * rs_ * ml_norm_g[c8 + 2 * e] * sigmoidf_(bflo(zo[e])); o[2 * e + 1] = hs[2 * e + 1] * rs_ * ml_norm_g[c8 + 2 * e + 1] * sigmoidf_(bfhi(zo[e])); }
        { u32x4 w; w.x = pk2(o[0], o[1]); w.y = pk2(o[2], o[3]); w.z = pk2(o[4], o[5]); w.w = pk2(o[6], o[7]); *(u32x4*)(mix + (size_t)rl * D_ + c8) = w; }
        const u32x4 yf = *(const u32x4*)(Y + (size_t)rl * 512 + c8), yb = *(const u32x4*)(Y + ((size_t)NLAT + rl) * 512 + c8);
        float y[8];
#pragma unroll
        for (int e = 0; e < 4; ++e) { y[2 * e] = bflo(yf[e]) + bflo(yb[e]); y[2 * e + 1] = bfhi(yf[e]) + bfhi(yb[e]); }
        float sm = 0.f;
#pragma unroll
        for (int e = 0; e < 8; ++e) sm += y[e];
        sm += __shfl_xor(sm, 1); sm += __shfl_xor(sm, 2); sm += __shfl_xor(sm, 4);
        const float mean = sm * (1.f / 64.f);
        float sv = 0.f;
#pragma unroll
        for (int e = 0; e < 8; ++e) { y[e] -= mean; sv += y[e] * y[e]; }
        sv += __shfl_xor(sv, 1); sv += __shfl_xor(sv, 2); sv += __shfl_xor(sv, 4);
        const float rstd = rsqrtf(sv * (1.f / 64.f) + 64e-5f);
        const int head = lane >> 3;
        const float bonus = BON[lrow * 8 + head] + BON[((size_t)NLAT + lrow) * 8 + head];
        const u32x4 vs = *(const u32x4*)(RWP + ((size_t)NCTX + lrow) * RWP_LD + 1024 + c8), gg = *(const u32x4*)(Gb + lrow * 512 + c8);
#pragma unroll
        for (int e = 0; e < 4; ++e) {
            o[2 * e] = (y[2 * e] * rstd * ln_g[c8 + 2 * e] + ln_b[c8 + 2 * e] + bonus * bflo(vs[e])) * bflo(gg[e]);
            o[2 * e + 1] = (y[2 * e + 1] * rstd * ln_g[c8 + 2 * e + 1] + ln_b[c8 + 2 * e + 1] + bonus * bfhi(vs[e])) * bfhi(gg[e]);
        }
        { u32x4 w; w.x = pk2(o[0], o[1]); w.y = pk2(o[2], o[3]); w.z = pk2(o[4], o[5]); w.w = pk2(o[6], o[7]); *(u32x4*)(mix + (size_t)rl * D_ + 512 + c8) = w; }
    }
}

__device__ __forceinline__ void phase_norm2(const Params& p, LAS unsigned char* lds) {
    const int tid = threadIdx.x, wave = tid >> 6;
    const int gw = blockIdx.x * NW + wave, NGW = gridDim.x * NW;
    const float* g = p.in[24]; const float* router_w = p.in[25]; const float* mod = (const float*)(p.ws + OFF_MOD);
    const bf16* h = (const bf16*)(p.ws + OFF_H);
    unsigned char* xn2 = p.ws + OFF_XN2;
    float* aff = (float*)(p.ws + OFF_AFF);
    LAS float* RWT = (LAS float*)lds;
    __syncthreads();
    for (int i = tid; i < 16384; i += NT) RWT[(i & 15) * 1024 + (i >> 4)] = router_w[i];
    __syncthreads();
#pragma unroll 1
    for (int rl = gw; rl < NLAT; rl += NGW) {
        int lane = tid & 63; asm volatile("" : "+v"(lane));
        const int b = rl / T_, t = rl % T_;
        const float* sh2 = mod + b * MOD6 + 3 * D_, *sc2 = sh2 + D_;
        f32x4 o[4]; float s = 0.f;
#pragma unroll
        for (int j = 0; j < 4; ++j) { const u32x2 hw = *(const u32x2*)(h + (size_t)rl * D_ + j * 256 + lane * 4); o[j] = (f32x4){bflo(hw.x), bfhi(hw.x), bflo(hw.y), bfhi(hw.y)}; s += (o[j].x * o[j].x + o[j].y * o[j].y) + (o[j].z * o[j].z + o[j].w * o[j].w); }
        const float rstd = rsqrtf(wave_sum(s) * (1.f / D_) + 1e-6f);
#pragma unroll
        for (int j = 0; j < 4; ++j) {
            const int d = j * 256 + lane * 4;
            const f32x4 gg = *(const f32x4*)(g + d), ss = *(const f32x4*)(sc2 + d), hh = *(const f32x4*)(sh2 + d);
            o[j] = o[j] * rstd * gg * (ss + 1.f) + hh;
            *(unsigned*)(xn2 + (size_t)rl * D_ + d) = pk4_f8(o[j].x, o[j].y, o[j].z, o[j].w);
        }
        float lg[16];
        const LAS float* RW = RWT + lane * 4;
#pragma unroll
        for (int e = 0; e < 16; ++e) {
            float a0 = 0.f;
#pragma unroll
            for (int j = 0; j < 4; ++j) { const f32x4 w4 = *(const LAS f32x4*)(RW + e * 1024 + j * 256); a0 += (o[j].x * w4.x + o[j].y * w4.y) + (o[j].z * w4.z + o[j].w * w4.w); }
            lg[e] = a0;
        }
        float x8[8], x4[4], x2[2], x1;
#pragma unroll
        for (int i = 0; i < 8; ++i) { const bool up = lane & 32; const float send = up ? lg[i] : lg[i + 8], keep = up ? lg[i + 8] : lg[i]; x8[i] = keep + __shfl_xor(send, 32); }
#pragma unroll
        for (int i = 0; i < 4; ++i) { const bool up = lane & 16; const float send = up ? x8[i] : x8[i + 4], keep = up ? x8[i + 4] : x8[i]; x4[i] = keep + __shfl_xor(send, 16); }
#pragma unroll
        for (int i = 0; i < 2; ++i) { const bool up = lane & 8; const float send = up ? x4[i] : x4[i + 2], keep = up ? x4[i + 2] : x4[i]; x2[i] = keep + __shfl_xor(send, 8); }
        { const bool up = lane & 4; const float send = up ? x2[0] : x2[1], keep = up ? x2[1] : x2[0]; x1 = keep + __shfl_xor(send, 4); }
        x1 += __shfl_xor(x1, 2); x1 += __shfl_xor(x1, 1);
        float mx = x1;
        mx = fmaxf(mx, __shfl_xor(mx, 4)); mx = fmaxf(mx, __shfl_xor(mx, 8)); mx = fmaxf(mx, __shfl_xor(mx, 16)); mx = fmaxf(mx, __shfl_xor(mx, 32));
        const float ex = expf(x1 - mx);
        float sm = ex;
        sm += __shfl_xor(sm, 4); sm += __shfl_xor(sm, 8); sm += __shfl_xor(sm, 16); sm += __shfl_xor(sm, 32);
        const int e = ((lane >> 5) & 1) * 8 + ((lane >> 4) & 1) * 4 + ((lane >> 3) & 1) * 2 + ((lane >> 2) & 1);
        if ((lane & 3) == 0) aff[((size_t)b * E_ + e) * T_ + t] = ex / sm;
    }
}

__device__ __forceinline__ void phase_topk(const Params& p, LAS unsigned char* lds) {
    LAS unsigned* hist = (LAS unsigned*)lds;
    LAS unsigned* wsum = hist + 256;
    LAS unsigned* bc = wsum + 8;
    const float* aff = (const float*)(p.ws + OFF_AFF);
    int* idx = (int*)(p.ws + OFF_IDX); float* gate = (float*)(p.ws + OFF_GATE); int* sel = (int*)(p.ws + OFF_SEL);
    const int tid = threadIdx.x, lane = tid & 63, wave = tid >> 6;
    for (int be = blockIdx.x; be < B_ * E_; be += gridDim.x) {
        const int b = be / E_, e = be % E_;
        unsigned key[8];
        { const u32x4 k0 = *(const u32x4*)(aff + (size_t)be * T_ + tid * 8), k1 = *(const u32x4*)(aff + (size_t)be * T_ + tid * 8 + 4);
          key[0] = k0.x; key[1] = k0.y; key[2] = k0.z; key[3] = k0.w; key[4] = k1.x; key[5] = k1.y; key[6] = k1.z; key[7] = k1.w; }
        unsigned prefix = 0u, need = CAP;
#pragma unroll 1
        for (int pass = 0; pass < 4; ++pass) {
            const int shift = 24 - 8 * pass;
            __syncthreads();
            if (tid < 256) hist[tid] = 0u;
            __syncthreads();
#pragma unroll
            for (int i = 0; i < 8; ++i) if (pass == 0 || (key[i] >> (shift + 8)) == prefix) __hip_atomic_fetch_add(&hist[(key[i] >> shift) & 255u], 1u, __ATOMIC_RELAXED, __HIP_MEMORY_SCOPE_WORKGROUP);
            __syncthreads();
            if (wave == 0) {
                const unsigned h0 = hist[4 * lane], h1 = hist[4 * lane + 1], h2 = hist[4 * lane + 2], h3 = hist[4 * lane + 3];
                const unsigned s = h0 + h1 + h2 + h3;
                unsigned suf = s;
#pragma unroll
                for (int o = 1; o < 64; o <<= 1) { const unsigned t = __shfl_down(suf, o); if (lane + o < 64) suf += t; }
                const unsigned above = suf - s;
                if (above < need && need <= suf) {
                    unsigned c = above, bin, nn;
                    if (c + h3 >= need) { bin = 4 * lane + 3; nn = need - c; }
                    else { c += h3; if (c + h2 >= need) { bin = 4 * lane + 2; nn = need - c; }
                    else { c += h2; if (c + h1 >= need) { bin = 4 * lane + 1; nn = need - c; }
                    else { c += h1; bin = 4 * lane; nn = need - c; } } }
                    bc[0] = bin; bc[1] = nn;
                }
            }
            __syncthreads();
            prefix = (prefix << 8) | bc[0]; need = bc[1];
        }
        unsigned cg = 0u, ce = 0u;
#pragma unroll
        for (int i = 0; i < 8; ++i) { cg += key[i] > prefix ? 1u : 0u; ce += key[i] == prefix ? 1u : 0u; }
        unsigned pk = cg | (ce << 16), inc = pk;
#pragma unroll
        for (int o = 1; o < 64; o <<= 1) { const unsigned t = __shfl_up(inc, o); if (lane >= o) inc += t; }
        __syncthreads();
        if (lane == 63) wsum[wave] = inc;
        __syncthreads();
        unsigned base = 0u;
#pragma unroll
        for (int w = 0; w < 8; ++w) base += w < wave ? wsum[w] : 0u;
        unsigned excl = base + inc - pk;
        unsigned gtb = excl & 0xffffu, eqb = excl >> 16;
#pragma unroll
        for (int i = 0; i < 8; ++i) {
            const int t = tid * 8 + i;
            const bool isg = key[i] > prefix, ise = key[i] == prefix;
            const bool take = isg || (ise && eqb < need);
            const int slot = (int)(gtb + (eqb < need ? eqb : need));
            if (take) { idx[e * 4096 + b * CAP + slot] = b * T_ + t; gate[e * 4096 + b * CAP + slot] = __uint_as_float(key[i]); }
            sel[(size_t)be * T_ + t] = take ? slot : -1;
            gtb += isg ? 1u : 0u; eqb += ise ? 1u : 0u;
        }
    }
}

__device__ __forceinline__ void phase_gather(const Params& p) {
    const int lane = threadIdx.x & 63, wave = threadIdx.x >> 6;
    const int gw = blockIdx.x * NW + wave, NGW = gridDim.x * NW;
    const unsigned char* xn2 = p.ws + OFF_XN2; const int* idx = (const int*)(p.ws + OFF_IDX);
    unsigned char* xs = p.ws + OFF_XS;
    for (int r = gw; r < E_ * 4096; r += NGW) *(u32x4*)(xs + (size_t)r * D_ + lane * 16) = *(const u32x4*)(xn2 + (size_t)idx[r] * D_ + lane * 16);
}

__device__ __forceinline__ void phase_final(const Params& p) {
    const int lane = threadIdx.x & 63, wave = threadIdx.x >> 6;
    const int gw = blockIdx.x * NW + wave, NGW = gridDim.x * NW;
    const float* mod = (const float*)(p.ws + OFF_MOD); const float* fg = p.in[29];
    const bf16* ys = (const bf16*)(p.ws + OFF_YS); const int* sel = (const int*)(p.ws + OFF_SEL); const float* aff = (const float*)(p.ws + OFF_AFF);
    float* out = p.out; const bf16* hb = (const bf16*)(p.ws + OFF_H);
    int cs = -1; float cg = 0.f;
    if (gw < NLAT && lane < 16) { const size_t o = ((size_t)(gw / T_) * E_ + lane) * T_ + gw % T_; cs = sel[o]; cg = aff[o]; }
    for (int rl = gw; rl < NLAT; rl += NGW) {
        const int b = rl / T_;
        const int myslot = cs; const float mygate = cg;
        { const int rn = rl + NGW; if (rn < NLAT && lane < 16) { const size_t o = ((size_t)(rn / T_) * E_ + lane) * T_ + rn % T_; cs = sel[o]; cg = aff[o]; } }
        f32x4 hv[4];
#pragma unroll
        for (int j = 0; j < 4; ++j) { const u32x2 hw = *(const u32x2*)(hb + (size_t)rl * D_ + j * 256 + lane * 4); hv[j] = (f32x4){bflo(hw.x), bfhi(hw.x), bflo(hw.y), bfhi(hw.y)}; }
        f32x4 acc[4];
#pragma unroll
        for (int j = 0; j < 4; ++j) acc[j] = (f32x4){0.f, 0.f, 0.f, 0.f};
        unsigned mm = (unsigned)__ballot(myslot >= 0) & 0xffffu;
        while (mm) {
            int ee[4]; float gg[4]; const bf16* yr[4];
#pragma unroll
            for (int i = 0; i < 4; ++i) { const bool v = mm != 0u; ee[i] = v ? __builtin_ctz(mm) : ee[0]; mm = v ? (mm & (mm - 1u)) : 0u;
                const int sl = __shfl(myslot, ee[i]); const float gt = __shfl(mygate, ee[i]); gg[i] = v ? gt : 0.f;
                yr[i] = ys + ((size_t)ee[i] * 4096 + b * CAP + sl) * D_ + lane * 4; }
            u32x2 w[4][4];
#pragma unroll
            for (int i = 0; i < 4; ++i)
#pragma unroll
                for (int j = 0; j < 4; ++j) w[i][j] = *(const u32x2*)(yr[i] + j * 256);
#pragma unroll
            for (int i = 0; i < 4; ++i)
#pragma unroll
                for (int j = 0; j < 4; ++j) { acc[j].x += gg[i] * bflo(w[i][j].x); acc[j].y += gg[i] * bfhi(w[i][j].x); acc[j].z += gg[i] * bflo(w[i][j].y); acc[j].w += gg[i] * bfhi(w[i][j].y); }
        }
        const float* g2 = mod + b * MOD6 + 5 * D_;
        f32x4 o[4]; float s2 = 0.f;
#pragma unroll
        for (int j = 0; j < 4; ++j) { const int d = j * 256 + lane * 4; o[j] = hv[j] + *(const f32x4*)(g2 + d) * acc[j];
            s2 += (o[j].x * o[j].x + o[j].y * o[j].y) + (o[j].z * o[j].z + o[j].w * o[j].w); }
        const float rstd = rsqrtf(wave_sum(s2) * (1.f / D_) + 1e-6f);
#pragma unroll
        for (int j = 0; j < 4; ++j) { const int d = j * 256 + lane * 4; *(f32x4*)(out + (size_t)rl * D_ + d) = o[j] * rstd * *(const f32x4*)(fg + d); }
    }
}


#define GAS __attribute__((address_space(1)))
#define XB_TMO      128
#define XB_XCNT(j)  (256  + 64 * (j))
#define XB_XSUB(j)  (1280 + 64 * (j))
#define XB_XGEN(j)  (2304 + 64 * (j))
#define XB_TOP      3328
#define XB_TOPGEN   3392
#define XCD_BAR_WORDS 3456
#define XB_SPIN_CAP (1u << 24)

__device__ __forceinline__ unsigned xb_ld(unsigned* p)              { return __hip_atomic_load(p, __ATOMIC_RELAXED, __HIP_MEMORY_SCOPE_AGENT); }
__device__ __forceinline__ unsigned xb_add(unsigned* p, unsigned v) { return __hip_atomic_fetch_add(p, v, __ATOMIC_RELAXED, __HIP_MEMORY_SCOPE_AGENT); }
__device__ __forceinline__ unsigned xb_xcc_id() { return (unsigned)__builtin_amdgcn_s_getreg((3 << 11) | 20) & 0xFu; }
#define XB_SPIN(cond, bar) do { unsigned _sp = 0; while (cond) { __builtin_amdgcn_s_sleep(1); \
    if ((++_sp & 255u) == 0u) { if (xb_ld(&(bar)[XB_TMO])) break; if (_sp > XB_SPIN_CAP) { atomicAdd(&(bar)[XB_TMO], 1u); break; } } } } while (0)

struct XcdBarrier {
    unsigned* bar; unsigned x;
    volatile LAS unsigned* st;
};

__device__ __forceinline__ XcdBarrier xcd_barrier_post(unsigned* bar, volatile LAS unsigned* st) {
    XcdBarrier b; b.bar = bar; b.x = xb_xcc_id(); b.st = st;
    if (threadIdx.x == 0) (void)xb_add(&bar[XB_XCNT(b.x)], 1u);
    return b;
}
__device__ __forceinline__ void xcd_barrier_complete(unsigned* bar, unsigned x, unsigned& nloc, unsigned& nx) {
    const unsigned G = gridDim.x * gridDim.y * gridDim.z;
    unsigned sum, cnt, mine, sp = 0u;
    for (;;) {
        sum = 0u; cnt = 0u; mine = 0u;
#pragma unroll
        for (unsigned j = 0; j < 16; ++j) { const unsigned c = xb_ld(&bar[XB_XCNT(j)]); sum += c; cnt += (c > 0u) ? 1u : 0u; mine = (j == x) ? c : mine; }
        if (sum == G) break;
        __builtin_amdgcn_s_sleep(1);
        if ((++sp & 255u) == 0u) { if (xb_ld(&bar[XB_TMO])) break; if (sp > XB_SPIN_CAP) { atomicAdd(&bar[XB_TMO], 1u); break; } }
    }
    nloc = mine > 0u ? mine : 1u; nx = cnt > 0u ? cnt : 1u;
}

__device__ __forceinline__ void xcd_barrier(const XcdBarrier& b) {
    asm volatile("s_waitcnt vmcnt(0)" ::: "memory");
    __syncthreads();
    if (threadIdx.x == 0) {
        unsigned* bar = b.bar;
        __builtin_amdgcn_s_waitcnt(0);
        unsigned nloc = b.st[0], nx = b.st[1];
        if (nloc == 0u) { xcd_barrier_complete(bar, b.x, nloc, nx); b.st[0] = nloc; b.st[1] = nx; }
        const unsigned old = xb_add(&bar[XB_XSUB(b.x)], 1u);
        const unsigned gen = old / nloc;
        if (old + 1u == (gen + 1u) * nloc) {
            __builtin_amdgcn_fence(__ATOMIC_RELEASE, "agent");
            asm volatile("s_waitcnt vmcnt(0)" ::: "memory");
            const unsigned og = xb_add(&bar[XB_TOP], 1u);
            const unsigned tg = og / nx;
            if (og + 1u == (tg + 1u) * nx) xb_add(&bar[XB_TOPGEN], 1u);
            else XB_SPIN(xb_ld(&bar[XB_TOPGEN]) == tg, bar);
            __builtin_amdgcn_fence(__ATOMIC_ACQUIRE, "agent");
            xb_add(&bar[XB_XGEN(b.x)], 1u);
            asm volatile("s_waitcnt vmcnt(0)" ::: "memory");
        } else {
            XB_SPIN(xb_ld(&bar[XB_XGEN(b.x)]) == gen, bar);
            __builtin_amdgcn_fence(__ATOMIC_ACQUIRE, "agent");
            asm volatile("s_waitcnt vmcnt(0)" ::: "memory");
        }
    }
    __syncthreads();
}


__device__ __forceinline__ void phase_expert_dynamic(const Params& p, LAS unsigned char* lds, volatile LAS unsigned* misc, unsigned* xctr) {
    const int lane = threadIdx.x & 63, wave = threadIdx.x >> 6; LAS float* scr = (LAS float*)(lds + wave * 16384);
    constexpr int XCH = 64;
    static_assert(EXP_ITEMS % XCH == 0, "chunking");
    __syncthreads();
    if (threadIdx.x == 0) misc[8] = xb_add(xctr, 1u);
    __syncthreads();
    unsigned cur = misc[8];
#pragma unroll 1
    while (cur < (unsigned)(EXP_ITEMS / XCH)) {
        unsigned nxt = 0u; if (threadIdx.x == 0) nxt = xb_add(xctr, 1u);
        const int it0 = (int)cur * XCH + wave;
        XRaw Ra, Rb;
        expert_load(p, it0, lane, Ra);
#pragma unroll 1
        for (int j = 0; j < XCH / NW; j += 2) {
            expert_load(p, it0 + (j + 1) * NW, lane, Rb);
            expert_finish(p, scr, it0 + j * NW, lane, Ra);
            if (j + 2 < XCH / NW) expert_load(p, it0 + (j + 2) * NW, lane, Ra);
            expert_finish(p, scr, it0 + (j + 1) * NW, lane, Rb);
        }
        __syncthreads();
        if (threadIdx.x == 0) misc[8] = nxt;
        __syncthreads();
        cur = misc[8];
    }
}

constexpr int N_PHASES = 17;
__global__ void __launch_bounds__(NT) mega(Params p) {
    extern __shared__ __attribute__((aligned(16))) unsigned char lds_raw[];
    LAS unsigned char* lds = (LAS unsigned char*)lds_raw;
    cg::grid_group grid = cg::this_grid();
    unsigned char* ws = p.ws;
    const int G = gridDim.x;
    const int lo = p.ph_lo, hi = p.ph_hi;
    volatile LAS unsigned* misc = (volatile LAS unsigned*)(lds + LDS_BYTES - 64);
    if (threadIdx.x < 16) misc[threadIdx.x] = 0u;
    __syncthreads();
    XcdBarrier bar; bar.bar = (unsigned*)(ws + OFF_BAR); bar.x = 0; bar.st = nullptr;
    if (hi - lo > 1) bar = xcd_barrier_post((unsigned*)(ws + OFF_BAR), misc);
#ifndef PHMASK
#define PHMASK 0xFFFFFFFFu
#endif
#define IN(k) (((PHMASK >> (k)) & 1) && lo <= (k) && (k) < hi)
#define SEAM(k) do { if (IN(k) && IN((k) + 1)) { if ((k) == 0 && G != 256) grid.sync(); else xcd_barrier(bar); } } while (0)
#ifndef PROBE_PH
#define PROBE_PH (-1)
#endif
#define RUNPH(k, ...) do { if (IN(k)) { __VA_ARGS__; if (PROBE_PH == (k)) { xcd_barrier(bar); __VA_ARGS__; } } } while (0)
    RUNPH(0, phase_prep(p, lds));
    SEAM(0);
    RUNPH(1, phase_norm1(p));
    SEAM(1);
    RUNPH(2, { pg8::Gemm g{(const bf16*)(ws + OFF_XN1), (const bf16*)(ws + OFF_WIN), NROW, UC, D_}; pg8::StaticOrder S; S.init(NROW, UC, G, blockIdx.x);
                 EpiU E{(bf16*)(ws + OFF_U), UC}; pg8::gemm_phase<EpiU, pg8::StaticOrder, true, true>(lds, g, S, E); });
    SEAM(2);
    RUNPH(3, phase_qk(p));
    RUNPH(4, {
        constexpr int NTILE = 128 + 2048;
        for (int t = blockIdx.x; t < NTILE; t += G) rwkv_prep_tile(p, lds, t);
    });
    SEAM(4);
    RUNPH(5, {
        unsigned* mdone = (unsigned*)(ws + OFF_BAR) + 3520; unsigned* xctr = mdone + 64;
        if (G == 256) {
            if (blockIdx.x < 128) rwkv_chunk_item(p, lds, blockIdx.x);
            else { mlstm_item(p, lds, blockIdx.x - 128); __syncthreads(); if (threadIdx.x == 0) { __threadfence(); xb_add(mdone, 1u); } }
            if (threadIdx.x == 0) { while (xb_ld(mdone) < 128u) __builtin_amdgcn_s_sleep(8); }
            __syncthreads();
        } else {
            for (int it = blockIdx.x; it < 128; it += G) mlstm_item(p, lds, it);
            __syncthreads();
            for (int it = blockIdx.x; it < 128; it += G) rwkv_chunk_item(p, lds, it);
            xcd_barrier(bar);
        }
        phase_expert_dynamic(p, lds, misc, xctr);
    });
    SEAM(5);
    RUNPH(6, phase_combine(p));
    SEAM(6);
    RUNPH(7, { pg8::Gemm g{(const bf16*)(ws + OFF_MIX), (const bf16*)(ws + OFF_WOUT), NLAT, D_, D_}; pg8::StaticOrder S; S.init(NLAT, D_, G, blockIdx.x);
                 EpiH E{p.in[0], (const float*)(ws + OFF_MOD), (bf16*)(ws + OFF_H)}; pg8::gemm_phase<EpiH, pg8::StaticOrder, true, true>(lds, g, S, E); });
    SEAM(7);
    RUNPH(9, phase_norm2(p, lds));
    SEAM(9);
    RUNPH(10, phase_topk(p, lds));
    SEAM(10);
#pragma unroll 1
    for (int gi = 0; gi < NG; ++gi) {
        RUNPH(12 + 2 * gi, {
            pg8::Gemm g{(const bf16*)(ws + OFF_XN2), (const bf16*)(ws + OFF_W13 + (size_t)gi * EG * 5632 * D_), EG * 4096, EG * 5632, D_ / 2, 0x7A7A7A7A, 0x7F7F7F7F, (const int*)(ws + OFF_IDX) + (size_t)gi * EG * 4096};
            ExpertOrder S{22, G, (int)blockIdx.x}; EpiHid E{ws + OFF_HID, 22};
            pg8::gemm_phase<EpiHid, ExpertOrder, true, true, true, true>(lds, g, S, E); });
        SEAM(12 + 2 * gi);
        RUNPH(13 + 2 * gi, {
            pg8::Gemm g{(const bf16*)(ws + OFF_HID), (const bf16*)(ws + OFF_W2 + (size_t)gi * EG * D_ * DE), EG * 4096, EG * D_, DE / 2, 0x79797979, 0x7C7C7C7C};
            ExpertOrder S{4, G, (int)blockIdx.x}; EpiYs E{(bf16*)(ws + OFF_YS) + (size_t)gi * EG * 4096 * D_, (const float*)(ws + OFF_GATE) + (size_t)gi * EG * 4096, 4};
            pg8::gemm_phase<EpiYs, ExpertOrder, true, true, true>(lds, g, S, E); });
        SEAM(13 + 2 * gi);
    }
    if (IN(16)) phase_final(p);
}
}

#ifndef MK_SPLIT
#define MK_SPLIT 0
#endif
extern "C" void kernel_launch(void* const* d_in, const int* in_sizes, int n_in, void* d_out, int out_size, void* d_ws, size_t ws_size, hipStream_t stream) {
    static int grid = 0;
    if (grid == 0) {
        int dev = 0, cus = 0, per_cu = 0;
        (void)hipGetDevice(&dev);
        (void)hipDeviceGetAttribute(&cus, hipDeviceAttributeMultiprocessorCount, dev);
        (void)hipFuncSetAttribute((const void*)mega, hipFuncAttributeMaxDynamicSharedMemorySize, LDS_BYTES);
        (void)hipOccupancyMaxActiveBlocksPerMultiprocessor(&per_cu, (const void*)mega, NT, LDS_BYTES);
        if (per_cu < 1) { fprintf(stderr, "kernel_launch: occupancy query reports %d blocks per CU\n", per_cu); per_cu = 1; }
        grid = cus * 1;
        if (ws_size < WS_END) { fprintf(stderr, "kernel_launch: workspace too small (%zu < %zu)\n", ws_size, (size_t)WS_END); grid = -1; }
    }
    if (grid < 0) return;
    if (hipMemsetAsync((char*)d_ws + OFF_BAR, 0, 16384, stream) != hipSuccess) { fprintf(stderr, "kernel_launch: memset of the barrier words failed\n"); return; }
    Params p{};
    for (int i = 0; i < 30; ++i) p.in[i] = (const float*)d_in[i];
    p.out = (float*)d_out; p.ws = (unsigned char*)d_ws;
#if MK_SPLIT
    for (int ph = 0; ph < N_PHASES; ++ph) { p.ph_lo = ph; p.ph_hi = ph + 1; hipLaunchKernelGGL(mega, dim3(grid), dim3(NT), LDS_BYTES, stream, p); }
#else
    p.ph_lo = 0; p.ph_hi = N_PHASES;
    void* args[] = {&p};
    hipError_t e = hipLaunchCooperativeKernel((const void*)mega, dim3(grid), dim3(NT), args, LDS_BYTES, stream);
    if (e != hipSuccess) fprintf(stderr, "cooperative launch failed: %s (grid %d)\n", hipGetErrorString(e), grid);
#endif
}
```

```cpp
#include <hip/hip_runtime.h>
#include <hip/hip_cooperative_groups.h>
#include <stdint.h>
#include <cstdio>
namespace cg = cooperative_groups;

namespace pg8 {
#define PG8_LAS __attribute__((address_space(3)))
typedef unsigned short bf16_t;
typedef short bf16x8 __attribute__((ext_vector_type(8)));
typedef float f32x4 __attribute__((ext_vector_type(4)));
typedef unsigned u32x4 __attribute__((ext_vector_type(4)));
constexpr int BM = 256, BK = 64, HALF = 128, HTB = HALF * BK * 2  , STAGE_BYTES = 8 * HTB, NXCD = 8, WGM = 8;

__host__ __device__ __forceinline__ int lds_byte(int r, int c) { const int st = (r >> 4) * 2 + (c >> 5), rr = r & 15, cc = c & 31, ob = rr * 64 + cc * 2; return st * 1024 + (ob ^ (((ob >> 9) & 1) << 5)); }
__host__ __device__ __forceinline__ void stage_rc(int b, int& R, int& C) { const int st = b / 1024, sb = b % 1024, swz = sb ^ (((sb >> 9) & 1) << 5); R = (st >> 1) * 16 + swz / 64; C = (st & 1) * 32 + (swz % 64) / 2; }
__host__ __device__ __forceinline__ int perm32(int rho) { const int n = rho >> 4, i = rho & 15; return 8 * (i >> 2) + 4 * n + (i & 3); }

struct Unit { int pm, pn; };
struct Gemm { const bf16_t* A; const bf16_t* Bt; int M, N, K; int sa, sb; const int* gidx; };
typedef int i32x8 __attribute__((ext_vector_type(8)));
typedef int i32x4v __attribute__((ext_vector_type(4)));
__device__ __forceinline__ i32x8 cat8(bf16x8 a, bf16x8 b) { const i32x4v x = __builtin_bit_cast(i32x4v, a), y = __builtin_bit_cast(i32x4v, b); return __builtin_shufflevector(x, y, 0, 1, 2, 3, 4, 5, 6, 7); }

struct StaticOrder {
    int nM, nN, nwg, G, c;
    __host__ __device__ void init(int M, int N, int G_, int c_) { nM = M / BM; nN = N / BM; nwg = nM * nN; G = G_; c = c_; }
    __host__ __device__ bool next(int i, Unit& u) const {
        const long L = (long)i * G + c; if (L >= nwg) return false;
        int wgid = (int)L; { const int q = nwg / NXCD, r = nwg % NXCD, xcd = wgid % NXCD, off = wgid / NXCD; wgid = (xcd < r ? xcd * (q + 1) : r * (q + 1) + (xcd - r) * q) + off; }
        const int nig = WGM * nN, gid = wgid / nig, fm = gid * WGM, gsz = (nM - fm) < WGM ? (nM - fm) : WGM;
        u.pm = fm + ((wgid % nig) % gsz); u.pn = (wgid % nig) / gsz; return true;
    }
    __device__ __forceinline__ void a_ready(const Unit&) const {}
    __device__ __forceinline__ void done(const Unit&) const {}
};


template <class Epi, class Sched, bool ALIGN_EPI = false, bool SP2 = false, bool F8 = false, bool GATHER = false>
__device__ __forceinline__ void gemm_phase(PG8_LAS unsigned char* lds, const Gemm g, const Sched& S, const Epi& E) {
    const int tid = threadIdx.x, wid = __builtin_amdgcn_readfirstlane(tid >> 6), lane = tid & 63, wr = wid >> 2, wc = wid & 3, fr = lane & 15, fq = lane >> 4;
    const int K = g.K, nt = K / BK;
    unsigned voffA[2], voffB[2]; int gR[2]; unsigned gC[2];
#pragma unroll
    for (int i = 0; i < 2; ++i) { int R, C; stage_rc(tid * 16 + i * 8192, R, C); const int Rb = Epi::PERM ? ((R & ~31) + perm32(R & 31)) : R;
        voffA[i] = (unsigned)(R * K + C) * 2u; voffB[i] = (unsigned)(Rb * K + C) * 2u; gR[i] = R; gC[i] = (unsigned)C * 2u; }
    unsigned cG[2][2], nG[2][2];
#define PG8_GOFF(dst, pm_) do { _Pragma("unroll") for (int _h = 0; _h < 2; ++_h) _Pragma("unroll") for (int _i = 0; _i < 2; ++_i) dst[_h][_i] = (unsigned)g.gidx[(pm_) * BM + _h * HALF + gR[_i]] * (unsigned)(K * 2) + gC[_i]; } while (0)
    const size_t kstep = (size_t)(BK * 2);
    const size_t hstep = (size_t)HALF * K * 2;
    const size_t tstep = 2 * hstep;
    const unsigned ldsw = (unsigned)wid * 1024u;
    const int aoff = lds_byte(wr * 64 + fr, fq * 8), boff = lds_byte(wc * 32 + fr, fq * 8);
#define PG8_SA(b, h) (((b) * 2 + (h)) * HTB)
#define PG8_SB(b, h) ((4 + (b) * 2 + (h)) * HTB)
#define PG8_STAGE(bufoff, gbase, voff) do { _Pragma("unroll") for (int _i = 0; _i < 2; ++_i) \
        __builtin_amdgcn_global_load_lds((const unsigned*)((const char*)(gbase) + (voff)[_i]), (PG8_LAS unsigned*)(lds + (bufoff) + ldsw + _i * 8192), 16, 0, 0); } while (0)
#define PG8_STAGE_A(bufoff, abase, half, nx) do { if constexpr (GATHER) { _Pragma("unroll") for (int _i = 0; _i < 2; ++_i) { const unsigned _o = (nx) ? nG[half][_i] : cG[half][_i]; \
        __builtin_amdgcn_global_load_lds((const unsigned*)((const char*)(abase) + _o), (PG8_LAS unsigned*)(lds + (bufoff) + ldsw + _i * 8192), 16, 0, 0); } } \
        else PG8_STAGE(bufoff, (abase) + (half) * hstep, voffA); } while (0)
#define PG8_LDA(dst, b, h) do { _Pragma("unroll") for (int m = 0; m < 4; ++m) { if constexpr (F8) { dst##8[m].lo = *(const PG8_LAS i32x4v*)(lds + PG8_SA(b, h) + aoff + m * 2048); dst##8[m].hi = *(const PG8_LAS i32x4v*)(lds + PG8_SA(b, h) + aoff + m * 2048 + 1024); } \
        else { _Pragma("unroll") for (int k = 0; k < 2; ++k) dst[m][k] = *(const PG8_LAS bf16x8*)(lds + PG8_SA(b, h) + aoff + m * 2048 + k * 1024); } } } while (0)
#define PG8_LDB(dst, b, h) do { _Pragma("unroll") for (int n = 0; n < 2; ++n) { if constexpr (F8) { dst##8[n].lo = *(const PG8_LAS i32x4v*)(lds + PG8_SB(b, h) + boff + n * 2048); dst##8[n].hi = *(const PG8_LAS i32x4v*)(lds + PG8_SB(b, h) + boff + n * 2048 + 1024); } \
        else { _Pragma("unroll") for (int k = 0; k < 2; ++k) dst[n][k] = *(const PG8_LAS bf16x8*)(lds + PG8_SB(b, h) + boff + n * 2048 + k * 1024); } } } while (0)
#define PG8_MMA(ai, bj, At, Bt) do { __builtin_amdgcn_s_setprio(1); _Pragma("unroll") for (int m = 0; m < 4; ++m) _Pragma("unroll") for (int n = 0; n < 2; ++n) { \
        if constexpr (F8) asm volatile("v_mfma_scale_f32_16x16x128_f8f6f4 %0, %1, %2, %0, %3, %4 op_sel_hi:[0,0,0]" : "+v"(acc[ai][bj][m][n]) : "v"(Bt##8[n]), "v"(At##8[m]), "v"(f8sa), "v"(f8sb)); \
        else { _Pragma("unroll") for (int k = 0; k < 2; ++k) acc[ai][bj][m][n] = __builtin_amdgcn_mfma_f32_16x16x32_bf16(Bt[n][k], At[m][k], acc[ai][bj][m][n], 0, 0, 0); } } \
        __builtin_amdgcn_s_setprio(0); } while (0)
#define PG8_WAIT_V(n) asm volatile("s_waitcnt vmcnt(" #n ")" ::: "memory")
#define PG8_WAIT_L(n) asm volatile("s_waitcnt lgkmcnt(" #n ")" ::: "memory")
#define PG8_BAR __builtin_amdgcn_s_barrier()
#define PG8_SCHED __builtin_amdgcn_sched_barrier(0)
    Unit cur, nxt; int ui = 0;
    if (!S.next(0, cur)) return;
    f32x4 acc[2][2][4][2];
#pragma unroll
    for (int a = 0; a < 2; ++a)
#pragma unroll
        for (int b = 0; b < 2; ++b)
#pragma unroll
            for (int m = 0; m < 4; ++m)
#pragma unroll
                for (int n = 0; n < 2; ++n) acc[a][b][m][n] = (f32x4){0.f, 0.f, 0.f, 0.f};
    bf16x8 At[4][2], B0[2][2], B1[2][2];
    i32x8 At8[4], B08[2], B18[2];
    const int f8sa = g.sa, f8sb = g.sb;
    const char* cA = (const char*)g.A + (GATHER ? (size_t)0 : (size_t)cur.pm * tstep); const char* cB = (const char*)g.Bt + (size_t)cur.pn * tstep;
    if constexpr (GATHER) { PG8_GOFF(cG, cur.pm); }
    S.a_ready(cur);
    if constexpr (SP2) {
        PG8_STAGE(PG8_SB(0, 0), cB, voffB); PG8_STAGE(PG8_SB(0, 1), cB + hstep, voffB); PG8_STAGE_A(PG8_SA(0, 0), cA, 0, false); PG8_STAGE_A(PG8_SA(0, 1), cA, 1, false);
        if (wr == 1) PG8_BAR;
        PG8_WAIT_V(2); PG8_BAR;
        PG8_STAGE(PG8_SB(1, 0), cB + kstep, voffB); PG8_STAGE_A(PG8_SA(1, 0), cA + kstep, 0, false); PG8_STAGE(PG8_SB(1, 1), cB + hstep + kstep, voffB);
        PG8_WAIT_V(6); PG8_BAR;
    } else {
        PG8_STAGE(PG8_SB(0, 0), cB, voffB); PG8_STAGE_A(PG8_SA(0, 0), cA, 0, false); PG8_STAGE(PG8_SB(0, 1), cB + hstep, voffB); PG8_STAGE_A(PG8_SA(0, 1), cA, 1, false);
        if (wr == 1) PG8_BAR;
        PG8_WAIT_V(4); PG8_BAR;
        PG8_STAGE(PG8_SB(1, 0), cB + kstep, voffB); PG8_STAGE_A(PG8_SA(1, 0), cA + kstep, 0, false); PG8_STAGE(PG8_SB(1, 1), cB + hstep + kstep, voffB);
        PG8_WAIT_V(6); PG8_BAR;
    }
    for (;;) {
        const bool has_next = S.next(ui + 1, nxt);
        if constexpr (GATHER) { if (has_next) { PG8_GOFF(nG, nxt.pm); } else { _Pragma("unroll") for (int _h = 0; _h < 2; ++_h) _Pragma("unroll") for (int _i = 0; _i < 2; ++_i) nG[_h][_i] = cG[_h][_i]; } }
        const char* nA = (has_next && !GATHER) ? (const char*)g.A + (size_t)nxt.pm * tstep : cA; const char* nB = has_next ? (const char*)g.Bt + (size_t)nxt.pn * tstep : cB;
        for (int t = 0; t < nt; t += 2) {
            const bool last = (t == nt - 2);
            const char* a1 = cA + (size_t)(t + 1) * kstep;
            const char* a2 = last ? nA : cA + (size_t)(t + 2) * kstep; const char* b2 = last ? nB : cB + (size_t)(t + 2) * kstep;
            const char* a3 = a2 + kstep; const char* b3 = b2 + kstep;
            if (last && has_next) S.a_ready(nxt);
            if constexpr (SP2) {
            PG8_LDB(B0, 0, 0); PG8_LDB(B1, 0, 1); PG8_SCHED; PG8_LDA(At, 0, 0); PG8_STAGE_A(PG8_SA(1, 1), a1, 1, false);
            PG8_WAIT_V(8); PG8_WAIT_L(0); PG8_BAR; PG8_MMA(0, 0, At, B0); PG8_MMA(0, 1, At, B1); PG8_BAR; PG8_SCHED;
            PG8_LDA(At, 0, 1); PG8_STAGE(PG8_SB(0, 0), b2, voffB); PG8_STAGE(PG8_SB(0, 1), b2 + hstep, voffB); PG8_STAGE_A(PG8_SA(0, 0), a2, 0, last);
            PG8_WAIT_V(8); PG8_WAIT_L(0); PG8_BAR; PG8_MMA(1, 0, At, B0); PG8_MMA(1, 1, At, B1); PG8_BAR; PG8_SCHED;
            PG8_LDB(B0, 1, 0); PG8_LDB(B1, 1, 1); PG8_SCHED; PG8_LDA(At, 1, 0); PG8_STAGE_A(PG8_SA(0, 1), a2, 1, last);
            PG8_WAIT_V(8); PG8_WAIT_L(0); PG8_BAR; PG8_MMA(0, 0, At, B0); PG8_MMA(0, 1, At, B1); PG8_BAR; PG8_SCHED;
            PG8_LDA(At, 1, 1); PG8_STAGE(PG8_SB(1, 0), b3, voffB); PG8_STAGE(PG8_SB(1, 1), b3 + hstep, voffB); PG8_STAGE_A(PG8_SA(1, 0), a3, 0, last);
            PG8_WAIT_V(8); PG8_WAIT_L(0); PG8_BAR; PG8_MMA(1, 0, At, B0); PG8_MMA(1, 1, At, B1); PG8_BAR; PG8_SCHED;
            } else {
            PG8_LDB(B0, 0, 0); PG8_SCHED; PG8_LDA(At, 0, 0); PG8_STAGE_A(PG8_SA(1, 1), a1, 1, false);
            PG8_WAIT_L(8); PG8_BAR; PG8_WAIT_L(0); PG8_MMA(0, 0, At, B0); PG8_BAR; PG8_SCHED;
            PG8_LDB(B1, 0, 1); PG8_STAGE(PG8_SB(0, 0), b2, voffB);
            PG8_BAR; PG8_WAIT_L(0); PG8_MMA(0, 1, At, B1); PG8_BAR;
            PG8_LDA(At, 0, 1); PG8_STAGE_A(PG8_SA(0, 0), a2, 0, last);
            PG8_BAR; PG8_WAIT_L(0); PG8_MMA(1, 0, At, B0); PG8_BAR; PG8_SCHED;
            PG8_STAGE(PG8_SB(0, 1), b2 + hstep, voffB);
            PG8_WAIT_V(6); PG8_BAR; PG8_MMA(1, 1, At, B1); PG8_BAR;
            PG8_LDB(B0, 1, 0); PG8_SCHED; PG8_LDA(At, 1, 0); PG8_STAGE_A(PG8_SA(0, 1), a2, 1, last);
            PG8_WAIT_L(8); PG8_BAR; PG8_WAIT_L(0); PG8_MMA(0, 0, At, B0); PG8_BAR; PG8_SCHED;
            PG8_LDB(B1, 1, 1); PG8_STAGE(PG8_SB(1, 0), b3, voffB);
            PG8_BAR; PG8_WAIT_L(0); PG8_MMA(0, 1, At, B1); PG8_BAR;
            PG8_LDA(At, 1, 1); PG8_STAGE_A(PG8_SA(1, 0), a3, 0, last);
            PG8_BAR; PG8_WAIT_L(0); PG8_MMA(1, 0, At, B0); PG8_BAR; PG8_SCHED;
            PG8_STAGE(PG8_SB(1, 1), b3 + hstep, voffB);
            PG8_WAIT_V(6); PG8_BAR; PG8_MMA(1, 1, At, B1); PG8_BAR;
            }
        }
        if constexpr (ALIGN_EPI) { if (wr == 0) PG8_BAR; }
        if constexpr (!Epi::AFTER_DRAIN) { E(acc, cur, wr, wc, fr, fq); S.done(cur); }
        if (!has_next) break;
#pragma unroll
        for (int a = 0; a < 2; ++a)
#pragma unroll
            for (int b = 0; b < 2; ++b)
#pragma unroll
                for (int m = 0; m < 4; ++m)
#pragma unroll
                    for (int n = 0; n < 2; ++n) acc[a][b][m][n] = (f32x4){0.f, 0.f, 0.f, 0.f};
        cur = nxt; cA = nA; cB = nB; ++ui;
        if constexpr (GATHER) { _Pragma("unroll") for (int _h = 0; _h < 2; ++_h) _Pragma("unroll") for (int _i = 0; _i < 2; ++_i) cG[_h][_i] = nG[_h][_i]; }
        if constexpr (ALIGN_EPI) { if (wr == 1) PG8_BAR; }
    }
    PG8_WAIT_V(0);
    if constexpr (!ALIGN_EPI) { if (wr == 0) PG8_BAR; }
    PG8_BAR;
    if constexpr (Epi::AFTER_DRAIN) { E.fused(acc, cur, wr, wc, fr, fq, lds, wid, lane); S.done(cur); }
#undef PG8_SA
#undef PG8_SB
#undef PG8_STAGE
#undef PG8_STAGE_A
#undef PG8_GOFF
#undef PG8_LDA
#undef PG8_LDB
#undef PG8_MMA
#undef PG8_WAIT_V
#undef PG8_WAIT_L
#undef PG8_BAR
#undef PG8_SCHED
}

}

namespace {
#define LAS __attribute__((address_space(3)))
typedef unsigned short bf16;
typedef float f32x4 __attribute__((ext_vector_type(4)));
typedef unsigned u32x4 __attribute__((ext_vector_type(4)));
typedef unsigned u32x2 __attribute__((ext_vector_type(2)));
constexpr int NT = 512, NW = 8;
constexpr int B_ = 8, T_ = 4096, TC_ = 256, D_ = 1024;
constexpr int NCTX = B_ * TC_, NLAT = B_ * T_, NROW = NCTX + NLAT;
constexpr int PIN = 4016, UC = 4096, MLC = 2064;
constexpr int E_ = 16, CAP = 512, DE = 2816, EG = 16  , NG = E_ / EG;
constexpr int MOD6 = 6 * D_;
constexpr int LDS_BYTES = 152 * 1024;
constexpr size_t MiB = 1024 * 1024;
constexpr size_t OFF_MOD = 0, OFF_LORA = 256 * 1024, OFF_AFF = 1 * MiB, OFF_IDX = 3 * MiB, OFF_GATE = 3 * MiB + 512 * 1024, OFF_SEL = 4 * MiB, OFF_BON = 6 * MiB, OFF_INVN = 8 * MiB, OFF_BAR = 10 * MiB;
constexpr size_t OFF_WIN = 12 * MiB, OFF_WOUT = 20 * MiB;
constexpr size_t OFF_XN1 = 22 * MiB, OFF_U = 90 * MiB, OFF_RWP = 362 * MiB, OFF_G = 600 * MiB, OFF_MIX = 632 * MiB, OFF_ZOX = 696 * MiB, WS_END = 702 * MiB;
constexpr int ZOX_ROWS = 6144;
constexpr size_t OFF_W13 = 22 * MiB, OFF_W2 = 110 * MiB, OFF_XN2 = 154 * MiB, OFF_XS = 186 * MiB, OFF_HID = 250 * MiB, OFF_YS = 426 * MiB, OFF_H = 554 * MiB;
static_assert(OFF_H + (size_t)NLAT * D_ * 2 <= OFF_MIX && OFF_YS + (size_t)65536 * D_ * 2 <= OFF_H, "h");
static_assert(OFF_HID + (size_t)EG * 4096 * DE <= OFF_YS && OFF_YS + (size_t)65536 * D_ * 2 <= OFF_MIX && OFF_W13 + (size_t)E_ * 5632 * D_ <= OFF_W2 && OFF_W2 + (size_t)E_ * D_ * DE <= OFF_XN2 && OFF_XN2 + (size_t)NLAT * D_ <= OFF_XS && OFF_XS + (size_t)65536 * D_ <= OFF_HID && OFF_RWP + (size_t)NROW * 3584 * 2 <= OFF_G, "ws map");

struct Params { const float* in[30]; float* out; unsigned char* ws; int ph_lo, ph_hi; };

__device__ __forceinline__ float bf2f(bf16 v) { return __uint_as_float(((unsigned)v) << 16); }
typedef __bf16 bf16x2_t __attribute__((ext_vector_type(2)));
typedef float f32x2_t __attribute__((ext_vector_type(2)));
__device__ __forceinline__ unsigned pk2(float lo, float hi) { const bf16x2_t h2 = __builtin_convertvector((f32x2_t){lo, hi}, bf16x2_t); return __builtin_bit_cast(unsigned, h2); }
__device__ __forceinline__ unsigned f2bf(float f) { return pk2(f, 0.f) & 0xffffu; }
__device__ __forceinline__ float sigmoidf_(float x) { return 1.f / (1.f + __expf(-x)); }
__device__ __forceinline__ float siluf_(float x) { return x / (1.f + __expf(-x)); }
__device__ __forceinline__ float softplusf_(float x) { return fmaxf(x, 0.f) + log1pf(__expf(-fabsf(x))); }
__device__ __forceinline__ float wave_sum(float v) {
#pragma unroll
    for (int o = 1; o < 64; o <<= 1) v += __shfl_xor(v, o);
    return v;
}

__device__ __forceinline__ unsigned pk4_f8(float a, float b, float c, float d) {
    a = __builtin_amdgcn_fmed3f(a, -448.f, 448.f); b = __builtin_amdgcn_fmed3f(b, -448.f, 448.f); c = __builtin_amdgcn_fmed3f(c, -448.f, 448.f); d = __builtin_amdgcn_fmed3f(d, -448.f, 448.f);
    int r = __builtin_amdgcn_cvt_pk_fp8_f32(a, b, 0, false); r = __builtin_amdgcn_cvt_pk_fp8_f32(c, d, r, true); return (unsigned)r; }
__device__ __forceinline__ void transpose_item(const float* W, int N, int Nvalid, bf16* WT, int ldt, long row_off, LAS float* scr, int kb, int nb, int lane) {
    const int k0 = 64 * kb, n0 = 32 * nb;
    const bool ok = (n0 + (lane & 7) * 4) < Nvalid;
    const float* src = W + (size_t)(k0 + (lane >> 3)) * N + n0 + (lane & 7) * 4;
    f32x4 v[8];
#pragma unroll
    for (int i = 0; i < 8; ++i) v[i] = ok ? *(const f32x4*)(src + (size_t)(8 * i) * N) : (f32x4){0.f, 0.f, 0.f, 0.f};
#pragma unroll
    for (int i = 0; i < 8; ++i) { LAS float* d = scr + (8 * i + (lane >> 3)) * 33 + (lane & 7) * 4; d[0] = v[i].x; d[1] = v[i].y; d[2] = v[i].z; d[3] = v[i].w; }
    asm volatile("s_waitcnt lgkmcnt(0)" ::: "memory");
    const int c = lane & 7;
#pragma unroll
    for (int j = 0; j < 4; ++j) { const int n = (lane >> 3) + 8 * j; const LAS float* s = scr + (8 * c) * 33 + n;
        u32x4 o; o.x = pk2(s[0 * 33], s[1 * 33]); o.y = pk2(s[2 * 33], s[3 * 33]); o.z = pk2(s[4 * 33], s[5 * 33]); o.w = pk2(s[6 * 33], s[7 * 33]);
        *(u32x4*)(WT + (size_t)(row_off + n0 + n) * ldt + k0 + 8 * c) = o; }
    asm volatile("s_waitcnt lgkmcnt(0)" ::: "memory");
}
struct XRaw { f32x4 v[8]; };
__device__ __forceinline__ void transpose_load_f8(const float* W, int N, int kb, int nb, int lane, XRaw& R) {
    const float* src = W + (size_t)(64 * kb + (lane >> 3)) * N + 32 * nb + (lane & 7) * 4;
#pragma unroll
    for (int i = 0; i < 8; ++i) R.v[i] = __builtin_nontemporal_load((const f32x4*)(src + (size_t)(8 * i) * N));
}
__device__ __forceinline__ void transpose_finish_f8(const XRaw& R, unsigned char* WT8, int ldt, long row_off, LAS float* scr, int kb, int nb, int lane, float scl) {
    const int k0 = 64 * kb, n0 = 32 * nb;
#pragma unroll
    for (int i = 0; i < 8; ++i) { LAS float* d = scr + (8 * i + (lane >> 3)) * 33 + (lane & 7) * 4; d[0] = R.v[i].x; d[1] = R.v[i].y; d[2] = R.v[i].z; d[3] = R.v[i].w; }
    asm volatile("s_waitcnt lgkmcnt(0)" ::: "memory");
    const int c = lane & 7;
#pragma unroll
    for (int j = 0; j < 4; ++j) { const int n = (lane >> 3) + 8 * j; const LAS float* s = scr + (8 * c) * 33 + n;
        u32x2 o; o.x = pk4_f8(s[0 * 33] * scl, s[1 * 33] * scl, s[2 * 33] * scl, s[3 * 33] * scl); o.y = pk4_f8(s[4 * 33] * scl, s[5 * 33] * scl, s[6 * 33] * scl, s[7 * 33] * scl);
        *(u32x2*)(WT8 + (size_t)(row_off + n0 + n) * ldt + k0 + 8 * c) = o; }
    asm volatile("s_waitcnt lgkmcnt(0)" ::: "memory");
}
__device__ __forceinline__ void phase_prep(const Params& p, LAS unsigned char* lds) {
    const int tid = threadIdx.x, lane = tid & 63, wave = tid >> 6, G = gridDim.x;
    unsigned char* ws = p.ws;
    {
        LAS float* sc = (LAS float*)lds;
        LAS float* red = sc + 9 * D_;
        const float* c = p.in[1]; const float* c_ctx = p.in[3]; const float* mod_w = p.in[4]; const float* mod_b = p.in[5];
        float* mod = (float*)(ws + OFF_MOD);
        bool staged = false;
        for (int item = blockIdx.x; item < MOD6 / 32; item += G) {
            if (!staged) {
                float cv[18];
#pragma unroll
                for (int j = 0; j < 18; ++j) { const int i = tid + j * NT, r = i >> 10, k = i & 1023; cv[j] = r < 8 ? c[r * D_ + k] : c_ctx[k]; }
#pragma unroll
                for (int j = 0; j < 18; ++j) sc[tid + j * NT] = siluf_(cv[j]);
                staged = true; }
            __syncthreads();
            const int kg = tid >> 5, cl = tid & 31, col = item * 32 + cl;
            float acc[9];
#pragma unroll
            for (int r = 0; r < 9; ++r) acc[r] = 0.f;
            float wv[64];
#pragma unroll
            for (int i = 0; i < 64; ++i) wv[i] = mod_w[(size_t)(kg * 64 + i) * MOD6 + col];
#pragma unroll
            for (int i = 0; i < 64; i += 4) {
#pragma unroll
                for (int r = 0; r < 9; ++r) { const f32x4 s4 = *(const LAS f32x4*)(sc + r * D_ + kg * 64 + i);
                    acc[r] += (s4.x * wv[i] + s4.y * wv[i + 1]) + (s4.z * wv[i + 2] + s4.w * wv[i + 3]); } }
#pragma unroll
            for (int r = 0; r < 9; ++r) red[(kg * 9 + r) * 32 + cl] = acc[r];
            __syncthreads();
            if (tid < 32) {
#pragma unroll
                for (int r = 0; r < 9; ++r) { float s = 0.f; for (int g = 0; g < 16; ++g) s += red[(g * 9 + r) * 32 + tid]; mod[r * MOD6 + item * 32 + tid] = s + mod_b[item * 32 + tid]; }
            }
        }
        __syncthreads();
    }
    LAS float* scr = (LAS float*)(lds + wave * 16384);
    const int gw = blockIdx.x * NW + wave, NGW = G * NW;
    constexpr int I_IN = 16 * 128, I_OUT = 16 * 32;
    const bool split = G == 256;
    for (int it = split ? (blockIdx.x >= 192 ? (blockIdx.x - 192) * NW + wave : I_IN + I_OUT) : gw; it < I_IN + I_OUT; it += split ? 64 * NW : NGW) {
        if (it < I_IN) transpose_item(p.in[7], PIN, PIN, (bf16*)(ws + OFF_WIN), D_, 0, scr, it / 128, it % 128, lane);
        else { const int r = it - I_IN; transpose_item(p.in[23], D_, D_, (bf16*)(ws + OFF_WOUT), D_, 0, scr, r / 32, r % 32, lane); }
    }
    {
        bf16* LT = (bf16*)(ws + OFF_LORA);
        const float* w_up = p.in[14]; const float* a_up = p.in[16]; const float* g_up = p.in[17];
        for (int i = blockIdx.x * NT + tid; i < 212992; i += G * NT) {
            float v;
            if (i < 131072) { const int j = i & 65535, d = j >> 15, c = (j >> 6) & 511, r = j & 63; v = (i < 65536 ? w_up : a_up)[(d * 64 + r) * 512 + c]; }
            else { const int j = i - 131072, c = j / 160, r = j % 160; v = g_up[r * 512 + c]; }
            LT[i] = (bf16)f2bf(v);
        }
    }
}
constexpr int EXP_ITEMS = E_ * (2 * 16 * 88 + 44 * 32);
struct XItem { int e, which, kb, nb; };
__device__ __forceinline__ XItem xitem(int it) {
    constexpr int P13 = 8 * 88, P2 = 22 * 32;
    const int P = (it >> 4) * 8 + (it & 7), kh = (it >> 3) & 1;
    XItem x; x.e = P / (2 * P13 + P2); int r = P % (2 * P13 + P2);
    if (r < 2 * P13) { x.which = r / P13; r %= P13; x.kb = (r / 88) * 2 + kh; x.nb = r % 88; }
    else { r -= 2 * P13; x.which = 2; x.kb = (r / 32) * 2 + kh; x.nb = r % 32; }
    return x;
}
__device__ __forceinline__ void expert_load(const Params& p, int it, int lane, XRaw& R) {
    const XItem x = xitem(it);
    if (x.which < 2) transpose_load_f8((x.which ? p.in[27] : p.in[26]) + (size_t)x.e * D_ * DE, DE, x.kb, x.nb, lane, R);
    else transpose_load_f8(p.in[28] + (size_t)x.e * DE * D_, D_, x.kb, x.nb, lane, R);
}
__device__ __forceinline__ void expert_finish(const Params& p, LAS float* scr, int it, int lane, const XRaw& R) {
    unsigned char* ws = p.ws;
    const XItem x = xitem(it);
    if (x.which < 2) {
        const int n0 = x.nb * 32;
        const long row_off = (long)x.e * 5632 + (n0 / 128) * 256 + (n0 % 128) + x.which * 128 - n0;
        transpose_finish_f8(R, ws + OFF_W13, D_, row_off, scr, x.kb, x.nb, lane, 32.f);
    } else {
        transpose_finish_f8(R, ws + OFF_W2, DE, (long)x.e * D_, scr, x.kb, x.nb, lane, 64.f);
    }
}
__device__ __forceinline__ void expert_item(const Params& p, LAS float* scr, int it, int lane) { XRaw R; expert_load(p, it, lane, R); expert_finish(p, scr, it, lane, R); }
__device__ __forceinline__ void phase_expert_prep(const Params& p, LAS unsigned char* lds) {
    const int tid = threadIdx.x, lane = tid & 63, wave = tid >> 6, G = gridDim.x;
    LAS float* scr = (LAS float*)(lds + wave * 16384);
    const int gw = blockIdx.x * NW + wave, NGW = G * NW;
    for (int it = gw; it < EXP_ITEMS; it += NGW) expert_item(p, scr, it, lane);
}

__device__ __forceinline__ void phase_norm1(const Params& p) {
    const int lane = threadIdx.x & 63, wave = threadIdx.x >> 6;
    const int gw = blockIdx.x * NW + wave, NGW = gridDim.x * NW;
    const float* g = p.in[6]; const float* mod = (const float*)(p.ws + OFF_MOD);
    bf16* xn = (bf16*)(p.ws + OFF_XN1);
    for (int row = gw; row < NROW; row += NGW) {
        const float* src; int mr;
        if (row < NCTX) { src = p.in[2] + (size_t)row * D_; mr = 8; } else { const int rl = row - NCTX; src = p.in[0] + (size_t)rl * D_; mr = rl / T_; }
        f32x4 v[4]; float s = 0.f;
#pragma unroll
        for (int j = 0; j < 4; ++j) { v[j] = *(const f32x4*)(src + j * 256 + lane * 4); s += (v[j].x * v[j].x + v[j].y * v[j].y) + (v[j].z * v[j].z + v[j].w * v[j].w); }
        const float rstd = rsqrtf(wave_sum(s) * (1.f / D_) + 1e-6f);
        const float* sh = mod + mr * MOD6, *scl = sh + D_;
#pragma unroll
        for (int j = 0; j < 4; ++j) {
            const int d = j * 256 + lane * 4;
            const f32x4 gg = *(const f32x4*)(g + d), ss = *(const f32x4*)(scl + d), hh = *(const f32x4*)(sh + d);
            const f32x4 o = v[j] * rstd * gg * (ss + 1.f) + hh;
            u32x2 w; w.x = pk2(o.x, o.y); w.y = pk2(o.z, o.w);
            *(u32x2*)(xn + (size_t)row * D_ + d) = w;
        }
    }
}

struct EpiU {
    static constexpr bool PERM = true, AFTER_DRAIN = false;
    bf16* C; int ldc;
    __device__ __forceinline__ void operator()(const pg8::f32x4 (&acc)[2][2][4][2], const pg8::Unit& u, int wr, int wc, int fr, int fq) const {
        const int row0 = u.pm * 256 + wr * 64 + fr, col0 = u.pn * 256 + wc * 32 + 8 * fq;
#pragma unroll
        for (int ai = 0; ai < 2; ++ai)
#pragma unroll
            for (int m = 0; m < 4; ++m) { bf16* rowp = C + (size_t)(row0 + ai * 128 + m * 16) * ldc + col0;
#pragma unroll
                for (int bj = 0; bj < 2; ++bj) { const pg8::f32x4 v0 = acc[ai][bj][m][0], v1 = acc[ai][bj][m][1];
                    u32x4 w; w.x = pk2(v0[0], v0[1]); w.y = pk2(v0[2], v0[3]); w.z = pk2(v1[0], v1[1]); w.w = pk2(v1[2], v1[3]);
                    __builtin_nontemporal_store(w, (u32x4*)(rowp + bj * 128)); } }
    }
};
struct EpiH {
    static constexpr bool PERM = true, AFTER_DRAIN = false;
    const float* x; const float* mod; bf16* h;
    __device__ __forceinline__ void operator()(const pg8::f32x4 (&acc)[2][2][4][2], const pg8::Unit& u, int wr, int wc, int fr, int fq) const {
        const int row0 = u.pm * 256 + wr * 64 + fr, col0 = u.pn * 256 + wc * 32 + 8 * fq;
        const float* g1 = mod + ((u.pm * 256) / T_) * MOD6 + 2 * D_;
#pragma unroll
        for (int ai = 0; ai < 2; ++ai)
#pragma unroll
            for (int m = 0; m < 4; ++m) { const size_t off = (size_t)(row0 + ai * 128 + m * 16) * D_ + col0;
#pragma unroll
                for (int bj = 0; bj < 2; ++bj) { const int cc = bj * 128;
                    const pg8::f32x4 x0 = *(const pg8::f32x4*)(x + off + cc), x1 = *(const pg8::f32x4*)(x + off + cc + 4), g0 = *(const pg8::f32x4*)(g1 + col0 + cc), g1v = *(const pg8::f32x4*)(g1 + col0 + cc + 4);
                    const pg8::f32x4 v0 = x0 + g0 * acc[ai][bj][m][0], v1 = x1 + g1v * acc[ai][bj][m][1];
                    u32x4 w; w.x = pk2(v0[0], v0[1]); w.y = pk2(v0[2], v0[3]); w.z = pk2(v1[0], v1[1]); w.w = pk2(v1[2], v1[3]);
                    *(u32x4*)(h + off + cc) = w; } }
    }
};
struct EpiHid {
    static constexpr bool PERM = true, AFTER_DRAIN = false;
    unsigned char* hid; int nN;
    __device__ __forceinline__ void operator()(const pg8::f32x4 (&acc)[2][2][4][2], const pg8::Unit& u, int, int, int, int) const {
        int t = threadIdx.x; asm volatile("" : "+v"(t));
        const int wid = t >> 6, wr = wid >> 2, wc = wid & 3, fr = t & 15, fq = (t >> 4) & 3;
        const int row0 = u.pm * 256 + wr * 64 + fr, col0 = (u.pn % nN) * 128 + wc * 32 + 8 * fq;
#pragma unroll
        for (int ai = 0; ai < 2; ++ai)
#pragma unroll
            for (int m = 0; m < 4; ++m) {
                float o[8];
#pragma unroll
                for (int n = 0; n < 2; ++n)
#pragma unroll
                    for (int j = 0; j < 4; ++j) { const float a = acc[ai][0][m][n][j]; o[n * 4 + j] = a * __builtin_amdgcn_rcpf(1.f + __expf(-a)) * acc[ai][1][m][n][j] * 8.f; }
                u32x2 w; w.x = pk4_f8(o[0], o[1], o[2], o[3]); w.y = pk4_f8(o[4], o[5], o[6], o[7]);
                *(u32x2*)(hid + (size_t)(row0 + ai * 128 + m * 16) * DE + col0) = w; }
    }
};
struct EpiYs {
    static constexpr bool PERM = true, AFTER_DRAIN = false;
    bf16* ys; const float* gate; int nN;
    __device__ __forceinline__ void operator()(const pg8::f32x4 (&acc)[2][2][4][2], const pg8::Unit& u, int, int, int, int) const {
        int t = threadIdx.x; asm volatile("" : "+v"(t));
        const int wid = t >> 6, wr = wid >> 2, wc = wid & 3, fr = t & 15, fq = (t >> 4) & 3;
        const int row0 = u.pm * 256 + wr * 64 + fr, col0 = (u.pn % nN) * 256 + wc * 32 + 8 * fq;
#pragma unroll
        for (int ai = 0; ai < 2; ++ai)
#pragma unroll
            for (int m = 0; m < 4; ++m) { const int row = row0 + ai * 128 + m * 16; bf16* rowp = ys + (size_t)row * D_ + col0;
#pragma unroll
                for (int bj = 0; bj < 2; ++bj) { const pg8::f32x4 v0 = acc[ai][bj][m][0], v1 = acc[ai][bj][m][1];
                    u32x4 w; w.x = pk2(v0[0], v0[1]); w.y = pk2(v0[2], v0[3]); w.z = pk2(v1[0], v1[1]); w.w = pk2(v1[2], v1[3]);
                    *(u32x4*)(rowp + bj * 128) = w; } }
    }
};
struct ExpertOrder {
    int nN, G, c;
    __device__ bool next(int i, pg8::Unit& u) const {
        if (G == 256) {
            const int xcd = c & 7, l = c >> 3, uidx = i * 32 + l;
            if (uidx >= (EG / 8) * 16 * nN) return false;
            const int es = uidx / (16 * nN), r2 = uidx % (16 * nN), el = xcd + 8 * es;
            const int rg = r2 / (8 * nN), rem = r2 % (8 * nN);
            u.pm = el * 16 + rg * 8 + (rem & 7); u.pn = el * nN + (rem >> 3); return true;
        }
        const long L = (long)i * G + c; if (L >= (long)EG * 16 * nN) return false;
        const int e = (int)(L / (16 * nN)), rem = (int)(L % (16 * nN));
        u.pm = e * 16 + (rem & 15); u.pn = e * nN + (rem >> 4); return true;
    }
    __device__ __forceinline__ void a_ready(const pg8::Unit&) const {}
    __device__ __forceinline__ void done(const pg8::Unit&) const {}
};

__device__ __forceinline__ float bflo(unsigned w) { return __uint_as_float(w << 16); }
__device__ __forceinline__ float bfhi(unsigned w) { return __uint_as_float(w & 0xffff0000u); }
#define BAR_LDS() do { asm volatile("s_waitcnt lgkmcnt(0)" ::: "memory"); __builtin_amdgcn_s_barrier(); asm volatile("" ::: "memory"); } while (0)
__device__ __forceinline__ float rcpf_(float x) { return __builtin_amdgcn_rcpf(x); }
__device__ __forceinline__ float silu_fast(float x) { return x * rcpf_(1.f + __expf(-x)); }
__device__ __forceinline__ float sigmoid_fast(float x) { return rcpf_(1.f + __expf(-x)); }
__device__ __forceinline__ void phase_qk(const Params& p) {
    const int lane = threadIdx.x & 63, wave = threadIdx.x >> 6;
    const int gw = blockIdx.x * NW + wave, NGW = gridDim.x * NW;
    const bf16* u = (const bf16*)(p.ws + OFF_U);
    bf16* QK = (bf16*)(p.ws + OFF_XN1);
    const float* cw = p.in[8]; const float* cb = p.in[9];
    const int c0 = lane * 16;
    float w0[16], w1[16], w2[16], bb[16];
#pragma unroll
    for (int e = 0; e < 16; ++e) { w0[e] = cw[c0 + e]; w1[e] = cw[1024 + c0 + e]; w2[e] = cw[2048 + c0 + e]; bb[e] = cb[c0 + e]; }
    const float scl = c0 >= 512 ? 0.08838834764831845f : 1.f;
    const bool wsplit = gridDim.x == 256;
    const int rstep = wsplit ? 5 * 1024 : NGW, rcnt = wsplit ? (blockIdx.x < 128 ? 2 : 3) : 1;
    const int rbase = wsplit ? (blockIdx.x < 128 ? gw * 2 : 2048 + (gw - 1024) * 3) : gw;
    for (int row0 = rbase; row0 < NROW; row0 += rstep)
    for (int rj = 0; rj < rcnt; ++rj) {
        const int row = row0 + rj; if (row >= NROW) break;
        int t, Tlen;
        if (row < NCTX) { t = row % TC_; Tlen = TC_; } else { t = (row - NCTX) % T_; Tlen = T_; }
        if (row >= NCTX && row < NCTX + ZOX_ROWS) *(u32x4*)((bf16*)(p.ws + OFF_ZOX) + (size_t)(row - NCTX) * 512 + lane * 8) = *(const u32x4*)(u + (size_t)row * UC + 1536 + lane * 8);
        const bf16* src = u + (size_t)row * UC + c0;
        u32x4 zc[2], zp[2], zn[2];
#pragma unroll
        for (int i = 0; i < 2; ++i) {
            zc[i] = *(const u32x4*)(src + i * 8);
            zp[i] = t > 0 ? *(const u32x4*)(src - UC + i * 8) : (u32x4){0u, 0u, 0u, 0u};
            zn[i] = t < Tlen - 1 ? *(const u32x4*)(src + UC + i * 8) : (u32x4){0u, 0u, 0u, 0u};
        }
#pragma unroll
        for (int i = 0; i < 2; ++i) {
            float o[8];
#pragma unroll
            for (int e = 0; e < 4; ++e) {
                const int c = i * 8 + e * 2;
                o[e * 2] = silu_fast(bflo(zp[i][e]) * w0[c] + bflo(zc[i][e]) * w1[c] + bflo(zn[i][e]) * w2[c] + bb[c]) * scl;
                o[e * 2 + 1] = silu_fast(bfhi(zp[i][e]) * w0[c + 1] + bfhi(zc[i][e]) * w1[c + 1] + bfhi(zn[i][e]) * w2[c + 1] + bb[c + 1]) * scl;
            }
            u32x4 w; w.x = pk2(o[0], o[1]); w.y = pk2(o[2], o[3]); w.z = pk2(o[4], o[5]); w.w = pk2(o[6], o[7]);
            *(u32x4*)(QK + (size_t)row * 1024 + c0 + i * 8) = w;
        }
    }
}

typedef short bf16x8 __attribute__((ext_vector_type(8)));
typedef float f32x16 __attribute__((ext_vector_type(16)));
#define MFMA32(a, b, c) __builtin_amdgcn_mfma_f32_32x32x16_bf16((a), (b), (c), 0, 0, 0)
namespace ml {
constexpr int QS = 0, KS = 17408, KTS = 34816, VTS = 53248, VTW = 62464, WS = 71680, CS = 80896, FB = 98304;
constexpr int F_GQ = 0, F_MJ = 64, F_WI = 128, F_WK = 192, F_BC = 256, F_NV = 320, F_NQ = 448, F_DP = 512, F_SC = 704;
constexpr int LDQ = 136, LDK = 72;
}
struct MlRaw { u32x4 q[4]; u32x4 v; bf16 gi, gf; };
__device__ __forceinline__ void ml_load(const bf16* QK, const bf16* u, size_t rowbase, int Tlen, int c, int dir, int h, int vh, int tid, int gi, int gf, MlRaw& R) {
    const int j = tid >> 3, cg = tid & 7;
    const int pp = c * 64 + j, t = dir ? Tlen - 1 - pp : pp;
    const bf16* src = QK + (rowbase + t) * 1024 + (cg < 4 ? h * 128 + cg * 32 : 512 + h * 128 + (cg - 4) * 32);
#pragma unroll
    for (int i = 0; i < 4; ++i) R.q[i] = *(const u32x4*)(src + i * 8);
    R.v = *(const u32x4*)(u + (rowbase + t) * UC + 1024 + h * 128 + vh * 64 + cg * 8);
    R.gi = 0; R.gf = 0;
    if (tid < 64) {
        const int p2 = c * 64 + tid, t2 = dir ? Tlen - 1 - p2 : p2;
        R.gi = u[(rowbase + t2) * UC + 2048 + gi]; R.gf = u[(rowbase + t2) * UC + 2048 + gf];
    }
}
__device__ __forceinline__ void mlstm_item(const Params& p, LAS unsigned char* lds0, int item) {
    using namespace ml;
    LAS unsigned char* lds = lds0;
    LAS float* F = (LAS float*)(lds + FB);
    const bf16* u = (const bf16*)(p.ws + OFF_U); const bf16* QK = (const bf16*)(p.ws + OFF_XN1);
    const float* gate_b = p.in[10];
    const int tid = threadIdx.x, lane = tid & 63, wave = __builtin_amdgcn_readfirstlane(tid >> 6), l31 = lane & 31, hf = lane >> 5;
    const int dir = item & 1, vh = (item >> 1) & 1, h = (item >> 2) & 3, b = item >> 4;
    const int gi = (dir ? 2 : 0) * 4 + h, gf = (dir ? 3 : 1) * 4 + h;
    const float gbi = gate_b[gi], gbf = gate_b[gf];
    bf16* Hout = (bf16*)(p.ws + OFF_MIX) + dir * 512;
    __syncthreads();
    for (int i = tid; i < 64 * LDQ / 2; i += NT) ((LAS unsigned*)(lds + CS))[i] = 0u;
    if (tid < 128) F[F_NV + tid] = 0.f;
    if (tid == 0) F[F_SC + 0] = 0.f;
    f32x16 accC[2];
#pragma unroll
    for (int r = 0; r < 16; ++r) { accC[0][r] = 0.f; accC[1][r] = 0.f; }
    MlRaw R;
    ml_load(QK, u, (size_t)b * TC_, TC_, 0, dir, h, vh, tid, gi, gf, R);
    __syncthreads();
    for (int ci = 0; ci < 68; ++ci) {
        lds = lds0; asm volatile("" : "+v"(lds));
        F = (LAS float*)(lds + FB);
        const int seq = ci >= 4, c = seq ? ci - 4 : ci, Tlen = seq ? T_ : TC_;
        if (wave == 0) {
            const float m = F[F_SC + 0];
            const float li = bf2f(R.gi) + gbi, lfv = -softplusf_(-(bf2f(R.gf) + gbf));
#define DPPF(x, ctrl, rmask, oldv) __int_as_float(__builtin_amdgcn_update_dpp(__float_as_int(oldv), __float_as_int(x), ctrl, rmask, 0xF, false))
            float bsum = lfv;
            bsum += DPPF(bsum, 0x111, 0xF, 0.f); bsum += DPPF(bsum, 0x112, 0xF, 0.f); bsum += DPPF(bsum, 0x114, 0xF, 0.f); bsum += DPPF(bsum, 0x118, 0xF, 0.f);
            bsum += DPPF(bsum, 0x142, 0xA, 0.f); bsum += DPPF(bsum, 0x143, 0xC, 0.f);
            const float g = li - bsum;
            float pm = g;
            const float ninf = -INFINITY;
            pm = fmaxf(pm, DPPF(pm, 0x111, 0xF, ninf)); pm = fmaxf(pm, DPPF(pm, 0x112, 0xF, ninf)); pm = fmaxf(pm, DPPF(pm, 0x114, 0xF, ninf)); pm = fmaxf(pm, DPPF(pm, 0x118, 0xF, ninf));
            pm = fmaxf(pm, DPPF(pm, 0x142, 0xA, ninf)); pm = fmaxf(pm, DPPF(pm, 0x143, 0xC, ninf));
#undef DPPF
            const float Mj = fmaxf(m, pm);
            const float M63 = __shfl(Mj, 63), bL = __shfl(bsum, 63);
            F[F_GQ + lane] = g; F[F_MJ + lane] = Mj; F[F_WI + lane] = __expf(m - Mj); F[F_WK + lane] = __expf(g - M63); F[F_BC + lane] = bsum;
            if (lane == 0) { F[F_SC + 1] = __expf(m - M63); F[F_SC + 2] = bL + M63; }
        }
        {
            const int j = tid >> 3, cg = tid & 7, k0 = (cg & 3) * 32;
#pragma unroll
            for (int i = 0; i < 4; ++i) *(LAS u32x4*)(lds + (cg < 4 ? QS : KS) + (j * LDQ + k0 + i * 8) * 2) = R.q[i];
            if (cg >= 4) {
                const int jc = j ^ ((cg & 3) << 4);
#pragma unroll
                for (int i = 0; i < 4; ++i)
#pragma unroll
                    for (int e = 0; e < 4; ++e) { const unsigned w = R.q[i][e];
                        *(LAS bf16*)(lds + KTS + ((k0 + i * 8 + e * 2) * LDK + jc) * 2) = (bf16)(w & 0xffffu);
                        *(LAS bf16*)(lds + KTS + ((k0 + i * 8 + e * 2 + 1) * LDK + jc) * 2) = (bf16)(w >> 16); }
            }
            const int jv = j ^ (cg << 3);
#pragma unroll
            for (int e = 0; e < 4; ++e) { const unsigned w = R.v[e];
                *(LAS bf16*)(lds + VTS + ((cg * 8 + e * 2) * LDK + jv) * 2) = (bf16)(w & 0xffffu);
                *(LAS bf16*)(lds + VTS + ((cg * 8 + e * 2 + 1) * LDK + jv) * 2) = (bf16)(w >> 16); }
        }
        BAR_LDS();
        {
            const int j = tid >> 3, cg = tid & 7, jv = j ^ (cg << 3); const float wk = F[F_WK + j];
#pragma unroll
            for (int e = 0; e < 4; ++e) { const unsigned w = R.v[e];
                *(LAS bf16*)(lds + VTW + ((cg * 8 + e * 2) * LDK + jv) * 2) = (bf16)f2bf(bflo(w) * wk);
                *(LAS bf16*)(lds + VTW + ((cg * 8 + e * 2 + 1) * LDK + jv) * 2) = (bf16)f2bf(bfhi(w) * wk); }
        }
        if (ci + 1 < 68) { const int s2 = (ci + 1) >= 4, c2 = s2 ? ci + 1 - 4 : ci + 1;
            ml_load(QK, u, s2 ? (size_t)NCTX + (size_t)b * T_ : (size_t)b * TC_, s2 ? T_ : TC_, c2, dir, h, vh, tid, gi, gf, R); }
        f32x16 accH;
#pragma unroll
        for (int r = 0; r < 16; ++r) accH[r] = 0.f;
        const int vt = (wave - 4) >> 1, jt4 = (wave - 4) & 1;
        const int vsw = ((l31 >> 3) & 3) << 3;
        if (wave < 3) {
            const int st = wave == 2 ? 1 : 0, jt = wave == 0 ? 0 : 1;
            f32x16 acc;
#pragma unroll
            for (int r = 0; r < 16; ++r) acc[r] = 0.f;
#pragma unroll
            for (int kk = 0; kk < 8; ++kk) {
                const bf16x8 a = *(const LAS bf16x8*)(lds + KS + ((st * 32 + l31) * LDQ + kk * 16 + hf * 8) * 2);
                const bf16x8 bq = *(const LAS bf16x8*)(lds + QS + ((jt * 32 + l31) * LDQ + kk * 16 + hf * 8) * 2);
                acc = MFMA32(a, bq, acc);
            }
            const int j = jt * 32 + l31; const float Mj = F[F_MJ + j];
            float sum = 0.f;
#pragma unroll
            for (int g4 = 0; g4 < 4; ++g4) {
                const f32x4 gq4 = *(const LAS f32x4*)(F + F_GQ + st * 32 + 8 * g4 + 4 * hf);
                float w4[4];
#pragma unroll
                for (int e = 0; e < 4; ++e) { const int s = st * 32 + 8 * g4 + 4 * hf + e; const float arg = (s <= j) ? gq4[e] - Mj : -INFINITY; const float wv = __expf(arg) * acc[g4 * 4 + e]; w4[e] = wv; sum += wv; }
                u32x2 w; w.x = pk2(w4[0], w4[1]); w.y = pk2(w4[2], w4[3]);
                *(LAS u32x2*)(lds + WS + (j * LDK + st * 32 + 8 * g4 + 4 * hf) * 2) = w;
            }
            sum += __shfl_xor(sum, 32);
            if (hf == 0) F[F_DP + wave * 64 + j] = sum;
        } else if (wave == 3) {
            float s2 = 0.f;
#pragma unroll
            for (int k8 = 0; k8 < 16; ++k8) { const u32x4 w = *(const LAS u32x4*)(lds + QS + (lane * LDQ + k8 * 8) * 2);
                const f32x4 n0 = *(const LAS f32x4*)(F + F_NV + k8 * 8), n1 = *(const LAS f32x4*)(F + F_NV + k8 * 8 + 4);
                s2 += bflo(w[0]) * n0.x + bfhi(w[0]) * n0.y + bflo(w[1]) * n0.z + bfhi(w[1]) * n0.w + bflo(w[2]) * n1.x + bfhi(w[2]) * n1.y + bflo(w[3]) * n1.z + bfhi(w[3]) * n1.w; }
            F[F_NQ + lane] = s2;
        } else {
#pragma unroll
            for (int kk = 0; kk < 8; ++kk) {
                const bf16x8 a = *(const LAS bf16x8*)(lds + CS + ((vt * 32 + l31) * LDQ + kk * 16 + hf * 8) * 2);
                const bf16x8 bq = *(const LAS bf16x8*)(lds + QS + ((jt4 * 32 + l31) * LDQ + kk * 16 + hf * 8) * 2);
                accH = MFMA32(a, bq, accH);
            }
        }
        BAR_LDS();
        if (wave >= 4) {
            f32x16 acc2;
#pragma unroll
            for (int r = 0; r < 16; ++r) acc2[r] = 0.f;
            const int nk = jt4 ? 4 : 2;
            const int vsw4 = (((vt * 32 + l31) >> 3) & 7) << 3;
            for (int kk = 0; kk < nk; ++kk) {
                const bf16x8 a = *(const LAS bf16x8*)(lds + VTS + ((vt * 32 + l31) * LDK + ((kk * 16 + hf * 8) ^ vsw4)) * 2);
                const bf16x8 bw = *(const LAS bf16x8*)(lds + WS + ((jt4 * 32 + l31) * LDK + kk * 16 + hf * 8) * 2);
                acc2 = MFMA32(a, bw, acc2);
            }
            if (seq) {
                const int j = jt4 * 32 + l31;
                const float wi = F[F_WI + j];
                const float dsum = j < 32 ? F[F_DP + j] : F[F_DP + 64 + j] + F[F_DP + 128 + j];
                const float den = dsum + wi * F[F_NQ + j];
                const float inv = rcpf_(fmaxf(fabsf(den), __expf(-(F[F_BC + j] + F[F_MJ + j]))));
                const int pp = c * 64 + j, t = dir ? Tlen - 1 - pp : pp;
                bf16* dst = Hout + ((size_t)b * T_ + t) * 1024 + h * 128 + vh * 64 + vt * 32 + 4 * hf;
#pragma unroll
                for (int g4 = 0; g4 < 4; ++g4) { u32x2 w;
                    w.x = pk2((acc2[g4 * 4] + wi * accH[g4 * 4]) * inv, (acc2[g4 * 4 + 1] + wi * accH[g4 * 4 + 1]) * inv);
                    w.y = pk2((acc2[g4 * 4 + 2] + wi * accH[g4 * 4 + 2]) * inv, (acc2[g4 * 4 + 3] + wi * accH[g4 * 4 + 3]) * inv);
                    *(u32x2*)(dst + 8 * g4) = w; }
            }
        } else {
            const float s_old = F[F_SC + 1];
            const int kt = wave;
#pragma unroll
            for (int r = 0; r < 16; ++r) { accC[0][r] *= s_old; accC[1][r] *= s_old; }
#pragma unroll
            for (int kk = 0; kk < 4; ++kk) {
                const bf16x8 a = *(const LAS bf16x8*)(lds + KTS + ((kt * 32 + l31) * LDK + ((kk * 16 + hf * 8) ^ (kt << 4))) * 2);
                const bf16x8 b0 = *(const LAS bf16x8*)(lds + VTW + ((l31) * LDK + ((kk * 16 + hf * 8) ^ vsw)) * 2);
                const bf16x8 b1 = *(const LAS bf16x8*)(lds + VTW + ((32 + l31) * LDK + ((kk * 16 + hf * 8) ^ (vsw + 32))) * 2);
                accC[0] = MFMA32(a, b0, accC[0]); accC[1] = MFMA32(a, b1, accC[1]);
            }
#pragma unroll
            for (int v2 = 0; v2 < 2; ++v2)
#pragma unroll
                for (int g4 = 0; g4 < 4; ++g4) { u32x2 w; w.x = pk2(accC[v2][g4 * 4], accC[v2][g4 * 4 + 1]); w.y = pk2(accC[v2][g4 * 4 + 2], accC[v2][g4 * 4 + 3]);
                    *(LAS u32x2*)(lds + CS + ((v2 * 32 + l31) * LDQ + kt * 32 + 8 * g4 + 4 * hf) * 2) = w; }
            if (tid < 128) {
                float nn = s_old * F[F_NV + tid];
                const int ksw = ((tid >> 5) & 3) << 4;
#pragma unroll
                for (int s8 = 0; s8 < 8; ++s8) { const u32x4 w = *(const LAS u32x4*)(lds + KTS + (tid * LDK + ((s8 * 8) ^ ksw)) * 2);
                    const f32x4 k0 = *(const LAS f32x4*)(F + F_WK + s8 * 8), k1 = *(const LAS f32x4*)(F + F_WK + s8 * 8 + 4);
                    nn += bflo(w[0]) * k0.x + bfhi(w[0]) * k0.y + bflo(w[1]) * k0.z + bfhi(w[1]) * k0.w + bflo(w[2]) * k1.x + bfhi(w[2]) * k1.y + bflo(w[3]) * k1.z + bfhi(w[3]) * k1.w; }
                F[F_NV + tid] = nn;
            }
            if (tid == 0) F[F_SC + 0] = F[F_SC + 2];
        }
        BAR_LDS();
    }
}

constexpr int RWP_LD = 3584;
__device__ __forceinline__ size_t rw_row(int seq, int b, int p) { return seq ? (size_t)NCTX + (size_t)b * T_ + (size_t)((p & 63) * 64 + (p >> 6)) : (size_t)b * TC_ + p; }
typedef short bf16x8 __attribute__((ext_vector_type(8)));
#define MFMA16(a, b, c) __builtin_amdgcn_mfma_f32_16x16x32_bf16((a), (b), (c), 0, 0, 0)
__device__ __forceinline__ float tanh_fast(float x) { const float xc = fminf(fmaxf(x, -15.f), 15.f); return 1.f - 2.f * rcpf_(__expf(2.f * xc) + 1.f); }
namespace rp {
constexpr int RS = 0, KSH = 16384, XW = 32768, XA = XW + 4608, XG = XA + 4608, OUT = 49152, LDX = 72, LDG = 168;
}
__device__ __forceinline__ void rwkv_prep_tile(const Params& p, LAS unsigned char* lds, int tile) {
    using namespace rp;
    const int tid = threadIdx.x, lane = tid & 63, wave = __builtin_amdgcn_readfirstlane(tid >> 6);
    const bf16* u = (const bf16*)(p.ws + OFF_U);
    bf16* RWP = (bf16*)(p.ws + OFF_RWP);
    const float* mu = p.in[12];
    int seq, b, p0;
    if (tile < 128) { seq = 0; b = tile >> 4; p0 = (tile & 15) * 16; } else { const int t2 = tile - 128; seq = 1; b = t2 >> 8; p0 = (t2 & 255) * 16; }
    const int Tlen = seq ? T_ : TC_;
    const size_t srow0 = (seq ? (size_t)NCTX + (size_t)b * T_ : (size_t)b * TC_) + p0;
    {
        const int cgp = tid & 255, half = tid >> 8;
        if (cgp < 244) {
            const int col = cgp * 8;
            u32x4 rows[10];
#pragma unroll
            for (int i = 0; i < 10; ++i) { const int pos = p0 + half * 8 - 1 + i; const bool ok = pos >= 0 && pos < Tlen;
                rows[i] = ok ? *(const u32x4*)(u + rw_row(seq, b, ok ? pos : p0) * UC + MLC + col) : (u32x4){0u, 0u, 0u, 0u}; }
            float mp[8], mn[8];
#pragma unroll
            for (int e = 0; e < 8; ++e) { mp[e] = mu[col + e]; mn[e] = mu[1952 + col + e]; }
            float kkw[8];
#pragma unroll
            for (int e = 0; e < 8; ++e) kkw[e] = (col >= 512 && col < 1024) ? p.in[18][col - 512 + e] : 0.f;
#pragma unroll
            for (int i = 0; i < 8; ++i) {
                const int t = half * 8 + i;
                float s[8];
#pragma unroll
                for (int e = 0; e < 4; ++e) {
                    const float c0 = bflo(rows[i + 1][e]), c1 = bfhi(rows[i + 1][e]);
                    s[2 * e] = c0 + mp[2 * e] * (bflo(rows[i][e]) - c0) + mn[2 * e] * (bflo(rows[i + 2][e]) - c0);
                    s[2 * e + 1] = c1 + mp[2 * e + 1] * (bfhi(rows[i][e]) - c1) + mn[2 * e + 1] * (bfhi(rows[i + 2][e]) - c1);
                }
                if (col < 1536) {
                    u32x4 w; w.x = pk2(s[0], s[1]); w.y = pk2(s[2], s[3]); w.z = pk2(s[4], s[5]); w.w = pk2(s[6], s[7]);
                    *(u32x4*)(RWP + (srow0 + t) * RWP_LD + col) = w;
                    if (col < 1024) *(LAS u32x4*)(lds + (col < 512 ? RS : KSH) + (t * 512 + (col & 511)) * 2) = w;
                    if (col >= 512 && col < 1024) {
                        float ss = 0.f;
#pragma unroll
                        for (int e = 0; e < 8; ++e) { const float kk = s[e] * kkw[e]; ss += kk * kk; }
                        ss += __shfl_xor(ss, 1); ss += __shfl_xor(ss, 2); ss += __shfl_xor(ss, 4);
                        if ((cgp & 7) == 0) ((float*)(p.ws + OFF_INVN))[(srow0 + t) * 8 + ((col - 512) >> 6)] = rcpf_(fmaxf(sqrtf(ss), 1e-12f));
                    }
                } else if (col < 1664) {
                    const int d = (col - 1536) >> 6, rr = (col - 1536) & 63;
                    u32x4 w; w.x = pk2(tanh_fast(s[0]), tanh_fast(s[1])); w.y = pk2(tanh_fast(s[2]), tanh_fast(s[3])); w.z = pk2(tanh_fast(s[4]), tanh_fast(s[5])); w.w = pk2(tanh_fast(s[6]), tanh_fast(s[7]));
                    *(LAS u32x4*)(lds + XW + ((d * 16 + t) * LDX + rr) * 2) = w;
                } else if (col < 1792) {
                    const int d = (col - 1664) >> 6, rr = (col - 1664) & 63;
                    u32x4 w; w.x = pk2(s[0], s[1]); w.y = pk2(s[2], s[3]); w.z = pk2(s[4], s[5]); w.w = pk2(s[6], s[7]);
                    *(LAS u32x4*)(lds + XA + ((d * 16 + t) * LDX + rr) * 2) = w;
                } else {
                    u32x4 w; w.x = pk2(sigmoid_fast(s[0]), sigmoid_fast(s[1])); w.y = pk2(sigmoid_fast(s[2]), sigmoid_fast(s[3])); w.z = pk2(sigmoid_fast(s[4]), sigmoid_fast(s[5])); w.w = pk2(sigmoid_fast(s[6]), sigmoid_fast(s[7]));
                    *(LAS u32x4*)(lds + XG + (t * LDG + (col - 1792)) * 2) = w;
                }
            }
        }
    }
    {
        const int l15 = lane & 15, q = lane >> 4, head = wave;
        const bf16* LT = (const bf16*)(p.ws + OFF_LORA);
        float bp[2][4];
#pragma unroll
        for (int d = 0; d < 2; ++d)
#pragma unroll
            for (int r = 0; r < 4; ++r) bp[d][r] = 0.f;
        bf16x8 bw[2][2], ba[2][2], bg[5]; float ka_n, rk_n, w0_n[2], a0_n[2];
#define RP_LOADB(ci_) do { const int c_ = head * 64 + (ci_) * 16 + l15; \
            _Pragma("unroll") for (int d = 0; d < 2; ++d) { _Pragma("unroll") for (int s = 0; s < 2; ++s) { \
                bw[d][s] = *(const bf16x8*)(LT + ((size_t)(d * 512 + c_) * 64 + s * 32 + q * 8)); ba[d][s] = *(const bf16x8*)(LT + 65536 + ((size_t)(d * 512 + c_) * 64 + s * 32 + q * 8)); } \
                w0_n[d] = p.in[13][d * 512 + c_]; a0_n[d] = p.in[15][d * 512 + c_]; } \
            _Pragma("unroll") for (int s = 0; s < 5; ++s) bg[s] = *(const bf16x8*)(LT + 131072 + ((size_t)c_ * 160 + s * 32 + q * 8)); \
            ka_n = p.in[19][c_]; rk_n = p.in[20][c_]; } while (0)
        RP_LOADB(0);
        __syncthreads();
#pragma unroll 1
        for (int ci = 0; ci < 4; ++ci) {
            const int c = head * 64 + ci * 16 + l15;
            f32x4 accW[2], accA[2], accG = (f32x4){0.f, 0.f, 0.f, 0.f};
#pragma unroll
            for (int d = 0; d < 2; ++d) {
                accW[d] = (f32x4){0.f, 0.f, 0.f, 0.f}; accA[d] = (f32x4){0.f, 0.f, 0.f, 0.f};
#pragma unroll
                for (int s = 0; s < 2; ++s) {
                    accW[d] = MFMA16(*(const LAS bf16x8*)(lds + XW + ((d * 16 + l15) * LDX + s * 32 + q * 8) * 2), bw[d][s], accW[d]);
                    accA[d] = MFMA16(*(const LAS bf16x8*)(lds + XA + ((d * 16 + l15) * LDX + s * 32 + q * 8) * 2), ba[d][s], accA[d]); }
            }
#pragma unroll
            for (int s = 0; s < 5; ++s) accG = MFMA16(*(const LAS bf16x8*)(lds + XG + (l15 * LDG + s * 32 + q * 8) * 2), bg[s], accG);
            const float ka = ka_n, rk = rk_n, w0c[2] = {w0_n[0], w0_n[1]}, a0c[2] = {a0_n[0], a0_n[1]};
            if (ci < 3) RP_LOADB(ci + 1);
            float rkv[4];
#pragma unroll
            for (int r = 0; r < 4; ++r) { const int t = q * 4 + r; rkv[r] = bf2f(*(const LAS bf16*)(lds + RS + (t * 512 + c) * 2)) * bf2f(*(const LAS bf16*)(lds + KSH + (t * 512 + c) * 2)) * rk; }
#pragma unroll
            for (int d = 0; d < 2; ++d) {
#pragma unroll
                for (int r = 0; r < 4; ++r) {
                    const int t = q * 4 + r;
                    const float lw = accW[d][r] + w0c[d];
                    const float ld = -0.6065306597126334f * sigmoid_fast(lw);
                    const float a = sigmoid_fast(accA[d][r] + a0c[d]);
                    *(LAS bf16*)(lds + OUT + ((2 * d) * 8192 + t * 512 + c) * 2) = (bf16)f2bf(ld);
                    *(LAS bf16*)(lds + OUT + ((2 * d + 1) * 8192 + t * 512 + c) * 2) = (bf16)f2bf(a);
                    bp[d][r] += rkv[r] * (1.f + (a - 1.f) * ka);
                }
            }
#pragma unroll
            for (int r = 0; r < 4; ++r) *(LAS bf16*)(lds + OUT + (4 * 8192 + (q * 4 + r) * 512 + c) * 2) = (bf16)f2bf(accG[r]);
        }
#undef RP_LOADB
        if (seq) {
#pragma unroll
            for (int d = 0; d < 2; ++d)
#pragma unroll
                for (int r = 0; r < 4; ++r) {
                    float v = bp[d][r];
                    v += __shfl_xor(v, 1); v += __shfl_xor(v, 2); v += __shfl_xor(v, 4); v += __shfl_xor(v, 8);
                    if (l15 == 0) ((float*)(p.ws + OFF_BON))[((size_t)d * NLAT + (size_t)b * T_ + p0 + q * 4 + r) * 8 + head] = v;
                }
        }
    }
    __syncthreads();
#pragma unroll
    for (int i = 0; i < 8; ++i) {
        const int pc = tid + i * NT, t = pc >> 8, rem = pc & 255, qq = rem >> 6, c8 = (rem & 63) * 8;
        *(u32x4*)(RWP + (srow0 + t) * RWP_LD + 1536 + qq * 512 + c8) = *(const LAS u32x4*)(lds + OUT + (qq * 8192 + t * 512 + c8) * 2);
    }
    if (seq) {
#pragma unroll
        for (int i = 0; i < 2; ++i) {
            const int pc = tid + i * NT, t = pc >> 6, c8 = (pc & 63) * 8;
            *(u32x4*)((bf16*)(p.ws + OFF_G) + ((size_t)b * T_ + p0 + t) * 512 + c8) = *(const LAS u32x4*)(lds + OUT + (4 * 8192 + t * 512 + c8) * 2);
        }
    }
    __syncthreads();
}

typedef float f32x2 __attribute__((ext_vector_type(2)));
__device__ __forceinline__ float dpp_sum8(float x) {
    x += __int_as_float(__builtin_amdgcn_update_dpp(0, __float_as_int(x), 0xB1, 0xF, 0xF, true));
    x += __int_as_float(__builtin_amdgcn_update_dpp(0, __float_as_int(x), 0x4E, 0xF, 0xF, true));
    x += __int_as_float(__builtin_amdgcn_update_dpp(0, __float_as_int(x), 0x141, 0xF, 0xF, true));
    return x;
}
namespace rs { constexpr int NS = 32, OPS = 0, VV = 2 * NS * 320 * 4, YB = VV + 2 * NS * 32 * 4, XSCR = YB + 2 * NS * 32 * 4, NCH = (TC_ + T_) / NS; }
struct RsRaw { u32x4 r, k, ld, a, v; float invn; };
__device__ __forceinline__ void rs_load(const bf16* RWP, const float* INVN, int cc, int b, int h, int dir, int vh, int st, RsRaw& R) {
    const int seq = cc >= TC_ / rs::NS, c = seq ? cc - TC_ / rs::NS : cc, Tlen = seq ? T_ : TC_;
    const int step = st >> 3, kq = st & 7;
    const int pos = dir ? Tlen - 1 - (c * rs::NS + step) : c * rs::NS + step;
    const size_t srow = (seq ? (size_t)NCTX + (size_t)b * T_ : (size_t)b * TC_) + pos;
    const bf16* rowp = RWP + srow * RWP_LD + h * 64 + kq * 8;
    R.r = *(const u32x4*)(rowp); R.k = *(const u32x4*)(rowp + 512);
    R.ld = *(const u32x4*)(rowp + 1536 + dir * 1024); R.a = *(const u32x4*)(rowp + 2048 + dir * 1024);
    R.v = *(const u32x4*)(RWP + srow * RWP_LD + 1024 + h * 64 + vh * 32 + (kq & 3) * 8);
    R.invn = INVN[srow * 8 + h];
}
template <bool XCVT>
__device__ __forceinline__ void rwkv_scan_item(const Params& p, LAS unsigned char* lds0, int item) {
    using namespace rs;
    const int tid = threadIdx.x, lane = tid & 63, wave = __builtin_amdgcn_readfirstlane(tid >> 6);
    const int dir = item & 1, vh = (item >> 1) & 1, h = (item >> 2) & 7, b = item >> 5;
    const bf16* RWP = (const bf16*)(p.ws + OFF_RWP); const float* INVN = (const float*)(p.ws + OFF_INVN);
    float* Y = p.out + (size_t)dir * NLAT * 512;
    const int st = tid - 256, skq = st & 7, sstep = st >> 3;
    float kkw[8], kaw[8];
    RsRaw R;
    if (wave >= 4) {
#pragma unroll
        for (int e = 0; e < 8; ++e) { kkw[e] = p.in[18][h * 64 + skq * 8 + e]; kaw[e] = p.in[19][h * 64 + skq * 8 + e]; }
        rs_load(RWP, INVN, 0, b, h, dir, vh, st, R);
    }
    f32x2 S[4];
#pragma unroll
    for (int i = 0; i < 4; ++i) S[i] = (f32x2){0.f, 0.f};
    const int v8 = lane >> 3, kq = lane & 7, vrow = wave * 8 + v8;
    __syncthreads();
    for (int cc = -1; cc <= NCH; ++cc) {
        LAS unsigned char* lds = lds0; asm volatile("" : "+v"(lds));
        if (wave >= 4) {
            if (cc >= 1 + TC_ / NS) {
                const int c1 = cc - 1 - TC_ / NS, pos = dir ? T_ - 1 - (c1 * NS + sstep) : c1 * NS + sstep;
                const f32x4 yv = *(const LAS f32x4*)((const LAS float*)(lds + YB) + (((cc - 1) & 1) * NS + sstep) * 32 + skq * 4);
                *(f32x4*)(Y + ((size_t)b * T_ + (size_t)((pos & 63) * 64 + (pos >> 6))) * 512 + h * 64 + vh * 32 + skq * 4) = yv;
            }
            if (cc + 1 < NCH) {
                const int buf = (cc + 1) & 1;
                LAS float* o = (LAS float*)(lds + OPS) + ((buf * NS + sstep) * 8 + skq) * 40;
                float nk[8], w[8], bb[8], kt[8], rr[8];
#pragma unroll
                for (int e = 0; e < 4; ++e) {
                    const float k0 = bflo(R.k[e]), k1 = bfhi(R.k[e]), a0 = bflo(R.a[e]), a1 = bfhi(R.a[e]);
                    const float n0 = k0 * kkw[2 * e] * R.invn, n1 = k1 * kkw[2 * e + 1] * R.invn;
                    nk[2 * e] = -n0; nk[2 * e + 1] = -n1; bb[2 * e] = n0 * a0; bb[2 * e + 1] = n1 * a1;
                    w[2 * e] = __expf(bflo(R.ld[e])); w[2 * e + 1] = __expf(bfhi(R.ld[e]));
                    kt[2 * e] = k0 * (1.f + (a0 - 1.f) * kaw[2 * e]); kt[2 * e + 1] = k1 * (1.f + (a1 - 1.f) * kaw[2 * e + 1]);
                    rr[2 * e] = bflo(R.r[e]); rr[2 * e + 1] = bfhi(R.r[e]);
                }
                *(LAS f32x4*)(o + 0) = (f32x4){nk[0], nk[1], nk[2], nk[3]}; *(LAS f32x4*)(o + 4) = (f32x4){nk[4], nk[5], nk[6], nk[7]};
                *(LAS f32x4*)(o + 8) = (f32x4){w[0], w[1], w[2], w[3]}; *(LAS f32x4*)(o + 12) = (f32x4){w[4], w[5], w[6], w[7]};
                *(LAS f32x4*)(o + 16) = (f32x4){bb[0], bb[1], bb[2], bb[3]}; *(LAS f32x4*)(o + 20) = (f32x4){bb[4], bb[5], bb[6], bb[7]};
                *(LAS f32x4*)(o + 24) = (f32x4){kt[0], kt[1], kt[2], kt[3]}; *(LAS f32x4*)(o + 28) = (f32x4){kt[4], kt[5], kt[6], kt[7]};
                *(LAS f32x4*)(o + 32) = (f32x4){rr[0], rr[1], rr[2], rr[3]}; *(LAS f32x4*)(o + 36) = (f32x4){rr[4], rr[5], rr[6], rr[7]};
                if (skq < 4) {
                    LAS float* vo = (LAS float*)(lds + VV) + (buf * NS + sstep) * 32 + skq * 8;
                    *(LAS f32x4*)(vo) = (f32x4){bflo(R.v[0]), bfhi(R.v[0]), bflo(R.v[1]), bfhi(R.v[1])};
                    *(LAS f32x4*)(vo + 4) = (f32x4){bflo(R.v[2]), bfhi(R.v[2]), bflo(R.v[3]), bfhi(R.v[3])};
                }
            }
            if (cc + 2 < NCH) rs_load(RWP, INVN, cc + 2, b, h, dir, vh, st, R);
            if (XCVT && cc >= 0 && (cc & 1) == 0) {
                const int it = (blockIdx.x * 4 + (wave - 4)) + 1024 * (cc >> 1);
                if (it < EXP_ITEMS) expert_item(p, (LAS float*)(lds + XSCR + (wave - 4) * 8448), it, lane);
            }
        } else if (cc >= 0 && cc < NCH) {
            const int buf = cc & 1;
            const LAS float* ob = (const LAS float*)(lds + OPS) + (buf * NS * 8 + kq) * 40;
            const LAS float* vb = (const LAS float*)(lds + VV) + buf * NS * 32 + vrow;
            LAS float* yl = (LAS float*)(lds + YB) + buf * NS * 32 + vrow;
            struct Ops { f32x4 n0, n1, w0, w1, b0, b1, k0, k1, r0, r1; float vv; };
#define RS_LOAD(P, i) do { const LAS float* o = ob + (i) * 320; P.n0 = *(const LAS f32x4*)(o); P.n1 = *(const LAS f32x4*)(o + 4); P.w0 = *(const LAS f32x4*)(o + 8); P.w1 = *(const LAS f32x4*)(o + 12); \
        P.b0 = *(const LAS f32x4*)(o + 16); P.b1 = *(const LAS f32x4*)(o + 20); P.k0 = *(const LAS f32x4*)(o + 24); P.k1 = *(const LAS f32x4*)(o + 28); P.r0 = *(const LAS f32x4*)(o + 32); P.r1 = *(const LAS f32x4*)(o + 36); P.vv = vb[(i) * 32]; } while (0)
#define RS_YDONE(i) do { yl[(i) * 32] = dpp_sum8(yp.x + yp.y); } while (0)
#define RS_STEP(P, i, FIN) do { \
        const f32x2 sa2 = (S[0] * (f32x2){P.n0.x, P.n0.y} + S[1] * (f32x2){P.n0.z, P.n0.w}) + (S[2] * (f32x2){P.n1.x, P.n1.y} + S[3] * (f32x2){P.n1.z, P.n1.w}); \
        if (FIN) RS_YDONE((i) - 1); \
        const float sa = dpp_sum8(sa2.x + sa2.y); const f32x2 sav = (f32x2){sa, sa}, vvv = (f32x2){P.vv, P.vv}; \
        S[0] = S[0] * (f32x2){P.w0.x, P.w0.y} + sav * (f32x2){P.b0.x, P.b0.y} + vvv * (f32x2){P.k0.x, P.k0.y}; \
        S[1] = S[1] * (f32x2){P.w0.z, P.w0.w} + sav * (f32x2){P.b0.z, P.b0.w} + vvv * (f32x2){P.k0.z, P.k0.w}; \
        S[2] = S[2] * (f32x2){P.w1.x, P.w1.y} + sav * (f32x2){P.b1.x, P.b1.y} + vvv * (f32x2){P.k1.x, P.k1.y}; \
        S[3] = S[3] * (f32x2){P.w1.z, P.w1.w} + sav * (f32x2){P.b1.z, P.b1.w} + vvv * (f32x2){P.k1.z, P.k1.w}; \
        yp = (S[0] * (f32x2){P.r0.x, P.r0.y} + S[1] * (f32x2){P.r0.z, P.r0.w}) + (S[2] * (f32x2){P.r1.x, P.r1.y} + S[3] * (f32x2){P.r1.z, P.r1.w}); \
    } while (0)
            Ops A, B;
            f32x2 yp;
            RS_LOAD(A, 0);
            RS_LOAD(B, 1);
            RS_STEP(A, 0, false);
            RS_LOAD(A, 2);
            RS_STEP(B, 1, true);
#pragma unroll 1
            for (int i = 2; i < NS; i += 2) {
                RS_LOAD(B, i + 1);
                RS_STEP(A, i, true);
                RS_LOAD(A, i + 2);
                RS_STEP(B, i + 1, true);
            }
            RS_YDONE(NS - 1);
#undef RS_LOAD
#undef RS_STEP
#undef RS_YDONE
        }
        __syncthreads();
    }
}

namespace rc {
constexpr int SET = 10752;
constexpr int RH = 0, BKT = 2304, VT = 6400, GAM = 10496;
constexpr int AH = 3 * SET, BH = AH + 2304, KH = BH + 2304, AHT = KH + 2304  , ABK = AHT + 2 * 4096  , AAK = ABK + 2 * 1024  , AABT = AAK + 2 * 1024, TT = AABT + 1024, W2T = TT + 1024,
              P1T = W2T + 1024, YB = P1T + 2304, END = YB + 4096;
constexpr int NCH = (TC_ + T_) / 16;
}
struct RcRaw { u32x2 r, k, a, v, ld; float invn; };
__device__ __forceinline__ void rc_load(const bf16* RWP, const float* INVN, int cc, int b, int h, int dir, int ei, int ekq, RcRaw& R) {
    const int seq = cc >= TC_ / 16, c = seq ? cc - TC_ / 16 : cc, Tlen = seq ? T_ : TC_;
    const size_t srow = (seq ? (size_t)NCTX + (size_t)b * T_ : (size_t)b * TC_) + (dir ? Tlen - 1 - (c * 16 + ei) : c * 16 + ei);
    const bf16* rowp = RWP + srow * RWP_LD + h * 64 + ekq * 4;
    R.r = *(const u32x2*)(rowp); R.k = *(const u32x2*)(rowp + 512); R.v = *(const u32x2*)(rowp + 1024);
    R.ld = *(const u32x2*)(rowp + 1536 + dir * 1024); R.a = *(const u32x2*)(rowp + 2048 + dir * 1024);
    R.invn = INVN[srow * 8 + h];
}
__device__ __forceinline__ float scan16_row(float x) {
    x += __int_as_float(__builtin_amdgcn_update_dpp(0, __float_as_int(x), 0x111, 0xF, 0xF, true));
    x += __int_as_float(__builtin_amdgcn_update_dpp(0, __float_as_int(x), 0x112, 0xF, 0xF, true));
    x += __int_as_float(__builtin_amdgcn_update_dpp(0, __float_as_int(x), 0x114, 0xF, 0xF, true));
    x += __int_as_float(__builtin_amdgcn_update_dpp(0, __float_as_int(x), 0x118, 0xF, 0xF, true));
    return x;
}
__device__ __forceinline__ void rwkv_chunk_item(const Params& p, LAS unsigned char* lds0, int item) {
    using namespace rc;
    const int tid = threadIdx.x, lane = tid & 63, wave = __builtin_amdgcn_readfirstlane(tid >> 6), l15 = lane & 15, q = lane >> 4;
    const int dir = item & 1, h = (item >> 1) & 7, b = item >> 4;
    const bf16* RWP = (const bf16*)(p.ws + OFF_RWP); const float* INVN = (const float*)(p.ws + OFF_INVN);
    bf16* Y = (bf16*)p.out + (size_t)dir * NLAT * 512;
    __syncthreads();
    for (int i = tid; i < END / 4; i += NT) ((LAS unsigned*)lds0)[i] = 0u;
    const int ei = lane & 15, ekq = (wave & 3) * 4 + (lane >> 4);
    RcRaw R;
    const f32x4 kkw = *(const f32x4*)(p.in[18] + h * 64 + ekq * 4), kaw = *(const f32x4*)(p.in[19] + h * 64 + ekq * 4);
    f32x4 acc[4];
#pragma unroll
    for (int t = 0; t < 4; ++t) acc[t] = (f32x4){0.f, 0.f, 0.f, 0.f};
    __syncthreads();
    for (int cc = -4; cc < NCH; ++cc) {
        LAS unsigned char* lds = lds0; asm volatile("" : "+v"(lds));
        int l15o = l15, qo = q; asm volatile("" : "+v"(l15o), "+v"(qo));
        const int c2 = cc + 2, c1 = cc + 1;
        if (wave < 4) {
            if (c2 >= 0 && c2 < NCH) {
                LAS unsigned char* S2 = lds + (c2 % 3) * SET;
                const float l0 = bflo(R.ld.x), l1 = bfhi(R.ld.x), l2 = bflo(R.ld.y), l3 = bfhi(R.ld.y);
                const float ldi[4] = {l0, l1, l2, l3};
                const float cl[4] = {scan16_row(l0), scan16_row(l1), scan16_row(l2), scan16_row(l3)};
                const float rr[4] = {bflo(R.r.x), bfhi(R.r.x), bflo(R.r.y), bfhi(R.r.y)}, kv[4] = {bflo(R.k.x), bfhi(R.k.x), bflo(R.k.y), bfhi(R.k.y)};
                const float av[4] = {bflo(R.a.x), bfhi(R.a.x), bflo(R.a.y), bfhi(R.a.y)};
                float rh[4], ah[4], bh[4], kh[4], e1[4];
#pragma unroll
                for (int e = 0; e < 4; ++e) {
                    e1[e] = __expf(cl[e]); const float e2 = __expf(-cl[e]), e3 = __expf(cl[e] - ldi[e]);
                    const float kkv = kv[e] * kkw[e] * R.invn;
                    rh[e] = rr[e] * e1[e]; ah[e] = -kkv * e3; bh[e] = kkv * av[e] * e2; kh[e] = kv[e] * (1.f + (av[e] - 1.f) * kaw[e]) * e2;
                }
                const int k0 = ekq * 4;
                { u32x2 w; w.x = pk2(rh[0], rh[1]); w.y = pk2(rh[2], rh[3]); *(LAS u32x2*)(S2 + RH + (ei * 72 + k0) * 2) = w; }
                { u32x2 w; w.x = pk2(ah[0], ah[1]); w.y = pk2(ah[2], ah[3]); *(LAS u32x2*)(lds + AH + (ei * 72 + k0) * 2) = w; }
                { u32x2 w; w.x = pk2(bh[0], bh[1]); w.y = pk2(bh[2], bh[3]); *(LAS u32x2*)(lds + BH + (ei * 72 + k0) * 2) = w; }
                { u32x2 w; w.x = pk2(kh[0], kh[1]); w.y = pk2(kh[2], kh[3]); *(LAS u32x2*)(lds + KH + (ei * 72 + k0) * 2) = w; }
                const int bq = (ei >> 2) * 8 + (ei & 3);
                LAS unsigned char* aht = lds + AHT + (c2 & 1) * 4096;
#pragma unroll
                for (int e = 0; e < 4; ++e) {
                    *(LAS bf16*)(aht + ((k0 + e) * 32 + ei) * 2) = (bf16)f2bf(ah[e]);
                    *(LAS bf16*)(S2 + BKT + ((k0 + e) * 32 + bq) * 2) = (bf16)f2bf(bh[e]);
                    *(LAS bf16*)(S2 + BKT + ((k0 + e) * 32 + bq + 4) * 2) = (bf16)f2bf(kh[e]);
                }
                *(LAS bf16*)(S2 + VT + ((k0 + 0) * 32 + ei) * 2) = (bf16)(R.v.x & 0xffffu); *(LAS bf16*)(S2 + VT + ((k0 + 1) * 32 + ei) * 2) = (bf16)(R.v.x >> 16);
                *(LAS bf16*)(S2 + VT + ((k0 + 2) * 32 + ei) * 2) = (bf16)(R.v.y & 0xffffu); *(LAS bf16*)(S2 + VT + ((k0 + 3) * 32 + ei) * 2) = (bf16)(R.v.y >> 16);
                if (ei == 15) *(LAS f32x4*)(S2 + GAM + k0 * 4) = (f32x4){e1[0], e1[1], e1[2], e1[3]};
            }
            if (cc + 3 >= 0 && cc + 3 < NCH) rc_load(RWP, INVN, cc + 3, b, h, dir, ei, ekq, R);
            if (wave == 0 && c1 >= 0 && c1 < NCH) {
                int lo = lane; asm volatile("" : "+v"(lo));
                const int ci = lo >> 2, part = lo & 3;
                float t[4];
#pragma unroll
                for (int e = 0; e < 4; ++e) t[e] = (part + 4 * e == ci) ? 1.f : 0.f;
#pragma unroll
                for (int m = 15; m >= 1; --m) {
                    const int src = __float_as_int(t[m >> 2]);
                    float tm;
                    switch (m & 3) {
                        case 0: tm = __int_as_float(__builtin_amdgcn_update_dpp(0, src, 0x00, 0xF, 0xF, true)); break;
                        case 1: tm = __int_as_float(__builtin_amdgcn_update_dpp(0, src, 0x55, 0xF, 0xF, true)); break;
                        case 2: tm = __int_as_float(__builtin_amdgcn_update_dpp(0, src, 0xAA, 0xF, 0xF, true)); break;
                        default: tm = __int_as_float(__builtin_amdgcn_update_dpp(0, src, 0xFF, 0xF, 0xF, true)); break;
                    }
                    const f32x4 a4 = *(const LAS f32x4*)((const LAS float*)(lds + AABT) + m * 16 + part * 4);
#pragma unroll
                    for (int e = 0; e < 4; ++e) if (4 * e < m) t[e] = fmaf(a4[e], tm, t[e]);
                }
#pragma unroll
                for (int e = 0; e < 4; ++e) *(LAS bf16*)(lds + TT + (ci * 32 + part + 4 * e) * 2) = (bf16)f2bf(t[e]);
            }
        } else if (cc >= 0) {
            const LAS unsigned char* S0 = lds + (cc % 3) * SET;
            const int vt = wave - 4;
            f32x4 sat = (f32x4){0.f, 0.f, 0.f, 0.f};
            {
                const bf16x8 a = *(const LAS bf16x8*)(lds + W2T + (l15 * 32 + q * 8) * 2);
                const bf16x8 bv = *(const LAS bf16x8*)(S0 + VT + ((vt * 16 + l15) * 32 + q * 8) * 2);
                sat = MFMA16(a, bv, sat);
            }
            f32x4 yt = (f32x4){0.f, 0.f, 0.f, 0.f};
#pragma unroll
            for (int s = 0; s < 2; ++s) {
                u32x4 sb; sb.x = pk2(acc[2 * s][0], acc[2 * s][1]); sb.y = pk2(acc[2 * s][2], acc[2 * s][3]); sb.z = pk2(acc[2 * s + 1][0], acc[2 * s + 1][1]); sb.w = pk2(acc[2 * s + 1][2], acc[2 * s + 1][3]);
                const bf16x8 sB = __builtin_bit_cast(bf16x8, sb);
                u32x4 pa; { const u32x2 lo = *(const LAS u32x2*)(lds + P1T + (l15 * 72 + 32 * s + 4 * q) * 2), hi = *(const LAS u32x2*)(lds + P1T + (l15 * 72 + 32 * s + 16 + 4 * q) * 2); pa = (u32x4){lo.x, lo.y, hi.x, hi.y}; }
                u32x4 ra; { const u32x2 lo = *(const LAS u32x2*)(S0 + RH + (l15 * 72 + 32 * s + 4 * q) * 2), hi = *(const LAS u32x2*)(S0 + RH + (l15 * 72 + 32 * s + 16 + 4 * q) * 2); ra = (u32x4){lo.x, lo.y, hi.x, hi.y}; }
                sat = MFMA16(__builtin_bit_cast(bf16x8, pa), sB, sat);
                yt = MFMA16(__builtin_bit_cast(bf16x8, ra), sB, yt);
            }
            const u32x2 vv = *(const LAS u32x2*)(S0 + VT + ((vt * 16 + l15) * 32 + 4 * q) * 2);
            u32x4 b2; b2.x = pk2(sat[0], sat[1]); b2.y = pk2(sat[2], sat[3]); b2.z = vv.x; b2.w = vv.y;
            const bf16x8 B2 = __builtin_bit_cast(bf16x8, b2);
            yt = MFMA16(*(const LAS bf16x8*)(lds + ABK + (cc & 1) * 1024 + (l15 * 32 + q * 8) * 2), B2, yt);
#pragma unroll
            for (int kt = 0; kt < 4; ++kt) {
                acc[kt] = MFMA16(*(const LAS bf16x8*)(S0 + BKT + ((kt * 16 + l15) * 32 + q * 8) * 2), B2, acc[kt]);
                acc[kt] = acc[kt] * *(const LAS f32x4*)(S0 + GAM + (kt * 16 + 4 * q) * 4);
            }
            LAS float* yb = (LAS float*)(lds + YB) + vt * 16 + l15;
#pragma unroll
            for (int r = 0; r < 4; ++r) yb[(4 * q + r) * 64] = yt[r];
        }
        BAR_LDS();
        if (wave < 4) {
            if (c2 >= 0 && c2 < NCH) {
                const LAS unsigned char* S2 = lds + (c2 % 3) * SET;
                const int ia = wave == 3 ? AH : (wave == 1 ? KH : BH);
                f32x4 d = (f32x4){0.f, 0.f, 0.f, 0.f};
#pragma unroll
                for (int s = 0; s < 2; ++s) {
                    const bf16x8 a = *(const LAS bf16x8*)(lds + ia + (l15 * 72 + s * 32 + q * 8) * 2);
                    bf16x8 bb;
                    if (wave < 2) bb = *(const LAS bf16x8*)(S2 + RH + (l15 * 72 + s * 32 + q * 8) * 2);
                    else if (wave == 2) bb = *(const LAS bf16x8*)(lds + AH + (l15 * 72 + s * 32 + q * 8) * 2);
                    else bb = *(const LAS bf16x8*)(lds + KH + (l15 * 72 + s * 32 + q * 8) * 2);
                    d = MFMA16(a, bb, d);
                }
                if (wave < 2) {
                    float o[4];
#pragma unroll
                    for (int r = 0; r < 4; ++r) o[r] = (4 * qo + r <= l15o) ? d[r] : 0.f;
                    u32x2 w; w.x = pk2(o[0], o[1]); w.y = pk2(o[2], o[3]);
                    *(LAS u32x2*)(lds + ABK + (c2 & 1) * 1024 + (l15 * 32 + q * 8 + wave * 4) * 2) = w;
                } else if (wave == 2) {
                    f32x4 o;
#pragma unroll
                    for (int r = 0; r < 4; ++r) o[r] = (4 * qo + r < l15o) ? d[r] : 0.f;
#pragma unroll
                    for (int r = 0; r < 4; ++r) *(LAS float*)(lds + AABT + (l15 * 16 + r * 4 + q) * 4) = o[r];
                } else {
                    float o[4];
#pragma unroll
                    for (int r = 0; r < 4; ++r) o[r] = (l15o < 4 * qo + r) ? d[r] : 0.f;
                    u32x2 w; w.x = pk2(o[0], o[1]); w.y = pk2(o[2], o[3]);
                    *(LAS u32x2*)(lds + AAK + (c2 & 1) * 1024 + (l15 * 32 + 4 * q) * 2) = w;
                }
            }
        } else {
            if (c1 >= 0 && c1 < NCH) {
                const bf16x8 bt = *(const LAS bf16x8*)(lds + TT + (l15 * 32 + q * 8) * 2);
                const int mt = wave - 4;
                f32x4 d = (f32x4){0.f, 0.f, 0.f, 0.f};
                d = MFMA16(*(const LAS bf16x8*)(lds + AHT + (c1 & 1) * 4096 + ((mt * 16 + l15) * 32 + q * 8) * 2), bt, d);
                { u32x2 w; w.x = pk2(d[0], d[1]); w.y = pk2(d[2], d[3]); *(LAS u32x2*)(lds + P1T + (l15 * 72 + mt * 16 + 4 * q) * 2) = w; }
                if (wave == 4) {
                    f32x4 d2 = (f32x4){0.f, 0.f, 0.f, 0.f};
                    d2 = MFMA16(*(const LAS bf16x8*)(lds + AAK + (c1 & 1) * 1024 + (l15 * 32 + q * 8) * 2), bt, d2);
                    u32x2 w; w.x = pk2(d2[0], d2[1]); w.y = pk2(d2[2], d2[3]);
                    *(LAS u32x2*)(lds + W2T + (l15 * 32 + 4 * q) * 2) = w;
                }
            }
            if (cc >= TC_ / 16) {
                const int t2 = tid - 256, fi = t2 >> 4, part = t2 & 15;
                const int cl1 = cc - TC_ / 16, pos = dir ? T_ - 1 - (cl1 * 16 + fi) : cl1 * 16 + fi;
                const f32x4 yv = *(const LAS f32x4*)((const LAS float*)(lds + YB) + fi * 64 + part * 4);
                u32x2 yw; yw.x = pk2(yv.x, yv.y); yw.y = pk2(yv.z, yv.w);
                *(u32x2*)(Y + ((size_t)b * T_ + (size_t)((pos & 63) * 64 + (pos >> 6))) * 512 + h * 64 + part * 4) = yw;
            }
        }
        BAR_LDS();
    }
}

__device__ __forceinline__ void phase_combine(const Params& p) {
    const int lane = threadIdx.x & 63, wave = threadIdx.x >> 6;
    const int gw = blockIdx.x * NW + wave, NGW = gridDim.x * NW;
    const bf16* u = (const bf16*)(p.ws + OFF_U); const bf16* HFB = (const bf16*)(p.ws + OFF_MIX);
    const bf16* Y = (const bf16*)p.out; const float* BON = (const float*)(p.ws + OFF_BON);
    const bf16* RWP = (const bf16*)(p.ws + OFF_RWP); const bf16* Gb = (const bf16*)(p.ws + OFF_G);
    const float* ml_norm_g = p.in[11]; const float* ln_g = p.in[21]; const float* ln_b = p.in[22];
    bf16* mix = (bf16*)(p.ws + OFF_MIX);
    const int c8 = lane * 8;
    for (int rl = gw; rl < NLAT; rl += NGW) {
        const int b = rl / T_, t = rl % T_, pp = (t & 63) * 64 + (t >> 6);
        const size_t lrow = (size_t)b * T_ + pp;
        const u32x4 hf = *(const u32x4*)(HFB + (size_t)rl * 1024 + c8), hb = *(const u32x4*)(HFB + (size_t)rl * 1024 + 512 + c8);
        const u32x4 zo = rl < ZOX_ROWS ? *(const u32x4*)((const bf16*)(p.ws + OFF_ZOX) + (size_t)rl * 512 + c8) : *(const u32x4*)(u + ((size_t)NCTX + rl) * UC + 1536 + c8);
        float hs[8], ss = 0.f;
#pragma unroll
        for (int e = 0; e < 4; ++e) { hs[2 * e] = bflo(hf[e]) + bflo(hb[e]); hs[2 * e + 1] = bfhi(hf[e]) + bfhi(hb[e]); ss += hs[2 * e] * hs[2 * e] + hs[2 * e + 1] * hs[2 * e + 1]; }
        ss += __shfl_xor(ss, 1); ss += __shfl_xor(ss, 2); ss += __shfl_xor(ss, 4); ss += __shfl_xor(ss, 8);
        const float rs_ = rsqrtf(ss * (1.f / 128.f) + 1e-6f);
        float o[8];
#pragma unroll
        for (int e = 0; e < 4; ++e) { o[2 * e] = hs[2 * e] * rs_ * ml_norm_g[c8 + 2 * e] * sigmoidf_(bflo(zo[e])); o[2 * e + 1] = hs[2 * e + 1] * rs_ * ml_norm_g[c8 + 2 * e + 1] * sigmoidf_(bfhi(zo[e])); }
        { u32x4 w; w.x = pk2(o[0], o[1]); w.y = pk2(o[2], o[3]); w.z = pk2(o[4], o[5]); w.w = pk2(o[6], o[7]); *(u32x4*)(mix + (size_t)rl * D_ + c8) = w; }
        const u32x4 yf = *(const u32x4*)(Y + (size_t)rl * 512 + c8), yb = *(const u32x4*)(Y + ((size_t)NLAT + rl) * 512 + c8);
        float y[8];
#pragma unroll
        for (int e = 0; e < 4; ++e) { y[2 * e] = bflo(yf[e]) + bflo(yb[e]); y[2 * e + 1] = bfhi(yf[e]) + bfhi(yb[e]); }
        float sm = 0.f;
#pragma unroll
        for (int e = 0; e < 8; ++e) sm += y[e];
        sm += __shfl_xor(sm, 1); sm += __shfl_xor(sm, 2); sm += __shfl_xor(sm, 4);
        const float mean = sm * (1.f / 64.f);
        float sv = 0.f;
#pragma unroll
        for (int e = 0; e < 8; ++e) { y[e] -= mean; sv += y[e] * y[e]; }
        sv += __shfl_xor(sv, 1); sv += __shfl_xor(sv, 2); sv += __shfl_xor(sv, 4);
        const float rstd = rsqrtf(sv * (1.f / 64.f) + 64e-5f);
        const int head = lane >> 3;
        const float bonus = BON[lrow * 8 + head] + BON[((size_t)NLAT + lrow) * 8 + head];
        const u32x4 vs = *(const u32x4*)(RWP + ((size_t)NCTX + lrow) * RWP_LD + 1024 + c8), gg = *(const u32x4*)(Gb + lrow * 512 + c8);
#pragma unroll
        for (int e = 0; e < 4; ++e) {
            o[2 * e] = (y[2 * e] * rstd * ln_g[c8 + 2 * e] + ln_b[c8 + 2 * e] + bonus * bflo(vs[e])) * bflo(gg[e]);
            o[2 * e + 1] = (y[2 * e + 1] * rstd * ln_g[c8 + 2 * e + 1] + ln_b[c8 + 2 * e + 1] + bonus * bfhi(vs[e])) * bfhi(gg[e]);
        }
        { u32x4 w; w.x = pk2(o[0], o[1]); w.y = pk2(o[2], o[3]); w.z = pk2(o[4], o[5]); w.w = pk2(o[6], o[7]); *(u32x4*)(mix + (size_t)rl * D_ + 512 + c8) = w; }
    }
}

__device__ __forceinline__ void phase_norm2(const Params& p, LAS unsigned char* lds) {
    const int tid = threadIdx.x, wave = tid >> 6;
    const int gw = blockIdx.x * NW + wave, NGW = gridDim.x * NW;
    const float* g = p.in[24]; const float* router_w = p.in[25]; const float* mod = (const float*)(p.ws + OFF_MOD);
    const bf16* h = (const bf16*)(p.ws + OFF_H);
    unsigned char* xn2 = p.ws + OFF_XN2;
    float* aff = (float*)(p.ws + OFF_AFF);
    LAS float* RWT = (LAS float*)lds;
    __syncthreads();
    {
        float rv[32];
#pragma unroll
        for (int j = 0; j < 32; ++j) rv[j] = router_w[tid + j * NT];
#pragma unroll
        for (int j = 0; j < 32; ++j) { const int i = tid + j * NT; RWT[(i & 15) * 1024 + (i >> 4)] = rv[j]; }
    }
    __syncthreads();
#pragma unroll 1
    for (int rl = gw; rl < NLAT; rl += NGW) {
        int lane = tid & 63; asm volatile("" : "+v"(lane));
        const int b = rl / T_, t = rl % T_;
        const float* sh2 = mod + b * MOD6 + 3 * D_, *sc2 = sh2 + D_;
        f32x4 o[4]; float s = 0.f;
#pragma unroll
        for (int j = 0; j < 4; ++j) { const u32x2 hw = *(const u32x2*)(h + (size_t)rl * D_ + j * 256 + lane * 4); o[j] = (f32x4){bflo(hw.x), bfhi(hw.x), bflo(hw.y), bfhi(hw.y)}; s += (o[j].x * o[j].x + o[j].y * o[j].y) + (o[j].z * o[j].z + o[j].w * o[j].w); }
        const float rstd = rsqrtf(wave_sum(s) * (1.f / D_) + 1e-6f);
#pragma unroll
        for (int j = 0; j < 4; ++j) {
            const int d = j * 256 + lane * 4;
            const f32x4 gg = *(const f32x4*)(g + d), ss = *(const f32x4*)(sc2 + d), hh = *(const f32x4*)(sh2 + d);
            o[j] = o[j] * rstd * gg * (ss + 1.f) + hh;
            *(unsigned*)(xn2 + (size_t)rl * D_ + d) = pk4_f8(o[j].x, o[j].y, o[j].z, o[j].w);
        }
        float lg[16];
        const LAS float* RW = RWT + lane * 4;
#pragma unroll
        for (int e = 0; e < 16; ++e) {
            float a0 = 0.f;
#pragma unroll
            for (int j = 0; j < 4; ++j) { const f32x4 w4 = *(const LAS f32x4*)(RW + e * 1024 + j * 256); a0 += (o[j].x * w4.x + o[j].y * w4.y) + (o[j].z * w4.z + o[j].w * w4.w); }
            lg[e] = a0;
        }
        float x8[8], x4[4], x2[2], x1;
#pragma unroll
        for (int i = 0; i < 8; ++i) { const bool up = lane & 32; const float send = up ? lg[i] : lg[i + 8], keep = up ? lg[i + 8] : lg[i]; x8[i] = keep + __shfl_xor(send, 32); }
#pragma unroll
        for (int i = 0; i < 4; ++i) { const bool up = lane & 16; const float send = up ? x8[i] : x8[i + 4], keep = up ? x8[i + 4] : x8[i]; x4[i] = keep + __shfl_xor(send, 16); }
#pragma unroll
        for (int i = 0; i < 2; ++i) { const bool up = lane & 8; const float send = up ? x4[i] : x4[i + 2], keep = up ? x4[i + 2] : x4[i]; x2[i] = keep + __shfl_xor(send, 8); }
        { const bool up = lane & 4; const float send = up ? x2[0] : x2[1], keep = up ? x2[1] : x2[0]; x1 = keep + __shfl_xor(send, 4); }
        x1 += __shfl_xor(x1, 2); x1 += __shfl_xor(x1, 1);
        float mx = x1;
        mx = fmaxf(mx, __shfl_xor(mx, 4)); mx = fmaxf(mx, __shfl_xor(mx, 8)); mx = fmaxf(mx, __shfl_xor(mx, 16)); mx = fmaxf(mx, __shfl_xor(mx, 32));
        const float ex = expf(x1 - mx);
        float sm = ex;
        sm += __shfl_xor(sm, 4); sm += __shfl_xor(sm, 8); sm += __shfl_xor(sm, 16); sm += __shfl_xor(sm, 32);
        const int e = ((lane >> 5) & 1) * 8 + ((lane >> 4) & 1) * 4 + ((lane >> 3) & 1) * 2 + ((lane >> 2) & 1);
        if ((lane & 3) == 0) aff[((size_t)b * E_ + e) * T_ + t] = ex / sm;
    }
}

__device__ __forceinline__ void phase_topk(const Params& p, LAS unsigned char* lds) {
    LAS unsigned* hist = (LAS unsigned*)lds;
    LAS unsigned* wsum = hist + 256;
    LAS unsigned* bc = wsum + 8;
    const float* aff = (const float*)(p.ws + OFF_AFF);
    int* idx = (int*)(p.ws + OFF_IDX); float* gate = (float*)(p.ws + OFF_GATE); int* sel = (int*)(p.ws + OFF_SEL);
    const int tid = threadIdx.x, lane = tid & 63, wave = tid >> 6;
    for (int be = blockIdx.x; be < B_ * E_; be += gridDim.x) {
        const int b = be / E_, e = be % E_;
        unsigned key[8];
        { const u32x4 k0 = *(const u32x4*)(aff + (size_t)be * T_ + tid * 8), k1 = *(const u32x4*)(aff + (size_t)be * T_ + tid * 8 + 4);
          key[0] = k0.x; key[1] = k0.y; key[2] = k0.z; key[3] = k0.w; key[4] = k1.x; key[5] = k1.y; key[6] = k1.z; key[7] = k1.w; }
        unsigned prefix = 0u, need = CAP;
#pragma unroll 1
        for (int pass = 0; pass < 4; ++pass) {
            const int shift = 24 - 8 * pass;
            __syncthreads();
            if (tid < 256) hist[tid] = 0u;
            __syncthreads();
#pragma unroll
            for (int i = 0; i < 8; ++i) if (pass == 0 || (key[i] >> (shift + 8)) == prefix) __hip_atomic_fetch_add(&hist[(key[i] >> shift) & 255u], 1u, __ATOMIC_RELAXED, __HIP_MEMORY_SCOPE_WORKGROUP);
            __syncthreads();
            if (wave == 0) {
                const unsigned h0 = hist[4 * lane], h1 = hist[4 * lane + 1], h2 = hist[4 * lane + 2], h3 = hist[4 * lane + 3];
                const unsigned s = h0 + h1 + h2 + h3;
                unsigned suf = s;
#pragma unroll
                for (int o = 1; o < 64; o <<= 1) { const unsigned t = __shfl_down(suf, o); if (lane + o < 64) suf += t; }
                const unsigned above = suf - s;
                if (above < need && need <= suf) {
                    unsigned c = above, bin, nn;
                    if (c + h3 >= need) { bin = 4 * lane + 3; nn = need - c; }
                    else { c += h3; if (c + h2 >= need) { bin = 4 * lane + 2; nn = need - c; }
                    else { c += h2; if (c + h1 >= need) { bin = 4 * lane + 1; nn = need - c; }
                    else { c += h1; bin = 4 * lane; nn = need - c; } } }
                    bc[0] = bin; bc[1] = nn;
                }
            }
            __syncthreads();
            prefix = (prefix << 8) | bc[0]; need = bc[1];
        }
        unsigned cg = 0u, ce = 0u;
#pragma unroll
        for (int i = 0; i < 8; ++i) { cg += key[i] > prefix ? 1u : 0u; ce += key[i] == prefix ? 1u : 0u; }
        unsigned pk = cg | (ce << 16), inc = pk;
#pragma unroll
        for (int o = 1; o < 64; o <<= 1) { const unsigned t = __shfl_up(inc, o); if (lane >= o) inc += t; }
        __syncthreads();
        if (lane == 63) wsum[wave] = inc;
        __syncthreads();
        unsigned base = 0u;
#pragma unroll
        for (int w = 0; w < 8; ++w) base += w < wave ? wsum[w] : 0u;
        unsigned excl = base + inc - pk;
        unsigned gtb = excl & 0xffffu, eqb = excl >> 16;
#pragma unroll
        for (int i = 0; i < 8; ++i) {
            const int t = tid * 8 + i;
            const bool isg = key[i] > prefix, ise = key[i] == prefix;
            const bool take = isg || (ise && eqb < need);
            const int slot = (int)(gtb + (eqb < need ? eqb : need));
            if (take) { idx[e * 4096 + b * CAP + slot] = b * T_ + t; gate[e * 4096 + b * CAP + slot] = __uint_as_float(key[i]); }
            sel[(size_t)be * T_ + t] = take ? slot : -1;
            gtb += isg ? 1u : 0u; eqb += ise ? 1u : 0u;
        }
    }
}

__device__ __forceinline__ void phase_gather(const Params& p) {
    const int lane = threadIdx.x & 63, wave = threadIdx.x >> 6;
    const int gw = blockIdx.x * NW + wave, NGW = gridDim.x * NW;
    const unsigned char* xn2 = p.ws + OFF_XN2; const int* idx = (const int*)(p.ws + OFF_IDX);
    unsigned char* xs = p.ws + OFF_XS;
    for (int r = gw; r < E_ * 4096; r += NGW) *(u32x4*)(xs + (size_t)r * D_ + lane * 16) = *(const u32x4*)(xn2 + (size_t)idx[r] * D_ + lane * 16);
}

__device__ __forceinline__ void phase_final(const Params& p) {
    const int lane = threadIdx.x & 63, wave = threadIdx.x >> 6;
    const int gw = blockIdx.x * NW + wave, NGW = gridDim.x * NW;
    const float* mod = (const float*)(p.ws + OFF_MOD); const float* fg = p.in[29];
    const bf16* ys = (const bf16*)(p.ws + OFF_YS); const int* sel = (const int*)(p.ws + OFF_SEL); const float* aff = (const float*)(p.ws + OFF_AFF);
    float* out = p.out; const bf16* hb = (const bf16*)(p.ws + OFF_H);
    int cs = -1; float cg = 0.f;
    if (gw < NLAT && lane < 16) { const size_t o = ((size_t)(gw / T_) * E_ + lane) * T_ + gw % T_; cs = sel[o]; cg = aff[o]; }
    for (int rl = gw; rl < NLAT; rl += NGW) {
        const int b = rl / T_;
        const int myslot = cs; const float mygate = cg;
        { const int rn = rl + NGW; if (rn < NLAT && lane < 16) { const size_t o = ((size_t)(rn / T_) * E_ + lane) * T_ + rn % T_; cs = sel[o]; cg = aff[o]; } }
        f32x4 hv[4];
#pragma unroll
        for (int j = 0; j < 4; ++j) { const u32x2 hw = *(const u32x2*)(hb + (size_t)rl * D_ + j * 256 + lane * 4); hv[j] = (f32x4){bflo(hw.x), bfhi(hw.x), bflo(hw.y), bfhi(hw.y)}; }
        f32x4 acc[4];
#pragma unroll
        for (int j = 0; j < 4; ++j) acc[j] = (f32x4){0.f, 0.f, 0.f, 0.f};
        unsigned mm = (unsigned)__ballot(myslot >= 0) & 0xffffu;
        while (mm) {
            int ee[4]; float gg[4]; const bf16* yr[4]; bool vv[4];
#pragma unroll
            for (int i = 0; i < 4; ++i) { const bool v = mm != 0u; vv[i] = v; ee[i] = v ? __builtin_ctz(mm) : ee[0]; mm = v ? (mm & (mm - 1u)) : 0u;
                const int sl = __shfl(myslot, ee[i]); const float gt = __shfl(mygate, ee[i]); gg[i] = v ? gt : 0.f;
                yr[i] = ys + ((size_t)ee[i] * 4096 + b * CAP + sl) * D_ + lane * 4; }
            u32x2 w[4][4];
#pragma unroll
            for (int i = 0; i < 4; ++i) {
                if (vv[i]) {
#pragma unroll
                    for (int j = 0; j < 4; ++j) w[i][j] = *(const u32x2*)(yr[i] + j * 256);
                } else {
#pragma unroll
                    for (int j = 0; j < 4; ++j) w[i][j] = (u32x2){0u, 0u};
                }
            }
#pragma unroll
            for (int i = 0; i < 4; ++i)
#pragma unroll
                for (int j = 0; j < 4; ++j) { acc[j].x += gg[i] * bflo(w[i][j].x); acc[j].y += gg[i] * bfhi(w[i][j].x); acc[j].z += gg[i] * bflo(w[i][j].y); acc[j].w += gg[i] * bfhi(w[i][j].y); }
        }
        const float* g2 = mod + b * MOD6 + 5 * D_;
        f32x4 o[4]; float s2 = 0.f;
#pragma unroll
        for (int j = 0; j < 4; ++j) { const int d = j * 256 + lane * 4; o[j] = hv[j] + *(const f32x4*)(g2 + d) * acc[j];
            s2 += (o[j].x * o[j].x + o[j].y * o[j].y) + (o[j].z * o[j].z + o[j].w * o[j].w); }
        const float rstd = rsqrtf(wave_sum(s2) * (1.f / D_) + 1e-6f);
#pragma unroll
        for (int j = 0; j < 4; ++j) { const int d = j * 256 + lane * 4; *(f32x4*)(out + (size_t)rl * D_ + d) = o[j] * rstd * *(const f32x4*)(fg + d); }
    }
}


#define GAS __attribute__((address_space(1)))
#define XB_TMO      128
#define XB_XCNT(j)  (256  + 64 * (j))
#define XB_XSUB(j)  (1280 + 64 * (j))
#define XB_XGEN(j)  (2304 + 64 * (j))
#define XB_TOP      3328
#define XB_TOPGEN   3392
#define XCD_BAR_WORDS 3456
#define XB_SPIN_CAP (1u << 24)

__device__ __forceinline__ unsigned xb_ld(unsigned* p)              { return __hip_atomic_load(p, __ATOMIC_RELAXED, __HIP_MEMORY_SCOPE_AGENT); }
__device__ __forceinline__ unsigned xb_add(unsigned* p, unsigned v) { return __hip_atomic_fetch_add(p, v, __ATOMIC_RELAXED, __HIP_MEMORY_SCOPE_AGENT); }
__device__ __forceinline__ unsigned xb_xcc_id() { return (unsigned)__builtin_amdgcn_s_getreg((3 << 11) | 20) & 0xFu; }
#define XB_SPIN(cond, bar) do { unsigned _sp = 0; while (cond) { __builtin_amdgcn_s_sleep(1); \
    if ((++_sp & 255u) == 0u) { if (xb_ld(&(bar)[XB_TMO])) break; if (_sp > XB_SPIN_CAP) { atomicAdd(&(bar)[XB_TMO], 1u); break; } } } } while (0)

struct XcdBarrier {
    unsigned* bar; unsigned x;
    volatile LAS unsigned* st;
};

__device__ __forceinline__ XcdBarrier xcd_barrier_post(unsigned* bar, volatile LAS unsigned* st) {
    XcdBarrier b; b.bar = bar; b.x = xb_xcc_id(); b.st = st;
    if (threadIdx.x == 0) (void)xb_add(&bar[XB_XCNT(b.x)], 1u);
    return b;
}
__device__ __forceinline__ void xcd_barrier_complete(unsigned* bar, unsigned x, unsigned& nloc, unsigned& nx) {
    const unsigned G = gridDim.x * gridDim.y * gridDim.z;
    unsigned sum, cnt, mine, sp = 0u;
    for (;;) {
        sum = 0u; cnt = 0u; mine = 0u;
#pragma unroll
        for (unsigned j = 0; j < 16; ++j) { const unsigned c = xb_ld(&bar[XB_XCNT(j)]); sum += c; cnt += (c > 0u) ? 1u : 0u; mine = (j == x) ? c : mine; }
        if (sum == G) break;
        __builtin_amdgcn_s_sleep(1);
        if ((++sp & 255u) == 0u) { if (xb_ld(&bar[XB_TMO])) break; if (sp > XB_SPIN_CAP) { atomicAdd(&bar[XB_TMO], 1u); break; } }
    }
    nloc = mine > 0u ? mine : 1u; nx = cnt > 0u ? cnt : 1u;
}

__device__ __forceinline__ void xcd_barrier(const XcdBarrier& b) {
    asm volatile("s_waitcnt vmcnt(0)" ::: "memory");
    __syncthreads();
    if (threadIdx.x == 0) {
        unsigned* bar = b.bar;
        __builtin_amdgcn_s_waitcnt(0);
        unsigned nloc = b.st[0], nx = b.st[1];
        if (nloc == 0u) { xcd_barrier_complete(bar, b.x, nloc, nx); b.st[0] = nloc; b.st[1] = nx; }
        const unsigned old = xb_add(&bar[XB_XSUB(b.x)], 1u);
        const unsigned gen = old / nloc;
        if (old + 1u == (gen + 1u) * nloc) {
            __builtin_amdgcn_fence(__ATOMIC_RELEASE, "agent");
            asm volatile("s_waitcnt vmcnt(0)" ::: "memory");
            const unsigned og = xb_add(&bar[XB_TOP], 1u);
            const unsigned tg = og / nx;
            if (og + 1u == (tg + 1u) * nx) xb_add(&bar[XB_TOPGEN], 1u);
            else XB_SPIN(xb_ld(&bar[XB_TOPGEN]) == tg, bar);
            __builtin_amdgcn_fence(__ATOMIC_ACQUIRE, "agent");
            xb_add(&bar[XB_XGEN(b.x)], 1u);
            asm volatile("s_waitcnt vmcnt(0)" ::: "memory");
        } else {
            XB_SPIN(xb_ld(&bar[XB_XGEN(b.x)]) == gen, bar);
            __builtin_amdgcn_fence(__ATOMIC_ACQUIRE, "agent");
            asm volatile("s_waitcnt vmcnt(0)" ::: "memory");
        }
    }
    __syncthreads();
}


__device__ __forceinline__ void phase_expert_dynamic(const Params& p, LAS unsigned char* lds, volatile LAS unsigned* misc, unsigned* xctr) {
    const int lane = threadIdx.x & 63, wave = threadIdx.x >> 6; LAS float* scr = (LAS float*)(lds + wave * 16384);
    constexpr int XCH = 16;
    static_assert(EXP_ITEMS % XCH == 0, "chunking");
    __syncthreads();
    if (threadIdx.x == 0) misc[8] = xb_add(xctr, 1u);
    __syncthreads();
    unsigned cur = misc[8];
#pragma unroll 1
    while (cur < (unsigned)(EXP_ITEMS / XCH)) {
        unsigned nxt = 0u; if (threadIdx.x == 0) nxt = xb_add(xctr, 1u);
        const int it0 = (int)cur * XCH + wave;
        XRaw Ra, Rb;
        expert_load(p, it0, lane, Ra);
#pragma unroll 1
        for (int j = 0; j < XCH / NW; j += 2) {
            expert_load(p, it0 + (j + 1) * NW, lane, Rb);
            expert_finish(p, scr, it0 + j * NW, lane, Ra);
            if (j + 2 < XCH / NW) expert_load(p, it0 + (j + 2) * NW, lane, Ra);
            expert_finish(p, scr, it0 + (j + 1) * NW, lane, Rb);
        }
        __syncthreads();
        if (threadIdx.x == 0) misc[8] = nxt;
        __syncthreads();
        cur = misc[8];
    }
}

constexpr int N_PHASES = 17;
__global__ void __launch_bounds__(NT) mega(Params p) {
    extern __shared__ __attribute__((aligned(16))) unsigned char lds_raw[];
    LAS unsigned char* lds = (LAS unsigned char*)lds_raw;
    cg::grid_group grid = cg::this_grid();
    unsigned char* ws = p.ws;
    const int G = gridDim.x;
    const int lo = p.ph_lo, hi = p.ph_hi;
    volatile LAS unsigned* misc = (volatile LAS unsigned*)(lds + LDS_BYTES - 64);
    if (threadIdx.x < 16) misc[threadIdx.x] = 0u;
    __syncthreads();
    XcdBarrier bar; bar.bar = (unsigned*)(ws + OFF_BAR); bar.x = 0; bar.st = nullptr;
    if (hi - lo > 1) bar = xcd_barrier_post((unsigned*)(ws + OFF_BAR), misc);
#ifndef PHMASK
#define PHMASK 0xFFFFFFFFu
#endif
#define IN(k) (((PHMASK >> (k)) & 1) && lo <= (k) && (k) < hi)
#define SEAM(k) do { if (IN(k) && IN((k) + 1)) { if ((k) == 0 && G != 256) grid.sync(); else xcd_barrier(bar); } } while (0)
#ifndef PROBE_PH
#define PROBE_PH (-1)
#endif
#define RUNPH(k, ...) do { if (IN(k)) { __VA_ARGS__; if (PROBE_PH == (k)) { xcd_barrier(bar); __VA_ARGS__; } } } while (0)
    RUNPH(0, phase_prep(p, lds));
    SEAM(0);
    RUNPH(1, phase_norm1(p));
    SEAM(1);
    RUNPH(2, { pg8::Gemm g{(const bf16*)(ws + OFF_XN1), (const bf16*)(ws + OFF_WIN), NROW, UC, D_}; pg8::StaticOrder S; S.init(NROW, UC, G, blockIdx.x);
                 EpiU E{(bf16*)(ws + OFF_U), UC}; pg8::gemm_phase<EpiU, pg8::StaticOrder, true, true>(lds, g, S, E); });
    SEAM(2);
    RUNPH(3, phase_qk(p));
    RUNPH(4, {
        constexpr int NTILE = 128 + 2048;
        for (int t = blockIdx.x; t < NTILE; t += G) rwkv_prep_tile(p, lds, t);
    });
    SEAM(4);
    RUNPH(5, {
        unsigned* mdone = (unsigned*)(ws + OFF_BAR) + 3520; unsigned* xctr = mdone + 64;
        if (G == 256) {
            if (blockIdx.x < 128) rwkv_chunk_item(p, lds, blockIdx.x);
            else { mlstm_item(p, lds, blockIdx.x - 128); __syncthreads(); if (threadIdx.x == 0) { __threadfence(); xb_add(mdone, 1u); } }
            if (threadIdx.x == 0) { while (xb_ld(mdone) < 128u) __builtin_amdgcn_s_sleep(8); }
            __syncthreads();
        } else {
            for (int it = blockIdx.x; it < 128; it += G) mlstm_item(p, lds, it);
            __syncthreads();
            for (int it = blockIdx.x; it < 128; it += G) rwkv_chunk_item(p, lds, it);
            xcd_barrier(bar);
        }
        phase_expert_dynamic(p, lds, misc, xctr);
    });
    SEAM(5);
    RUNPH(6, phase_combine(p));
    SEAM(6);
    RUNPH(7, { pg8::Gemm g{(const bf16*)(ws + OFF_MIX), (const bf16*)(ws + OFF_WOUT), NLAT, D_, D_}; pg8::StaticOrder S; S.init(NLAT, D_, G, blockIdx.x);
                 EpiH E{p.in[0], (const float*)(ws + OFF_MOD), (bf16*)(ws + OFF_H)}; pg8::gemm_phase<EpiH, pg8::StaticOrder, true, true>(lds, g, S, E); });
    SEAM(7);
    RUNPH(9, phase_norm2(p, lds));
    SEAM(9);
    RUNPH(10, phase_topk(p, lds));
    SEAM(10);
#pragma unroll 1
    for (int gi = 0; gi < NG; ++gi) {
        RUNPH(12 + 2 * gi, {
            pg8::Gemm g{(const bf16*)(ws + OFF_XN2), (const bf16*)(ws + OFF_W13 + (size_t)gi * EG * 5632 * D_), EG * 4096, EG * 5632, D_ / 2, 0x7A7A7A7A, 0x7F7F7F7F, (const int*)(ws + OFF_IDX) + (size_t)gi * EG * 4096};
            ExpertOrder S{22, G, (int)blockIdx.x}; EpiHid E{ws + OFF_HID, 22};
            pg8::gemm_phase<EpiHid, ExpertOrder, true, true, true, true>(lds, g, S, E); });
        SEAM(12 + 2 * gi);
        RUNPH(13 + 2 * gi, {
            pg8::Gemm g{(const bf16*)(ws + OFF_HID), (const bf16*)(ws + OFF_W2 + (size_t)gi * EG * D_ * DE), EG * 4096, EG * D_, DE / 2, 0x79797979, 0x7C7C7C7C};
            ExpertOrder S{4, G, (int)blockIdx.x}; EpiYs E{(bf16*)(ws + OFF_YS) + (size_t)gi * EG * 4096 * D_, (const float*)(ws + OFF_GATE) + (size_t)gi * EG * 4096, 4};
            pg8::gemm_phase<EpiYs, ExpertOrder, true, true, true>(lds, g, S, E); });
        SEAM(13 + 2 * gi);
    }
    if (IN(16)) phase_final(p);
}
}

#ifndef MK_SPLIT
#define MK_SPLIT 0
#endif
extern "C" void kernel_launch(void* const* d_in, const int* in_sizes, int n_in, void* d_out, int out_size, void* d_ws, size_t ws_size, hipStream_t stream) {
    static int grid = 0;
    if (grid == 0) {
        int dev = 0, cus = 0, per_cu = 0;
        (void)hipGetDevice(&dev);
        (void)hipDeviceGetAttribute(&cus, hipDeviceAttributeMultiprocessorCount, dev);
        (void)hipFuncSetAttribute((const void*)mega, hipFuncAttributeMaxDynamicSharedMemorySize, LDS_BYTES);
        (void)hipOccupancyMaxActiveBlocksPerMultiprocessor(&per_cu, (const void*)mega, NT, LDS_BYTES);
        if (per_cu < 1) { fprintf(stderr, "kernel_launch: occupancy query reports %d blocks per CU\n", per_cu); per_cu = 1; }
        grid = cus * 1;
        if (ws_size < WS_END) { fprintf(stderr, "kernel_launch: workspace too small (%zu < %zu)\n", ws_size, (size_t)WS_END); grid = -1; }
    }
    if (grid < 0) return;
    if (hipMemsetAsync((char*)d_ws + OFF_BAR, 0, 16384, stream) != hipSuccess) { fprintf(stderr, "kernel_launch: memset of the barrier words failed\n"); return; }
    Params p{};
    for (int i = 0; i < 30; ++i) p.in[i] = (const float*)d_in[i];
    p.out = (float*)d_out; p.ws = (unsigned char*)d_ws;
#if MK_SPLIT
    for (int ph = 0; ph < N_PHASES; ++ph) { p.ph_lo = ph; p.ph_hi = ph + 1; hipLaunchKernelGGL(mega, dim3(grid), dim3(NT), LDS_BYTES, stream, p); }
#else
    p.ph_lo = 0; p.ph_hi = N_PHASES;
    void* args[] = {&p};
    hipError_t e = hipLaunchCooperativeKernel((const void*)mega, dim3(grid), dim3(NT), args, LDS_BYTES, stream);
    if (e != hipSuccess) fprintf(stderr, "cooperative launch failed: %s (grid %d)\n", hipGetErrorString(e), grid);
#endif
}
```
